# Optimizing an MI355X kernel written in HIP

```python
import jax, jax.numpy as jnp
from jax import lax
import numpy as np

D_MODEL = 2048
BATCH = 2
SEQ = 4096
DEPTH = 2

MIX_WIDTH = D_MODEL
RWKV_WIDTH = MIX_WIDTH // 2
RWKV_HEAD = 64
RWKV_HEADS = RWKV_WIDTH // RWKV_HEAD
DECAY_LORA = 64
ICLR_LORA = 64
VRES_LORA = 32
GATE_LORA = 128
ATTN_WIDTH = MIX_WIDTH - RWKV_WIDTH
ATTN_HEAD = 128
ATTN_HEADS = ATTN_WIDTH // ATTN_HEAD
MOBA_BLOCK = 256
MOBA_TOPK = 3
QUERY_CHUNK = 16
ROPE_THETA = 10000.0
D_FF = 4 * D_MODEL
NORM_EPS = 1e-6
LNX_EPS = 64e-5
N_SHIFT = 3 * RWKV_WIDTH + DECAY_LORA + ICLR_LORA + GATE_LORA
N_IN = N_SHIFT + 3 * ATTN_WIDTH

kernel_name = 'hybrid_rwkv7_moba_sandwich'


def rms_norm(x, gain):
    xf = x.astype(jnp.float32)
    y = xf * lax.rsqrt(jnp.mean(xf * xf, axis=-1, keepdims=True) + NORM_EPS)
    return (y * gain.astype(jnp.float32)).astype(x.dtype)


def token_shift(z, mu):
    prev = jnp.pad(z[:, :-1], ((0, 0), (1, 0), (0, 0)))
    return z + (prev - z) * mu


def wkv7_scan(r, w, k, v, a, b):
    bsz, _, nh, n = r.shape

    def step(state, inp):
        r_t, w_t, k_t, v_t, a_t, b_t = inp
        sa = jnp.einsum('bhij,bhj->bhi', state, a_t)
        state = (state * w_t[:, :, None, :] + sa[..., None] * b_t[:, :, None, :]
                 + v_t[..., None] * k_t[:, :, None, :])
        return state, jnp.einsum('bhij,bhj->bhi', state, r_t)

    xs = tuple(jnp.moveaxis(t, 1, 0) for t in (r, w, k, v, a, b))
    state0 = jnp.zeros((bsz, nh, n, n), jnp.float32)
    _, y = lax.scan(step, state0, xs)
    return jnp.moveaxis(y, 0, 1)


def rwkv7_mix(zs, v_first, vres, w0, w2, a0, a2, g2, k_k, k_a, r_k, lnx_g, lnx_b):
    bsz, s, _ = zs.shape
    c = RWKV_WIDTH
    f32 = jnp.float32
    r, k, v = zs[..., :c], zs[..., c:2 * c], zs[..., 2 * c:3 * c]
    o = 3 * c
    wd = zs[..., o:o + DECAY_LORA]
    o += DECAY_LORA
    ad = zs[..., o:o + ICLR_LORA]
    o += ICLR_LORA
    gd = zs[..., o:o + GATE_LORA]
    w_log = -jax.nn.softplus(-(w0 + jnp.tanh(wd) @ w2)) - 0.5
    decay = jnp.exp(-jnp.exp(w_log.astype(f32)))
    a = jax.nn.sigmoid(a0 + ad @ a2)
    g = jax.nn.sigmoid(gd) @ g2
    if vres is not None:
        vd, v0, v2 = vres
        v = v + (v_first - v) * jax.nn.sigmoid(v0 + vd @ v2)
    heads = lambda t: t.reshape(bsz, s, RWKV_HEADS, RWKV_HEAD).astype(f32)
    kk = heads(k * k_k)
    kk = kk / jnp.maximum(jnp.sqrt(jnp.sum(kk * kk, axis=-1, keepdims=True)), 1e-12)
    k = k * (1 + (a - 1) * k_a)
    rh, kh, vh, ah = heads(r), heads(k), heads(v), heads(a)
    y = wkv7_scan(rh, heads(decay), kh, vh, -kk, kk * ah)
    mu = jnp.mean(y, axis=-1, keepdims=True)
    var = jnp.mean(jnp.square(y - mu), axis=-1, keepdims=True)
    yn = ((y - mu) * lax.rsqrt(var + LNX_EPS)).reshape(bsz, s, c)
    yn = yn * lnx_g.astype(f32) + lnx_b.astype(f32)
    bonus = jnp.sum(rh * kh * r_k.astype(f32), axis=-1, keepdims=True) * vh
    out = (yn + bonus.reshape(bsz, s, c)) * g.astype(f32)
    return out.astype(zs.dtype), v


def rope(x, positions):
    half = x.shape[-1] // 2
    inv_freq = ROPE_THETA ** (-jnp.arange(half, dtype=jnp.float32) / half)
    ang = positions.astype(jnp.float32)[:, None] * inv_freq[None, :]
    cos, sin = jnp.cos(ang), jnp.sin(ang)
    xf = x.astype(jnp.float32)
    x1, x2 = xf[..., :half], xf[..., half:]
    return jnp.concatenate([x1 * cos - x2 * sin, x2 * cos + x1 * sin], axis=-1).astype(x.dtype)


def moba_attention(q, k, v):
    bsz, nh, s, dh = q.shape
    f32 = jnp.float32
    nb = -(-s // MOBA_BLOCK)
    s_pad = nb * MOBA_BLOCK
    pad = ((0, 0), (0, 0), (0, s_pad - s), (0, 0))
    q, k, v = (jnp.pad(t, pad) for t in (q, k, v))
    k_blk = k.reshape(bsz, nh, nb, MOBA_BLOCK, dh).astype(f32)
    v_blk = v.reshape(bsz, nh, nb, MOBA_BLOCK, dh).astype(f32)
    k_mean = jnp.mean(k_blk, axis=3)
    gate = jnp.einsum('bhsd,bhnd->bhsn', q.astype(f32), k_mean)
    q_blk = jnp.arange(s_pad) // MOBA_BLOCK
    past = jnp.arange(nb)[None, :] < q_blk[:, None]
    gate = jnp.where(past, gate, -jnp.inf)
    topk = min(MOBA_TOPK, nb)
    sel_score, sel_idx = lax.top_k(gate, topk)
    sel_valid = jnp.isfinite(sel_score)

    n_chunks = s_pad // QUERY_CHUNK
    scale = dh ** -0.5

    def to_chunks(t):
        t = t.reshape(bsz, nh, n_chunks, QUERY_CHUNK, *t.shape[3:])
        return jnp.moveaxis(t, 2, 0)

    b_idx = jnp.arange(bsz)[:, None, None, None]
    h_idx = jnp.arange(nh)[None, :, None, None]
    q_offs = jnp.arange(QUERY_CHUNK)
    k_offs = jnp.arange(MOBA_BLOCK)

    def attend(inp):
        c, q_c, idx_c, valid_c = inp
        start = c * QUERY_CHUNK
        own = start // MOBA_BLOCK
        k_sel = k_blk[b_idx, h_idx, idx_c]
        v_sel = v_blk[b_idx, h_idx, idx_c]
        k_own = lax.dynamic_index_in_dim(k_blk, own, axis=2, keepdims=False)
        v_own = lax.dynamic_index_in_dim(v_blk, own, axis=2, keepdims=False)
        qf = q_c.astype(f32) * scale
        s_sel = jnp.einsum('bhqd,bhqkjd->bhqkj', qf, k_sel)
        s_sel = jnp.where(valid_c[..., None], s_sel, -jnp.inf)
        s_sel = s_sel.reshape(bsz, nh, QUERY_CHUNK, topk * MOBA_BLOCK)
        s_own = jnp.einsum('bhqd,bhjd->bhqj', qf, k_own)
        q_pos = start + q_offs
        k_pos = own * MOBA_BLOCK + k_offs
        s_own = jnp.where(k_pos[None, :] <= q_pos[:, None], s_own, -jnp.inf)
        p = jax.nn.softmax(jnp.concatenate([s_sel, s_own], axis=-1), axis=-1)
        p_sel = p[..., :topk * MOBA_BLOCK].reshape(bsz, nh, QUERY_CHUNK, topk, MOBA_BLOCK)
        p_own = p[..., topk * MOBA_BLOCK:]
        o = (jnp.einsum('bhqkj,bhqkjd->bhqd', p_sel, v_sel)
             + jnp.einsum('bhqj,bhjd->bhqd', p_own, v_own))
        return o.astype(q_c.dtype)

    out = lax.map(attend, (jnp.arange(n_chunks), to_chunks(q), to_chunks(sel_idx), to_chunks(sel_valid)))
    out = jnp.moveaxis(out, 0, 2).reshape(bsz, nh, s_pad, dh)
    return out[:, :, :s]


def setup_inputs(seed: int = 0) -> dict:
    key = jax.random.key(seed)
    ks = iter(jax.random.split(key, 32))
    nrm = lambda shape, scale: jax.random.normal(next(ks), shape, jnp.float32) * scale
    gain = lambda shape: 1.0 + nrm(shape, 0.05)
    unif = lambda shape: jax.random.uniform(next(ks), shape, jnp.float32)
    L, Lv, C = DEPTH, DEPTH - 1, RWKV_WIDTH
    return {
        'x': nrm((BATCH, SEQ, D_MODEL), 1.0),
        'norm_mix_pre': gain((L, D_MODEL)),
        'norm_mix_post': gain((L, D_MODEL)),
        'norm_mlp_pre': gain((L, D_MODEL)),
        'norm_mlp_post': gain((L, D_MODEL)),
        'w_in': nrm((L, D_MODEL, N_IN), D_MODEL ** -0.5),
        'w_in_vres': nrm((Lv, D_MODEL, VRES_LORA), D_MODEL ** -0.5),
        'shift_mu': unif((L, N_SHIFT)),
        'shift_mu_vres': unif((Lv, VRES_LORA)),
        'decay_w0': nrm((L, C), 0.5),
        'decay_w2': nrm((L, DECAY_LORA, C), 0.5 * DECAY_LORA ** -0.5),
        'iclr_a0': nrm((L, C), 0.5),
        'iclr_a2': nrm((L, ICLR_LORA, C), 0.5 * ICLR_LORA ** -0.5),
        'vres_v0': nrm((Lv, C), 0.5),
        'vres_v2': nrm((Lv, VRES_LORA, C), 0.5 * VRES_LORA ** -0.5),
        'gate_g2': nrm((L, GATE_LORA, C), GATE_LORA ** -0.5),
        'k_k': 0.85 + nrm((L, C), 0.05),
        'k_a': gain((L, C)),
        'r_k': nrm((L, RWKV_HEADS, RWKV_HEAD), 0.1),
        'lnx_gain': gain((L, C)),
        'lnx_bias': nrm((L, C), 0.01),
        'w_out': nrm((L, MIX_WIDTH, D_MODEL), MIX_WIDTH ** -0.5),
        'w_up': nrm((L, D_MODEL, D_FF), D_MODEL ** -0.5),
        'w_down': nrm((L, D_FF, D_MODEL), D_FF ** -0.5),
    }


def reference(x, norm_mix_pre, norm_mix_post, norm_mlp_pre, norm_mlp_post, w_in, w_in_vres,
              shift_mu, shift_mu_vres, decay_w0, decay_w2, iclr_a0, iclr_a2, vres_v0, vres_v2,
              gate_g2, k_k, k_a, r_k, lnx_gain, lnx_bias, w_out, w_up, w_down):
    bsz, s, _ = x.shape
    positions = jnp.arange(s)
    v_first = None
    for i in range(DEPTH):
        h = rms_norm(x, norm_mix_pre[i])
        w_comb = w_in[i] if i == 0 else jnp.concatenate([w_in[i], w_in_vres[i - 1]], axis=1)
        z = h @ w_comb
        z_rwkv = token_shift(z[..., :N_SHIFT], shift_mu[i])
        z_att = z[..., N_SHIFT:N_IN]
        vres = None if i == 0 else (token_shift(z[..., N_IN:], shift_mu_vres[i - 1]),
                                    vres_v0[i - 1], vres_v2[i - 1])
        y_r, v_r = rwkv7_mix(z_rwkv, v_first, vres, decay_w0[i], decay_w2[i], iclr_a0[i], iclr_a2[i],
                             gate_g2[i], k_k[i], k_a[i], r_k[i], lnx_gain[i], lnx_bias[i])
        if i == 0:
            v_first = v_r
        qkv = z_att.reshape(bsz, s, 3, ATTN_HEADS, ATTN_HEAD)
        q = rope(jnp.transpose(qkv[:, :, 0], (0, 2, 1, 3)), positions)
        k = rope(jnp.transpose(qkv[:, :, 1], (0, 2, 1, 3)), positions)
        v = jnp.transpose(qkv[:, :, 2], (0, 2, 1, 3))
        y_a = jnp.transpose(moba_attention(q, k, v), (0, 2, 1, 3)).reshape(bsz, s, ATTN_WIDTH)
        y = jnp.concatenate([y_r, y_a], axis=-1) @ w_out[i]
        x = x + rms_norm(y, norm_mix_post[i])
        h = rms_norm(x, norm_mlp_pre[i])
        m = jnp.square(jax.nn.relu(h @ w_up[i])) @ w_down[i]
        x = x + rms_norm(m, norm_mlp_post[i])
    return x
```

```cpp
#include <hip/hip_runtime.h>
#include <cstdio>
#include <cstdint>
namespace pg8 {
#define PG8_LAS __attribute__((address_space(3)))
typedef unsigned short bf16_t;
typedef short bf16x8 __attribute__((ext_vector_type(8)));
typedef float f32x4 __attribute__((ext_vector_type(4)));
typedef unsigned u32x4 __attribute__((ext_vector_type(4)));
constexpr int BM = 256, BK = 64, HALF = 128, HTB = HALF * BK * 2  , STAGE_BYTES = 8 * HTB, NXCD = 8, WGM = 8;

__host__ __device__ __forceinline__ int lds_byte(int r, int c) { const int st = (r >> 4) * 2 + (c >> 5), rr = r & 15, cc = c & 31, ob = rr * 64 + cc * 2; return st * 1024 + (ob ^ (((ob >> 9) & 1) << 5)); }
__host__ __device__ __forceinline__ void stage_rc(int b, int& R, int& C) { const int st = b / 1024, sb = b % 1024, swz = sb ^ (((sb >> 9) & 1) << 5); R = (st >> 1) * 16 + swz / 64; C = (st & 1) * 32 + (swz % 64) / 2; }
__host__ __device__ __forceinline__ int perm32(int rho) { const int n = rho >> 4, i = rho & 15; return 8 * (i >> 2) + 4 * n + (i & 3); }

struct Unit { int pm, pn; };
struct Gemm { const bf16_t* A; const bf16_t* Bt; int M, N, K; };

struct StaticOrder {
    int nM, nN, nwg, G, c;
    __host__ __device__ void init(int M, int N, int G_, int c_) { nM = M / BM; nN = N / BM; nwg = nM * nN; G = G_; c = c_; }
    __host__ __device__ bool next(int i, Unit& u) const {
        const long L = (long)i * G + c; if (L >= nwg) return false;
        int wgid = (int)L; { const int q = nwg / NXCD, r = nwg % NXCD, xcd = wgid % NXCD, off = wgid / NXCD; wgid = (xcd < r ? xcd * (q + 1) : r * (q + 1) + (xcd - r) * q) + off; }
        const int nig = WGM * nN, gid = wgid / nig, fm = gid * WGM, gsz = (nM - fm) < WGM ? (nM - fm) : WGM;
        u.pm = fm + ((wgid % nig) % gsz); u.pn = (wgid % nig) / gsz; return true;
    }
    __device__ __forceinline__ void a_ready(const Unit&) const {}
    __device__ __forceinline__ void done(const Unit&) const {}
};

__device__ __forceinline__ unsigned cvt_pk_bf16(float lo, float hi) { unsigned r; asm volatile("v_cvt_pk_bf16_f32 %0, %1, %2" : "=v"(r) : "v"(lo), "v"(hi)); return r; }
struct EpiF32 {
    static constexpr bool PERM = false, AFTER_DRAIN = false;
    float* C; int ldc;
    __device__ __forceinline__ void operator()(const f32x4 (&acc)[2][2][4][2], const Unit& u, int wr, int wc, int fr, int fq) const {
        const int row0 = u.pm * BM + wr * 64 + fr, col0 = u.pn * BM + wc * 32 + 4 * fq;
#pragma unroll
        for (int ai = 0; ai < 2; ++ai)
#pragma unroll
            for (int m = 0; m < 4; ++m) { float* rowp = C + (size_t)(row0 + ai * HALF + m * 16) * ldc + col0;
#pragma unroll
                for (int bj = 0; bj < 2; ++bj)
#pragma unroll
                    for (int n = 0; n < 2; ++n) *(f32x4*)(rowp + bj * HALF + n * 16) = acc[ai][bj][m][n]; }
    }
};
template <int ACT  > struct EpiBf16 {
    static constexpr bool PERM = true, AFTER_DRAIN = false;
    bf16_t* O; int ldc;
    __device__ __forceinline__ void operator()(const f32x4 (&acc)[2][2][4][2], const Unit& u, int wr, int wc, int fr, int fq) const {
        const int row0 = u.pm * BM + wr * 64 + fr; const int col0 = u.pn * BM + wc * 32 + 8 * fq;
#pragma unroll
        for (int ai = 0; ai < 2; ++ai)
#pragma unroll
            for (int m = 0; m < 4; ++m) { bf16_t* rowp = O + (size_t)(row0 + ai * HALF + m * 16) * ldc + col0;
#pragma unroll
                for (int bj = 0; bj < 2; ++bj) { f32x4 v0 = acc[ai][bj][m][0], v1 = acc[ai][bj][m][1];
                    if (ACT == 2) {
#pragma unroll
                        for (int e = 0; e < 4; ++e) { float a = v0[e] > 0.f ? v0[e] : 0.f; v0[e] = a * a; float b = v1[e] > 0.f ? v1[e] : 0.f; v1[e] = b * b; } }
                    u32x4 w; w.x = cvt_pk_bf16(v0[0], v0[1]); w.y = cvt_pk_bf16(v0[2], v0[3]); w.z = cvt_pk_bf16(v1[0], v1[1]); w.w = cvt_pk_bf16(v1[2], v1[3]);
                    *(u32x4*)(rowp + bj * HALF) = w; } }
    }
};

template <class Epi, class Sched, bool ALIGN_EPI = false, bool SP2 = false>
__device__ __forceinline__ void gemm_phase(PG8_LAS unsigned char* lds, const Gemm g, const Sched& S, const Epi& E, const int tid) {
    const int wid = __builtin_amdgcn_readfirstlane(tid >> 6), lane = tid & 63, wr = wid >> 2, wc = wid & 3, fr = lane & 15, fq = lane >> 4;
    const int K = g.K, nt = K / BK;
    unsigned voffA[2], voffB[2];
#pragma unroll
    for (int i = 0; i < 2; ++i) { int R, C; stage_rc(tid * 16 + i * 8192, R, C); const int Rb = Epi::PERM ? ((R & ~31) + perm32(R & 31)) : R;
        voffA[i] = (unsigned)(R * K + C) * 2u; voffB[i] = (unsigned)(Rb * K + C) * 2u; }
    const size_t kstep = (size_t)(BK * 2);
    const size_t hstep = (size_t)HALF * K * 2;
    const size_t tstep = 2 * hstep;
    const unsigned ldsw = (unsigned)wid * 1024u;
    const int aoff = lds_byte(wr * 64 + fr, fq * 8), boff = lds_byte(wc * 32 + fr, fq * 8);
#define PG8_SA(b, h) (((b) * 2 + (h)) * HTB)
#define PG8_SB(b, h) ((4 + (b) * 2 + (h)) * HTB)
#define PG8_STAGE(bufoff, gbase, voff) do { _Pragma("unroll") for (int _i = 0; _i < 2; ++_i) \
        __builtin_amdgcn_global_load_lds((const unsigned*)((const char*)(gbase) + (voff)[_i]), (PG8_LAS unsigned*)(lds + (bufoff) + ldsw + _i * 8192), 16, 0, 0); } while (0)
#define PG8_LDA(dst, b, h) do { _Pragma("unroll") for (int m = 0; m < 4; ++m) _Pragma("unroll") for (int k = 0; k < 2; ++k) dst[m][k] = *(const PG8_LAS bf16x8*)(lds + PG8_SA(b, h) + aoff + m * 2048 + k * 1024); } while (0)
#define PG8_LDB(dst, b, h) do { _Pragma("unroll") for (int n = 0; n < 2; ++n) _Pragma("unroll") for (int k = 0; k < 2; ++k) dst[n][k] = *(const PG8_LAS bf16x8*)(lds + PG8_SB(b, h) + boff + n * 2048 + k * 1024); } while (0)
#define PG8_MMA(ai, bj, At, Bt) do { __builtin_amdgcn_s_setprio(1); _Pragma("unroll") for (int m = 0; m < 4; ++m) _Pragma("unroll") for (int n = 0; n < 2; ++n) _Pragma("unroll") for (int k = 0; k < 2; ++k) \
        acc[ai][bj][m][n] = __builtin_amdgcn_mfma_f32_16x16x32_bf16(Bt[n][k], At[m][k], acc[ai][bj][m][n], 0, 0, 0); __builtin_amdgcn_s_setprio(0); } while (0)
#define PG8_WAIT_V(n) asm volatile("s_waitcnt vmcnt(" #n ")" ::: "memory")
#define PG8_WAIT_L(n) asm volatile("s_waitcnt lgkmcnt(" #n ")" ::: "memory")
#define PG8_BAR __builtin_amdgcn_s_barrier()
#define PG8_SCHED __builtin_amdgcn_sched_barrier(0)
    Unit cur, nxt; int ui = 0;
    if (!S.next(0, cur)) return;
    f32x4 acc[2][2][4][2];
#pragma unroll
    for (int a = 0; a < 2; ++a)
#pragma unroll
        for (int b = 0; b < 2; ++b)
#pragma unroll
            for (int m = 0; m < 4; ++m)
#pragma unroll
                for (int n = 0; n < 2; ++n) acc[a][b][m][n] = (f32x4){0.f, 0.f, 0.f, 0.f};
    bf16x8 At[4][2], B0[2][2], B1[2][2];
    const char* cA = (const char*)g.A + (size_t)cur.pm * tstep; const char* cB = (const char*)g.Bt + (size_t)cur.pn * tstep;
    S.a_ready(cur);
    if constexpr (SP2) {
        PG8_STAGE(PG8_SB(0, 0), cB, voffB); PG8_STAGE(PG8_SB(0, 1), cB + hstep, voffB); PG8_STAGE(PG8_SA(0, 0), cA, voffA); PG8_STAGE(PG8_SA(0, 1), cA + hstep, voffA);
        if (wr == 1) PG8_BAR;
        PG8_WAIT_V(2); PG8_BAR;
        PG8_STAGE(PG8_SB(1, 0), cB + kstep, voffB); PG8_STAGE(PG8_SA(1, 0), cA + kstep, voffA); PG8_STAGE(PG8_SB(1, 1), cB + hstep + kstep, voffB);
        PG8_WAIT_V(6); PG8_BAR;
    } else {
        PG8_STAGE(PG8_SB(0, 0), cB, voffB); PG8_STAGE(PG8_SA(0, 0), cA, voffA); PG8_STAGE(PG8_SB(0, 1), cB + hstep, voffB); PG8_STAGE(PG8_SA(0, 1), cA + hstep, voffA);
        if (wr == 1) PG8_BAR;
        PG8_WAIT_V(4); PG8_BAR;
        PG8_STAGE(PG8_SB(1, 0), cB + kstep, voffB); PG8_STAGE(PG8_SA(1, 0), cA + kstep, voffA); PG8_STAGE(PG8_SB(1, 1), cB + hstep + kstep, voffB);
        PG8_WAIT_V(6); PG8_BAR;
    }
    for (;;) {
        const bool has_next = S.next(ui + 1, nxt);
        const char* nA = has_next ? (const char*)g.A + (size_t)nxt.pm * tstep : cA; const char* nB = has_next ? (const char*)g.Bt + (size_t)nxt.pn * tstep : cB;
        for (int t = 0; t < nt; t += 2) {
            const bool last = (t == nt - 2);
            const char* a1 = cA + (size_t)(t + 1) * kstep;
            const char* a2 = last ? nA : cA + (size_t)(t + 2) * kstep; const char* b2 = last ? nB : cB + (size_t)(t + 2) * kstep;
            const char* a3 = a2 + kstep; const char* b3 = b2 + kstep;
            if (last && has_next) S.a_ready(nxt);
            if constexpr (SP2) {
            PG8_LDB(B0, 0, 0); PG8_LDB(B1, 0, 1); PG8_SCHED; PG8_LDA(At, 0, 0); PG8_STAGE(PG8_SA(1, 1), a1 + hstep, voffA);
            PG8_WAIT_V(8); PG8_WAIT_L(0); PG8_BAR; PG8_MMA(0, 0, At, B0); PG8_MMA(0, 1, At, B1); PG8_BAR; PG8_SCHED;
            PG8_LDA(At, 0, 1); PG8_STAGE(PG8_SB(0, 0), b2, voffB); PG8_STAGE(PG8_SB(0, 1), b2 + hstep, voffB); PG8_STAGE(PG8_SA(0, 0), a2, voffA);
            PG8_WAIT_V(8); PG8_WAIT_L(0); PG8_BAR; PG8_MMA(1, 0, At, B0); PG8_MMA(1, 1, At, B1); PG8_BAR; PG8_SCHED;
            PG8_LDB(B0, 1, 0); PG8_LDB(B1, 1, 1); PG8_SCHED; PG8_LDA(At, 1, 0); PG8_STAGE(PG8_SA(0, 1), a2 + hstep, voffA);
            PG8_WAIT_V(8); PG8_WAIT_L(0); PG8_BAR; PG8_MMA(0, 0, At, B0); PG8_MMA(0, 1, At, B1); PG8_BAR; PG8_SCHED;
            PG8_LDA(At, 1, 1); PG8_STAGE(PG8_SB(1, 0), b3, voffB); PG8_STAGE(PG8_SB(1, 1), b3 + hstep, voffB); PG8_STAGE(PG8_SA(1, 0), a3, voffA);
            PG8_WAIT_V(8); PG8_WAIT_L(0); PG8_BAR; PG8_MMA(1, 0, At, B0); PG8_MMA(1, 1, At, B1); PG8_BAR; PG8_SCHED;
            } else {
            PG8_LDB(B0, 0, 0); PG8_SCHED; PG8_LDA(At, 0, 0); PG8_STAGE(PG8_SA(1, 1), a1 + hstep, voffA);
            PG8_WAIT_L(8); PG8_BAR; PG8_WAIT_L(0); PG8_MMA(0, 0, At, B0); PG8_BAR; PG8_SCHED;
            PG8_LDB(B1, 0, 1); PG8_STAGE(PG8_SB(0, 0), b2, voffB);
            PG8_BAR; PG8_WAIT_L(0); PG8_MMA(0, 1, At, B1); PG8_BAR;
            PG8_LDA(At, 0, 1); PG8_STAGE(PG8_SA(0, 0), a2, voffA);
            PG8_BAR; PG8_WAIT_L(0); PG8_MMA(1, 0, At, B0); PG8_BAR; PG8_SCHED;
            PG8_STAGE(PG8_SB(0, 1), b2 + hstep, voffB);
            PG8_WAIT_V(6); PG8_BAR; PG8_MMA(1, 1, At, B1); PG8_BAR;
            PG8_LDB(B0, 1, 0); PG8_SCHED; PG8_LDA(At, 1, 0); PG8_STAGE(PG8_SA(0, 1), a2 + hstep, voffA);
            PG8_WAIT_L(8); PG8_BAR; PG8_WAIT_L(0); PG8_MMA(0, 0, At, B0); PG8_BAR; PG8_SCHED;
            PG8_LDB(B1, 1, 1); PG8_STAGE(PG8_SB(1, 0), b3, voffB);
            PG8_BAR; PG8_WAIT_L(0); PG8_MMA(0, 1, At, B1); PG8_BAR;
            PG8_LDA(At, 1, 1); PG8_STAGE(PG8_SA(1, 0), a3, voffA);
            PG8_BAR; PG8_WAIT_L(0); PG8_MMA(1, 0, At, B0); PG8_BAR; PG8_SCHED;
            PG8_STAGE(PG8_SB(1, 1), b3 + hstep, voffB);
            PG8_WAIT_V(6); PG8_BAR; PG8_MMA(1, 1, At, B1); PG8_BAR;
            }
        }
        if constexpr (ALIGN_EPI) { if (wr == 0) PG8_BAR; }
        if constexpr (!Epi::AFTER_DRAIN) { E(acc, cur, wr, wc, fr, fq); S.done(cur); }
        if (!has_next) break;
#pragma unroll
        for (int a = 0; a < 2; ++a)
#pragma unroll
            for (int b = 0; b < 2; ++b)
#pragma unroll
                for (int m = 0; m < 4; ++m)
#pragma unroll
                    for (int n = 0; n < 2; ++n) acc[a][b][m][n] = (f32x4){0.f, 0.f, 0.f, 0.f};
        cur = nxt; cA = nA; cB = nB; ++ui;
        if constexpr (ALIGN_EPI) { if (wr == 1) PG8_BAR; }
    }
    PG8_WAIT_V(0);
    if constexpr (!ALIGN_EPI) { if (wr == 0) PG8_BAR; }
    PG8_BAR;
    if constexpr (Epi::AFTER_DRAIN) { E.fused(acc, cur, wr, wc, fr, fq, lds, wid, lane); S.done(cur); }
#undef PG8_SA
#undef PG8_SB
#undef PG8_STAGE
#undef PG8_LDA
#undef PG8_LDB
#undef PG8_MMA
#undef PG8_WAIT_V
#undef PG8_WAIT_L
#undef PG8_BAR
#undef PG8_SCHED
}
}

#define GAS __attribute__((address_space(1)))
#define LAS __attribute__((address_space(3)))
typedef unsigned short bf16;
typedef unsigned v4u __attribute__((ext_vector_type(4)));
typedef unsigned v2u __attribute__((ext_vector_type(2)));
typedef float f32x4 __attribute__((ext_vector_type(4)));
typedef float f32x16 __attribute__((ext_vector_type(16)));
typedef short bf16x8 __attribute__((ext_vector_type(8)));
typedef GAS unsigned gu32;
#define RLX_AGENT __ATOMIC_RELAXED, __HIP_MEMORY_SCOPE_AGENT
#define LDS_WAIT() asm volatile("s_waitcnt lgkmcnt(0)" ::: "memory")
#define VM_WAIT() asm volatile("s_waitcnt vmcnt(0)" ::: "memory")

constexpr int NWAVES = 8, NTHR = 512;
constexpr int BATCH = 2, SEQ = 4096, T = BATCH * SEQ, D = 2048, C = 1024, NH = 16, HD = 64;
constexpr int AH = 8, AD = 128, MB = 256, NBLK = SEQ / MB;
constexpr int NSHIFT = 3328, NIN = 6400, NZ = 6656, FF = 8192;
constexpr int ZQ = 3328, ZK = 4352, ZV = 5376, ZVD = 6400;
constexpr int DEPTH = 2;
constexpr float NORM_EPS = 1e-6f, LNX_EPS = 64e-5f;

constexpr size_t MiB = 1u << 20;
constexpr size_t WS_CTL = 0, CTL_ZERO_BYTES = 1 * MiB;
constexpr size_t WS_WIN = 1 * MiB, WS_WOUT = 27 * MiB, WS_WUP = 35 * MiB, WS_WDN = 67 * MiB;
constexpr size_t WS_VF = 99 * MiB;
constexpr size_t WS_HN = 131 * MiB;
constexpr size_t WS_YC = 163 * MiB;
constexpr size_t WS_Z = 195 * MiB;
constexpr size_t WS_SR = 299 * MiB, WS_SK = 315 * MiB, WS_SV = 331 * MiB, WS_SKK = 347 * MiB, WS_SA = 363 * MiB;
constexpr size_t WS_SW = 379 * MiB;
constexpr size_t WS_SG = 411 * MiB;
constexpr size_t WS_AQ = 427 * MiB, WS_AK = 443 * MiB, WS_AVT = 459 * MiB;
constexpr size_t WS_KM = 475 * MiB;
constexpr size_t WS_U = 195 * MiB;
constexpr size_t WS_Y2 = 195 * MiB;
constexpr size_t WS_M = 131 * MiB;
constexpr size_t WS_END = 476 * MiB;
constexpr int CW_BAR = 4096;

constexpr int RING_BYTES = 131072;
constexpr int LDSCTL_OFF = RING_BYTES, MISC_OFF = LDSCTL_OFF + 320;
constexpr int LDS_BYTES = 147456;
constexpr int PTAB_OFF = MISC_OFF + 128;

__device__ __forceinline__ unsigned f2bf(float f) { unsigned u = __builtin_bit_cast(unsigned, f); return (u + 0x7fffu + ((u >> 16) & 1u)) >> 16; }
__device__ __forceinline__ unsigned pk2(float lo, float hi) { return f2bf(lo) | (f2bf(hi) << 16); }
__device__ __forceinline__ float bf2f(unsigned short b) { return __builtin_bit_cast(float, (unsigned)b << 16); }
__device__ __forceinline__ float bflo(unsigned w) { return __builtin_bit_cast(float, w << 16); }
__device__ __forceinline__ float bfhi(unsigned w) { return __builtin_bit_cast(float, w & 0xffff0000u); }

#define XB_TMO      128
#define XB_XCNT(j)  (256  + 64 * (j))
#define XB_XSUB(j)  (1280 + 64 * (j))
#define XB_XGEN(j)  (2304 + 64 * (j))
#define XB_TOP      3328
#define XB_TOPGEN   3392
#define XCD_BAR_WORDS 3456
#define XB_SPIN_CAP (1u << 20)
__device__ __forceinline__ unsigned xb_ld(unsigned* p)              { return __hip_atomic_load(p, __ATOMIC_RELAXED, __HIP_MEMORY_SCOPE_AGENT); }
__device__ __forceinline__ unsigned xb_add(unsigned* p, unsigned v) { return __hip_atomic_fetch_add(p, v, __ATOMIC_RELAXED, __HIP_MEMORY_SCOPE_AGENT); }
__device__ __forceinline__ unsigned xb_xcc_id() { return (unsigned)__builtin_amdgcn_s_getreg((3 << 11) | 20) & 0xFu; }
#define XB_SPIN(cond, bar) do { unsigned _sp = 0; while (cond) { __builtin_amdgcn_s_sleep(1); \
    if ((++_sp & 255u) == 0u) { if (xb_ld(&(bar)[XB_TMO])) break; if (_sp > XB_SPIN_CAP) { atomicAdd(&(bar)[XB_TMO], 1u); break; } } } } while (0)
struct XcdBarrier { unsigned* bar; unsigned x; volatile LAS unsigned* st; };
__device__ __forceinline__ XcdBarrier xcd_barrier_post(unsigned* bar, volatile LAS unsigned* st) {
    XcdBarrier b; b.bar = bar; b.x = xb_xcc_id(); b.st = st;
    if (threadIdx.x == 0) (void)xb_add(&bar[XB_XCNT(b.x)], 1u);
    return b;
}
__device__ __forceinline__ void xcd_barrier_complete(unsigned* bar, unsigned x, unsigned& nloc, unsigned& nx) {
    const unsigned G = gridDim.x * gridDim.y * gridDim.z;
    unsigned sum, cnt, mine, sp = 0u;
    for (;;) {
        sum = 0u; cnt = 0u; mine = 0u;
#pragma unroll
        for (unsigned j = 0; j < 16; ++j) { const unsigned c = xb_ld(&bar[XB_XCNT(j)]); sum += c; cnt += (c > 0u) ? 1u : 0u; mine = (j == x) ? c : mine; }
        if (sum == G) break;
        __builtin_amdgcn_s_sleep(1);
        if ((++sp & 255u) == 0u) { if (xb_ld(&bar[XB_TMO])) break; if (sp > XB_SPIN_CAP) { atomicAdd(&bar[XB_TMO], 1u); break; } }
    }
    nloc = mine > 0u ? mine : 1u; nx = cnt > 0u ? cnt : 1u;
}
__device__ __forceinline__ void xcd_barrier(const XcdBarrier& b) {
    asm volatile("s_waitcnt vmcnt(0)" ::: "memory");
    __syncthreads();
    if (threadIdx.x == 0) {
        unsigned* bar = b.bar;
        __builtin_amdgcn_s_waitcnt(0);
        unsigned nloc = b.st[0], nx = b.st[1];
        if (nloc == 0u) { xcd_barrier_complete(bar, b.x, nloc, nx); b.st[0] = nloc; b.st[1] = nx; }
        const unsigned old = xb_add(&bar[XB_XSUB(b.x)], 1u);
        const unsigned gen = old / nloc;
        if (old + 1u == (gen + 1u) * nloc) {
            __builtin_amdgcn_fence(__ATOMIC_RELEASE, "agent");
            asm volatile("s_waitcnt vmcnt(0)" ::: "memory");
            const unsigned og = xb_add(&bar[XB_TOP], 1u);
            const unsigned tg = og / nx;
            if (og + 1u == (tg + 1u) * nx) xb_add(&bar[XB_TOPGEN], 1u);
            else XB_SPIN(xb_ld(&bar[XB_TOPGEN]) == tg, bar);
            __builtin_amdgcn_fence(__ATOMIC_ACQUIRE, "agent");
            xb_add(&bar[XB_XGEN(b.x)], 1u);
            asm volatile("s_waitcnt vmcnt(0)" ::: "memory");
        } else {
            XB_SPIN(xb_ld(&bar[XB_XGEN(b.x)]) == gen, bar);
            __builtin_amdgcn_fence(__ATOMIC_ACQUIRE, "agent");
            asm volatile("s_waitcnt vmcnt(0)" ::: "memory");
        }
    }
    __syncthreads();
}

struct Frame {
    LAS unsigned char* lds;
    volatile LAS unsigned* MISC;
    gu32* ctl;
    int tid, lane, wave, vcu, G;
    float* out;
    unsigned char* ws;
};
enum { I_X = 0, I_NMIXPRE, I_NMIXPOST, I_NMLPPRE, I_NMLPPOST, I_WIN, I_WINV, I_MU, I_MUV, I_W0, I_W2, I_A0, I_A2, I_V0, I_V2, I_G2, I_KK, I_KA, I_RK, I_LNG, I_LNB, I_WOUT, I_WUP, I_WDN };

__device__ __forceinline__ const float* inp_(const Frame& F, int i) {
    const unsigned long long v = *(const LAS unsigned long long*)(F.lds + PTAB_OFF + 8 * i);
    const unsigned lo = __builtin_amdgcn_readfirstlane((unsigned)v), hi = __builtin_amdgcn_readfirstlane((unsigned)(v >> 32));
    return (const float*)(((unsigned long long)hi << 32) | lo);
}
#define INP(i) inp_(F, (i))
__device__ __forceinline__ float wave_sum(float v) {
#pragma unroll
    for (int o = 1; o < 64; o <<= 1) v += __shfl_xor(v, o);
    return v;
}
__device__ __forceinline__ void transpose_item(const float* W, int K, int N, bf16* WT, int row_off, LAS float* scr, int item, int lane) {
    const int nblk = N / 32, kb = item / nblk, nb = item % nblk, k0 = 64 * kb, n0 = 32 * nb;
#pragma unroll 8
    for (int i = 0; i < 32; ++i) { const int kk = 2 * i + (lane >> 5); scr[kk * 33 + (lane & 31)] = W[(size_t)(k0 + kk) * N + n0 + (lane & 31)]; }
    LDS_WAIT(); asm volatile("" ::: "memory");
    const int c = lane & 7;
#pragma unroll
    for (int j = 0; j < 4; ++j) { const int n = (lane >> 3) + 8 * j; const LAS float* s = scr + (8 * c) * 33 + n;
        v4u o; o.x = pk2(s[0 * 33], s[1 * 33]); o.y = pk2(s[2 * 33], s[3 * 33]); o.z = pk2(s[4 * 33], s[5 * 33]); o.w = pk2(s[6 * 33], s[7 * 33]);
        *(GAS v4u*)(WT + (size_t)(row_off + n0 + n) * K + k0 + 8 * c) = o; }
    LDS_WAIT(); asm volatile("" ::: "memory");
}
__device__ __forceinline__ void rmsnorm_row_to_bf16(const float* xrow, const float* gain, bf16* orow, int lane) {
    const GAS f32x4* xr = (const GAS f32x4*)xrow + lane; const GAS f32x4* gr = (const GAS f32x4*)gain + lane;
    f32x4 v[8]; float s = 0.f;
#pragma unroll
    for (int j = 0; j < 8; ++j) { v[j] = xr[64 * j]; s += (v[j].x * v[j].x + v[j].y * v[j].y) + (v[j].z * v[j].z + v[j].w * v[j].w); }
    const float rs = 1.0f / sqrtf(wave_sum(s) * (1.f / D) + NORM_EPS);
    GAS v2u* o8 = (GAS v2u*)orow + lane;
#pragma unroll
    for (int j = 0; j < 8; ++j) { const f32x4 g = gr[64 * j]; v2u w; w.x = pk2(v[j].x * rs * g.x, v[j].y * rs * g.y); w.y = pk2(v[j].z * rs * g.z, v[j].w * rs * g.w); o8[64 * j] = w; }
}
__device__ __forceinline__ void ph_convert(Frame& F, int L) {
    LAS float* scr = (LAS float*)(F.lds + F.wave * 16384);
    const int gw = F.vcu * NWAVES + F.wave, NGW = F.G * NWAVES;
    bf16* WinT = (bf16*)(F.ws + WS_WIN); bf16* WoutT = (bf16*)(F.ws + WS_WOUT); bf16* WupT = (bf16*)(F.ws + WS_WUP); bf16* WdnT = (bf16*)(F.ws + WS_WDN);
    constexpr int I_IN = (D / 64) * (NIN / 32), I_VR = (D / 64), I_OUT = (D / 64) * (D / 32), I_UP = (D / 64) * (FF / 32), I_DN = (FF / 64) * (D / 32);
    const int nvr = (L > 0) ? I_VR : 0;
    const int NITEMS = I_IN + nvr + I_OUT + I_UP + I_DN;
    for (int it = gw; it < NITEMS; it += NGW) {
        int r = it;
        if (r < I_IN) { transpose_item(INP(I_WIN) + (size_t)L * D * NIN, D, NIN, WinT, 0, scr, r, F.lane); continue; } r -= I_IN;
        if (r < nvr) { transpose_item(INP(I_WINV) + (size_t)(L - 1) * D * 32, D, 32, WinT, NIN, scr, r, F.lane); continue; } r -= nvr;
        if (r < I_OUT) { transpose_item(INP(I_WOUT) + (size_t)L * D * D, D, D, WoutT, 0, scr, r, F.lane); continue; } r -= I_OUT;
        if (r < I_UP) { transpose_item(INP(I_WUP) + (size_t)L * D * FF, D, FF, WupT, 0, scr, r, F.lane); continue; } r -= I_UP;
        transpose_item(INP(I_WDN) + (size_t)L * FF * D, FF, D, WdnT, 0, scr, r, F.lane);
    }
    if (L > 0) {
        const int gt = F.vcu * NTHR + F.tid, NGT = F.G * NTHR;
        for (int i = gt; i < (NZ - NIN - 32) * (D / 8); i += NGT) *(GAS v4u*)(WinT + (size_t)(NIN + 32) * D + (size_t)i * 8) = (v4u){0u, 0u, 0u, 0u};
    }
    if (L == 0) {
        bf16* HN = (bf16*)(F.ws + WS_HN);
        for (int m = gw; m < T; m += NGW) rmsnorm_row_to_bf16(INP(I_X) + (size_t)m * D, INP(I_NMIXPRE), HN + (size_t)m * D, F.lane);
    }
}
__device__ __forceinline__ void ph_resnorm(Frame& F, const float* y, const float* xin, const float* gA, const float* gB, float* xout, bf16* hn) {
    const int gw = F.vcu * NWAVES + F.wave, NGW = F.G * NWAVES;
    for (int m = gw; m < T; m += NGW) {
        const GAS f32x4* yr = (const GAS f32x4*)(y + (size_t)m * D) + F.lane; const GAS f32x4* xr = (const GAS f32x4*)(xin + (size_t)m * D) + F.lane;
        const GAS f32x4* ga = (const GAS f32x4*)gA + F.lane;
        f32x4 v[8]; float s = 0.f;
#pragma unroll
        for (int j = 0; j < 8; ++j) { v[j] = yr[64 * j]; s += (v[j].x * v[j].x + v[j].y * v[j].y) + (v[j].z * v[j].z + v[j].w * v[j].w); }
        const float rs = 1.0f / sqrtf(wave_sum(s) * (1.f / D) + NORM_EPS);
        float s2 = 0.f;
        GAS f32x4* xo = (GAS f32x4*)(xout + (size_t)m * D) + F.lane;
#pragma unroll
        for (int j = 0; j < 8; ++j) { const f32x4 g = ga[64 * j]; const f32x4 x = xr[64 * j];
            v[j].x = x.x + v[j].x * rs * g.x; v[j].y = x.y + v[j].y * rs * g.y; v[j].z = x.z + v[j].z * rs * g.z; v[j].w = x.w + v[j].w * rs * g.w;
            xo[64 * j] = v[j]; s2 += (v[j].x * v[j].x + v[j].y * v[j].y) + (v[j].z * v[j].z + v[j].w * v[j].w); }
        if (gB) {
            const float rs2 = 1.0f / sqrtf(wave_sum(s2) * (1.f / D) + NORM_EPS);
            const GAS f32x4* gb = (const GAS f32x4*)gB + F.lane; GAS v2u* o8 = (GAS v2u*)(hn + (size_t)m * D) + F.lane;
#pragma unroll
            for (int j = 0; j < 8; ++j) { const f32x4 g = gb[64 * j]; v2u w; w.x = pk2(v[j].x * rs2 * g.x, v[j].y * rs2 * g.y); w.y = pk2(v[j].z * rs2 * g.z, v[j].w * rs2 * g.w); o8[64 * j] = w; }
        }
    }
}
__device__ __forceinline__ float sigmoidf_(float x) { return 1.0f / (1.0f + __expf(-x)); }
__device__ __forceinline__ float softplusf_(float x) { return fmaxf(x, 0.f) + log1pf(__expf(-fabsf(x))); }

__device__ __forceinline__ void prep_rwkv_unit(Frame& F, int L, int unit) {
    const bf16* Z = (const bf16*)(F.ws + WS_Z);
    LAS float* xl = (LAS float*)F.lds;
    const int t0 = unit * 16, tid = F.tid;
    const float* mu = INP(I_MU) + (size_t)L * NSHIFT;
    __syncthreads();
    for (int e = tid; e < 288 * 16; e += NTHR) {
        const int j = e >> 4, tt = e & 15, t = t0 + tt, s = t & (SEQ - 1);
        float f = 0.f;
        if (j < 256 || L > 0) {
            const int col = (j < 256) ? (3072 + j) : (ZVD + (j - 256));
            const float m_ = (j < 256) ? mu[col] : INP(I_MUV)[(size_t)(L - 1) * 32 + (j - 256)];
            const float zc = bf2f(Z[(size_t)t * NZ + col]); const float zp = s ? bf2f(Z[(size_t)(t - 1) * NZ + col]) : 0.f;
            const float zs = zc + (zp - zc) * m_;
            f = (j < 64) ? tanhf(zs) : ((j < 128) ? zs : ((j < 256) ? sigmoidf_(zs) : zs));
        }
        xl[j * 16 + tt] = f;
    }
    __syncthreads();
    const float* w0 = INP(I_W0) + (size_t)L * C; const float* w2 = INP(I_W2) + (size_t)L * 64 * C;
    const float* a0 = INP(I_A0) + (size_t)L * C; const float* a2 = INP(I_A2) + (size_t)L * 64 * C;
    const float* g2 = INP(I_G2) + (size_t)L * 128 * C;
    const float* v0 = INP(I_V0) + (size_t)(L > 0 ? L - 1 : 0) * C; const float* v2 = INP(I_V2) + (size_t)(L > 0 ? L - 1 : 0) * 32 * C;
    const float* kkw = INP(I_KK) + (size_t)L * C; const float* kaw = INP(I_KA) + (size_t)L * C;
    bf16* SR = (bf16*)(F.ws + WS_SR); bf16* SK = (bf16*)(F.ws + WS_SK); bf16* SV = (bf16*)(F.ws + WS_SV); bf16* SKK = (bf16*)(F.ws + WS_SKK); bf16* SA = (bf16*)(F.ws + WS_SA);
    float* SW = (float*)(F.ws + WS_SW); bf16* SG = (bf16*)(F.ws + WS_SG); float* VF = (float*)(F.ws + WS_VF);
    for (int cc = 0; cc < 2; ++cc) {
        const int c = tid + 512 * cc;
        float dec[16], av[16], gv[16], sv[16];
        {   float acc[16];
#pragma unroll
            for (int tt = 0; tt < 16; ++tt) acc[tt] = w0[c];
            for (int j = 0; j < 64; ++j) { const float wv = w2[(size_t)j * C + c]; const LAS f32x4* xp = (const LAS f32x4*)(xl + j * 16);
#pragma unroll
                for (int q = 0; q < 4; ++q) { const f32x4 x = xp[q]; acc[4 * q] += x.x * wv; acc[4 * q + 1] += x.y * wv; acc[4 * q + 2] += x.z * wv; acc[4 * q + 3] += x.w * wv; } }
#pragma unroll
            for (int tt = 0; tt < 16; ++tt) { const float wl = -softplusf_(-acc[tt]) - 0.5f; dec[tt] = __expf(-__expf(wl)); }
        }
        {   float acc[16];
#pragma unroll
            for (int tt = 0; tt < 16; ++tt) acc[tt] = a0[c];
            for (int j = 0; j < 64; ++j) { const float wv = a2[(size_t)j * C + c]; const LAS f32x4* xp = (const LAS f32x4*)(xl + (64 + j) * 16);
#pragma unroll
                for (int q = 0; q < 4; ++q) { const f32x4 x = xp[q]; acc[4 * q] += x.x * wv; acc[4 * q + 1] += x.y * wv; acc[4 * q + 2] += x.z * wv; acc[4 * q + 3] += x.w * wv; } }
#pragma unroll
            for (int tt = 0; tt < 16; ++tt) av[tt] = sigmoidf_(acc[tt]);
        }
        {   float acc[16];
#pragma unroll
            for (int tt = 0; tt < 16; ++tt) acc[tt] = 0.f;
            for (int j = 0; j < 128; ++j) { const float wv = g2[(size_t)j * C + c]; const LAS f32x4* xp = (const LAS f32x4*)(xl + (128 + j) * 16);
#pragma unroll
                for (int q = 0; q < 4; ++q) { const f32x4 x = xp[q]; acc[4 * q] += x.x * wv; acc[4 * q + 1] += x.y * wv; acc[4 * q + 2] += x.z * wv; acc[4 * q + 3] += x.w * wv; } }
#pragma unroll
            for (int tt = 0; tt < 16; ++tt) gv[tt] = acc[tt];
        }
        if (L > 0) {   float acc[16];
#pragma unroll
            for (int tt = 0; tt < 16; ++tt) acc[tt] = v0[c];
            for (int j = 0; j < 32; ++j) { const float wv = v2[(size_t)j * C + c]; const LAS f32x4* xp = (const LAS f32x4*)(xl + (256 + j) * 16);
#pragma unroll
                for (int q = 0; q < 4; ++q) { const f32x4 x = xp[q]; acc[4 * q] += x.x * wv; acc[4 * q + 1] += x.y * wv; acc[4 * q + 2] += x.z * wv; acc[4 * q + 3] += x.w * wv; } }
#pragma unroll
            for (int tt = 0; tt < 16; ++tt) sv[tt] = sigmoidf_(acc[tt]);
        } else {
#pragma unroll
            for (int tt = 0; tt < 16; ++tt) sv[tt] = 0.f;
        }
        const float mur = mu[c], muk = mu[C + c], muv = mu[2 * C + c], kkc = kkw[c], kac = kaw[c];
        float zpr, zpk, zpv;
        { const int s0 = t0 & (SEQ - 1);
          if (s0) { const bf16* zp = Z + (size_t)(t0 - 1) * NZ; zpr = bf2f(zp[c]); zpk = bf2f(zp[C + c]); zpv = bf2f(zp[2 * C + c]); } else { zpr = zpk = zpv = 0.f; } }
#pragma unroll
        for (int tt = 0; tt < 16; ++tt) {
            const int t = t0 + tt; const bf16* zc = Z + (size_t)t * NZ;
            const float zr = bf2f(zc[c]), zk = bf2f(zc[C + c]), zv = bf2f(zc[2 * C + c]);
            const float r = zr + (zpr - zr) * mur, k = zk + (zpk - zk) * muk; float v = zv + (zpv - zv) * muv;
            zpr = zr; zpk = zk; zpv = zv;
            const size_t o = (size_t)t * C + c;
            if (L == 0) VF[o] = v; else v = v + (VF[o] - v) * sv[tt];
            float kk = k * kkc; const float ss = wave_sum(kk * kk); kk = kk / fmaxf(sqrtf(ss), 1e-12f);
            const float k2 = k * (1.f + (av[tt] - 1.f) * kac);
            SR[o] = (bf16)f2bf(r); SK[o] = (bf16)f2bf(k2); SV[o] = (bf16)f2bf(v); SKK[o] = (bf16)f2bf(kk); SA[o] = (bf16)f2bf(av[tt]); SW[o] = dec[tt]; SG[o] = (bf16)f2bf(gv[tt]);
        }
    }
}
__device__ __forceinline__ void prep_attn_unit(Frame& F, int u) {
    const bf16* Z = (const bf16*)(F.ws + WS_Z);
    bf16* AQ = (bf16*)(F.ws + WS_AQ); bf16* AKp = (bf16*)(F.ws + WS_AK); bf16* AVT = (bf16*)(F.ws + WS_AVT); float* KM = (float*)(F.ws + WS_KM);
    const int b = u / (NBLK * AH), rem = u % (NBLK * AH), blk = rem / AH, h = rem % AH;
    const int tid = F.tid, d = tid & 63, tw = tid >> 6;
    const int tb = b * SEQ + blk * MB;
    LAS float* red = (LAS float*)F.lds;
    LAS bf16* vt = (LAS bf16*)(F.lds + 4096);
    __syncthreads();
    const float inv_freq = exp2f(-(float)d * (13.287712379549449f / 64.0f));
    float ks0 = 0.f, ks1 = 0.f;
    for (int i = 0; i < 32; ++i) {
        const int tok = tw + 8 * i; const int s = blk * MB + tok; const size_t t = (size_t)(tb + tok);
        float sn, cs; sincosf((float)s * inv_freq, &sn, &cs);
        const bf16* zq = Z + t * NZ + ZQ + h * AD; const bf16* zk = Z + t * NZ + ZK + h * AD;
        const float q1 = bf2f(zq[d]), q2 = bf2f(zq[d + 64]), k1 = bf2f(zk[d]), k2 = bf2f(zk[d + 64]);
        const float q1r = q1 * cs - q2 * sn, q2r = q2 * cs + q1 * sn, k1r = k1 * cs - k2 * sn, k2r = k2 * cs + k1 * sn;
        AQ[t * C + h * AD + d] = (bf16)f2bf(q1r); AQ[t * C + h * AD + 64 + d] = (bf16)f2bf(q2r);
        AKp[t * C + h * AD + d] = (bf16)f2bf(k1r); AKp[t * C + h * AD + 64 + d] = (bf16)f2bf(k2r);
        ks0 += k1r; ks1 += k2r;
    }
    red[tw * 128 + d] = ks0; red[tw * 128 + 64 + d] = ks1;
    for (int i = 0; i < 64; ++i) { const int idx = tid + NTHR * i; const int tok = idx >> 7, dd = idx & 127;
        vt[dd * 264 + tok] = Z[(size_t)(tb + tok) * NZ + ZV + h * AD + dd]; }
    __syncthreads();
    if (tid < 128) { float s = 0.f;
#pragma unroll
        for (int w = 0; w < 8; ++w) s += red[w * 128 + tid];
        KM[((size_t)(b * AH + h) * NBLK + blk) * AD + tid] = s * (1.0f / MB); }
    for (int i = 0; i < 8; ++i) { const int idx = tid + NTHR * i; const int dd = idx >> 5, ch = idx & 31;
        const v4u v = *(const LAS v4u*)(vt + dd * 264 + ch * 8);
        *(GAS v4u*)(AVT + ((size_t)(b * AH + h) * AD + dd) * SEQ + blk * MB + ch * 8) = v; }
}
__device__ __forceinline__ void ph_prep(Frame& F, int L) {
    for (int u = F.vcu; u < T / 16 + BATCH * NBLK * AH; u += F.G) {
        if (u < T / 16) prep_rwkv_unit(F, L, u); else prep_attn_unit(F, u - T / 16);
    }
}

__device__ __forceinline__ float dpp_f(float v, int) { return v; }
#define DPP_ADD(v, ctrl) ((v) + __builtin_bit_cast(float, __builtin_amdgcn_update_dpp(0, __builtin_bit_cast(int, (v)), (ctrl), 0xF, 0xF, true)))
__device__ __forceinline__ float red8(float v) {
    v = DPP_ADD(v, 0xB1);
    v = DPP_ADD(v, 0x4E);
    v = DPP_ADD(v, 0x141);
    return v;
}
__device__ __forceinline__ void scan_unit(Frame& F, int bh) {
    const int b = bh / NH, h = bh % NH, tid = F.tid, lane = F.lane, wv = F.wave;
    const bf16* SR = (const bf16*)(F.ws + WS_SR); const bf16* SK = (const bf16*)(F.ws + WS_SK); const bf16* SV = (const bf16*)(F.ws + WS_SV);
    const bf16* SKK = (const bf16*)(F.ws + WS_SKK); const bf16* SA = (const bf16*)(F.ws + WS_SA); const float* SW = (const float*)(F.ws + WS_SW);
    float* YR = (float*)(F.ws + WS_HN);
    LAS float* buf = (LAS float*)F.lds;
    constexpr int ARR = 16 * 64, BUFSZ = 6 * ARR;
    const int i_row = 8 * wv + (lane >> 3), jq = lane & 7;
    float st[8];
#pragma unroll
    for (int e = 0; e < 8; ++e) st[e] = 0.f;
    const int ltt = tid >> 5, lch = 2 * (tid & 31);
    const size_t gbase = ((size_t)b * SEQ) * C + (size_t)h * HD + lch;
    unsigned pr, pk, pv, pkk, pa; float pw0, pw1;
#define SCAN_LOAD(cidx) do { const size_t o = gbase + (size_t)((cidx) * 16 + ltt) * C; \
        pr = *(const GAS unsigned*)(SR + o); pk = *(const GAS unsigned*)(SK + o); pv = *(const GAS unsigned*)(SV + o); pkk = *(const GAS unsigned*)(SKK + o); pa = *(const GAS unsigned*)(SA + o); \
        pw0 = SW[o]; pw1 = SW[o + 1]; } while (0)
#define SCAN_STORE(bi) do { LAS float* B_ = buf + (bi) * BUFSZ + ltt * 64 + lch; \
        B_[0] = bflo(pr); B_[1] = bfhi(pr); B_[ARR] = pw0; B_[ARR + 1] = pw1; B_[2 * ARR] = bflo(pk); B_[2 * ARR + 1] = bfhi(pk); \
        { const float k0_ = bflo(pkk), k1_ = bfhi(pkk); B_[3 * ARR] = -k0_; B_[3 * ARR + 1] = -k1_; B_[4 * ARR] = k0_ * bflo(pa); B_[4 * ARR + 1] = k1_ * bfhi(pa); } \
        B_[5 * ARR] = bflo(pv); B_[5 * ARR + 1] = bfhi(pv); } while (0)
    __syncthreads();
    SCAN_LOAD(0); SCAN_STORE(0);
    __syncthreads();
    constexpr int NCH = SEQ / 16;
    for (int ci = 0; ci < NCH; ++ci) {
        if (ci + 1 < NCH) SCAN_LOAD(ci + 1);
        const LAS float* Bc = buf + (ci & 1) * BUFSZ;
#pragma unroll 4
        for (int tt = 0; tt < 16; ++tt) {
            const LAS f32x4* pr_ = (const LAS f32x4*)(Bc + tt * 64 + 8 * jq);
            const f32x4 r0 = pr_[0], r1 = pr_[1];
            const f32x4 w0 = pr_[ARR / 4], w1 = pr_[ARR / 4 + 1];
            const f32x4 k0 = pr_[2 * ARR / 4], k1 = pr_[2 * ARR / 4 + 1];
            const f32x4 a0 = pr_[3 * ARR / 4], a1 = pr_[3 * ARR / 4 + 1];
            const f32x4 b0 = pr_[4 * ARR / 4], b1 = pr_[4 * ARR / 4 + 1];
            const float vi = Bc[5 * ARR + tt * 64 + i_row];
            float sa = st[0] * a0.x + st[1] * a0.y + st[2] * a0.z + st[3] * a0.w + st[4] * a1.x + st[5] * a1.y + st[6] * a1.z + st[7] * a1.w;
            sa = red8(sa);
            st[0] = st[0] * w0.x + sa * b0.x + vi * k0.x; st[1] = st[1] * w0.y + sa * b0.y + vi * k0.y; st[2] = st[2] * w0.z + sa * b0.z + vi * k0.z; st[3] = st[3] * w0.w + sa * b0.w + vi * k0.w;
            st[4] = st[4] * w1.x + sa * b1.x + vi * k1.x; st[5] = st[5] * w1.y + sa * b1.y + vi * k1.y; st[6] = st[6] * w1.z + sa * b1.z + vi * k1.z; st[7] = st[7] * w1.w + sa * b1.w + vi * k1.w;
            float y = st[0] * r0.x + st[1] * r0.y + st[2] * r0.z + st[3] * r0.w + st[4] * r1.x + st[5] * r1.y + st[6] * r1.z + st[7] * r1.w;
            y = red8(y);
            if (jq == 0) YR[((size_t)b * SEQ + ci * 16 + tt) * C + h * HD + i_row] = y;
        }
        if (ci + 1 < NCH) SCAN_STORE((ci + 1) & 1);
        __syncthreads();
    }
#undef SCAN_LOAD
#undef SCAN_STORE
}
__device__ __forceinline__ void ph_post(Frame& F, int L) {
    const bf16* SR = (const bf16*)(F.ws + WS_SR); const bf16* SK = (const bf16*)(F.ws + WS_SK); const bf16* SV = (const bf16*)(F.ws + WS_SV); const bf16* SG = (const bf16*)(F.ws + WS_SG);
    const float* YR = (const float*)(F.ws + WS_HN); bf16* YC = (bf16*)(F.ws + WS_YC);
    const float* rk = INP(I_RK) + (size_t)L * C; const float* lg = INP(I_LNG) + (size_t)L * C; const float* lb = INP(I_LNB) + (size_t)L * C;
    const int gw = F.vcu * NWAVES + F.wave, NGW = F.G * NWAVES, lane = F.lane;
    for (int it = gw; it < T * NH; it += NGW) {
        const int t = it / NH, h = it % NH; const int c = h * HD + lane; const size_t o = (size_t)t * C + c;
        const float y = YR[o];
        const float mean = wave_sum(y) * (1.f / HD); const float dlt = y - mean; const float var = wave_sum(dlt * dlt) * (1.f / HD);
        const float yn = dlt * (1.0f / sqrtf(var + LNX_EPS)) * lg[c] + lb[c];
        const float r = bf2f(SR[o]), k = bf2f(SK[o]), v = bf2f(SV[o]), g = bf2f(SG[o]);
        const float bonus = wave_sum(r * k * rk[c]) * v;
        YC[(size_t)t * D + c] = (bf16)f2bf((yn + bonus) * g);
    }
}
__device__ __forceinline__ int crow(int r, int hi) { return (r & 3) + 8 * (r >> 2) + 4 * hi; }
__device__ __forceinline__ void attn_unit(Frame& F, int b, int h, int qb) {
    const bf16* AQ = (const bf16*)(F.ws + WS_AQ); const bf16* AKp = (const bf16*)(F.ws + WS_AK); const bf16* AVT = (const bf16*)(F.ws + WS_AVT); const float* KM = (const float*)(F.ws + WS_KM);
    bf16* YC = (bf16*)(F.ws + WS_YC);
    const int tid = F.tid, lane = F.lane, wid = F.wave, r32 = lane & 31, hi = lane >> 5;
    constexpr int KBUF = 64 * 256, VPITCH = 136, VBUF = 128 * VPITCH;
    LAS unsigned char* kbuf = F.lds;
    LAS unsigned char* vbuf = F.lds + 2 * KBUF;
    LAS float* kmL = (LAS float*)(F.lds + 2 * KBUF + 2 * VBUF);
    const size_t tb = (size_t)b * SEQ; const int q0 = qb * MB + wid * 32;
    __syncthreads();
    for (int i = tid; i < NBLK * AD; i += NTHR) kmL[i] = KM[(size_t)(b * AH + h) * NBLK * AD + i];
    bf16x8 qr[8];
    { const bf16* Qp = AQ + (tb + q0 + r32) * C + h * AD + hi * 8;
#pragma unroll
      for (int d0 = 0; d0 < 8; ++d0) qr[d0] = *(const GAS bf16x8*)(Qp + d0 * 16); }
    __syncthreads();
    unsigned selmask;
    {
        float g1 = -INFINITY, g2 = -INFINITY, g3 = -INFINITY; int i1 = 0, i2 = 0, i3 = 0;
        for (int n = 0; n < qb; ++n) {
            float acc = 0.f;
#pragma unroll
            for (int d0 = 0; d0 < 8; ++d0) { const LAS f32x4* kp = (const LAS f32x4*)(kmL + n * AD + d0 * 16 + hi * 8); const f32x4 ka = kp[0], kb = kp[1];
                const bf16x8 q = qr[d0];
                acc += bf2f((unsigned short)q[0]) * ka.x + bf2f((unsigned short)q[1]) * ka.y + bf2f((unsigned short)q[2]) * ka.z + bf2f((unsigned short)q[3]) * ka.w
                     + bf2f((unsigned short)q[4]) * kb.x + bf2f((unsigned short)q[5]) * kb.y + bf2f((unsigned short)q[6]) * kb.z + bf2f((unsigned short)q[7]) * kb.w; }
            const float g = acc + __shfl_xor(acc, 32);
            if (g > g1) { g3 = g2; i3 = i2; g2 = g1; i2 = i1; g1 = g; i1 = n; }
            else if (g > g2) { g3 = g2; i3 = i2; g2 = g; i2 = n; }
            else if (g > g3) { g3 = g; i3 = n; }
        }
        selmask = (qb <= 3) ? ((1u << qb) - 1u) : ((1u << i1) | (1u << i2) | (1u << i3));
    }
    const int NT = 4 * (qb + 1);
    v4u kreg[2], vreg[2];
    const bf16* Kg = AKp + tb * C + h * AD; const bf16* Vg = AVT + (size_t)(b * AH + h) * AD * SEQ;
#define TILE_KS(ti) (((ti) < 4) ? (qb * MB + 64 * (ti)) : ((((ti) - 4) >> 2) * MB + 64 * (((ti) - 4) & 3)))
#define ATT_LOAD(ti) do { const int ks_ = TILE_KS(ti); _Pragma("unroll") for (int i_ = 0; i_ < 2; ++i_) { const int idx_ = tid + NTHR * i_; \
        kreg[i_] = *(const GAS v4u*)(Kg + (size_t)(ks_ + (idx_ >> 4)) * C + (idx_ & 15) * 8); \
        vreg[i_] = *(const GAS v4u*)(Vg + (size_t)(idx_ >> 3) * SEQ + ks_ + (idx_ & 7) * 8); } } while (0)
#define ATT_STORE(bi) do { _Pragma("unroll") for (int i_ = 0; i_ < 2; ++i_) { const int idx_ = tid + NTHR * i_; const int row_ = idx_ >> 4, c_ = idx_ & 15; \
        *(LAS v4u*)(kbuf + (bi) * KBUF + row_ * 256 + ((c_ ^ (row_ & 15)) << 4)) = kreg[i_]; \
        LAS v2u* vd_ = (LAS v2u*)(vbuf + (bi) * VBUF + (idx_ >> 3) * VPITCH + (idx_ & 7) * 16); vd_[0] = (v2u){vreg[i_].x, vreg[i_].y}; vd_[1] = (v2u){vreg[i_].z, vreg[i_].w}; } } while (0)
    f32x16 O[4];
#pragma unroll
    for (int dt = 0; dt < 4; ++dt) O[dt] = (f32x16){0.f};
    float m_run = -1e30f, l_run = 0.f;
    const float SC = 0.08838834764831845f * 1.4426950408889634f;
    ATT_LOAD(0); ATT_STORE(0);
    __syncthreads();
    const int qpos = q0 + r32;
    for (int ti = 0; ti < NT; ++ti) {
        if (ti + 1 < NT) ATT_LOAD(ti + 1);
        const LAS unsigned char* kb_ = kbuf + (ti & 1) * KBUF; const LAS unsigned char* vb_ = vbuf + (ti & 1) * VBUF;
        const int ks = TILE_KS(ti);
        f32x16 p[2];
#pragma unroll
        for (int kb2 = 0; kb2 < 2; ++kb2) {
            f32x16 acc = (f32x16){0.f};
            const int row = 32 * kb2 + r32;
#pragma unroll
            for (int d0 = 0; d0 < 8; ++d0) {
                const bf16x8 kf = *(const LAS bf16x8*)(kb_ + row * 256 + (((2 * d0 + hi) ^ (row & 15)) << 4));
                acc = __builtin_amdgcn_mfma_f32_32x32x16_bf16(kf, qr[d0], acc, 0, 0, 0);
            }
            p[kb2] = acc;
        }
        const bool own = ti < 4;
        const bool lane_ok = own || ((selmask >> ((ti - 4) >> 2)) & 1u);
        float mx = -1e30f;
#pragma unroll
        for (int kb2 = 0; kb2 < 2; ++kb2)
#pragma unroll
            for (int r = 0; r < 16; ++r) {
                float s = p[kb2][r] * SC;
                const int kpos = ks + 32 * kb2 + crow(r, hi);
                const bool ok = own ? (kpos <= qpos) : lane_ok;
                s = ok ? s : -1e30f; p[kb2][r] = s; mx = fmaxf(mx, s);
            }
        mx = fmaxf(mx, __shfl_xor(mx, 32));
        const float m_new = fmaxf(m_run, mx);
        const float alpha = exp2f(m_run - m_new);
        m_run = m_new;
        float ls = 0.f;
#pragma unroll
        for (int kb2 = 0; kb2 < 2; ++kb2)
#pragma unroll
            for (int r = 0; r < 16; ++r) { const float e = exp2f(p[kb2][r] - m_new); p[kb2][r] = e; ls += e; }
        l_run = l_run * alpha + ls;
#pragma unroll
        for (int dt = 0; dt < 4; ++dt)
#pragma unroll
            for (int r = 0; r < 16; ++r) O[dt][r] *= alpha;
#pragma unroll
        for (int kb2 = 0; kb2 < 2; ++kb2)
#pragma unroll
            for (int s = 0; s < 2; ++s) {
                v4u pw; pw.x = pk2(p[kb2][8 * s + 0], p[kb2][8 * s + 1]); pw.y = pk2(p[kb2][8 * s + 2], p[kb2][8 * s + 3]); pw.z = pk2(p[kb2][8 * s + 4], p[kb2][8 * s + 5]); pw.w = pk2(p[kb2][8 * s + 6], p[kb2][8 * s + 7]);
                const bf16x8 pf = __builtin_bit_cast(bf16x8, pw);
                const int key0 = 32 * kb2 + 16 * s + 4 * hi;
#pragma unroll
                for (int dt = 0; dt < 4; ++dt) {
                    const LAS unsigned char* vp = vb_ + (32 * dt + r32) * VPITCH + key0 * 2;
                    const v2u lo = *(const LAS v2u*)vp, hi2 = *(const LAS v2u*)(vp + 16);
                    const v4u vw = (v4u){lo.x, lo.y, hi2.x, hi2.y};
                    O[dt] = __builtin_amdgcn_mfma_f32_32x32x16_bf16(__builtin_bit_cast(bf16x8, vw), pf, O[dt], 0, 0, 0);
                }
            }
        if (ti + 1 < NT) ATT_STORE((ti + 1) & 1);
        __syncthreads();
    }
    const float l_tot = l_run + __shfl_xor(l_run, 32);
    const float inv = 1.0f / l_tot;
    bf16* yo = YC + (tb + q0 + r32) * D + C + h * AD;
#pragma unroll
    for (int dt = 0; dt < 4; ++dt)
#pragma unroll
        for (int rq = 0; rq < 4; ++rq) {
            v2u w; w.x = pk2(O[dt][4 * rq] * inv, O[dt][4 * rq + 1] * inv); w.y = pk2(O[dt][4 * rq + 2] * inv, O[dt][4 * rq + 3] * inv);
            *(GAS v2u*)(yo + 32 * dt + 8 * rq + 4 * hi) = w;
        }
#undef TILE_KS
#undef ATT_LOAD
#undef ATT_STORE
}
__device__ __forceinline__ void ph_mixer(Frame& F, int L) {
    constexpr int NSC = BATCH * NH, NAT = BATCH * AH * NBLK;
    if (F.G >= 64) {
        if (F.vcu < NSC) { for (int u = F.vcu; u < NSC; u += NSC) scan_unit(F, u); }
        else { const int na = F.G - NSC; for (int au = F.vcu - NSC; au < NAT; au += na) { const int qb = NBLK - 1 - au / (BATCH * AH), bh = au % (BATCH * AH); attn_unit(F, bh / AH, bh % AH, qb); } }
    } else {
        for (int u = F.vcu; u < NSC; u += F.G) scan_unit(F, u);
        for (int au = F.vcu; au < NAT; au += F.G) { const int qb = NBLK - 1 - au / (BATCH * AH), bh = au % (BATCH * AH); attn_unit(F, bh / AH, bh % AH, qb); }
    }
}

constexpr int PH_PER_LAYER = 10, NPHASE = DEPTH * PH_PER_LAYER;
#ifndef MK_N_LAUNCHES
#define MK_N_LAUNCHES NPHASE
#endif
struct Args { const float* in[24]; float* out; unsigned char* ws; int ph_lo, ph_hi, li, pad; };
__global__ void __launch_bounds__(NTHR, 2) mega_fwd(Args args) {
    extern __shared__ __attribute__((aligned(16))) unsigned char lds[];
    Frame F;
    F.lds = (LAS unsigned char*)lds;
    F.MISC = (volatile LAS unsigned*)(F.lds + MISC_OFF);
    F.tid = threadIdx.x; F.lane = F.tid & 63; F.wave = __builtin_amdgcn_readfirstlane(F.tid >> 6);
    F.G = gridDim.x; { const int bx = blockIdx.x; F.vcu = (F.G % 8 == 0) ? (bx % 8) * (F.G / 8) + bx / 8 : bx; }
    F.ws = args.ws; F.out = args.out; F.ctl = (gu32*)(args.ws + WS_CTL);
    for (int u = F.tid; u < (LDS_BYTES - LDSCTL_OFF) / 4; u += NTHR) ((LAS unsigned*)(F.lds + LDSCTL_OFF))[u] = 0u;
    __syncthreads();
    if (F.tid < 24) *(LAS unsigned long long*)(F.lds + PTAB_OFF + 8 * F.tid) = (unsigned long long)args.in[F.tid];
    __syncthreads();
    XcdBarrier bar; bar.bar = (unsigned*)(F.ctl + CW_BAR) + args.li * XCD_BAR_WORDS; bar.x = 0; bar.st = nullptr;
    const bool one_launch = (args.ph_hi - args.ph_lo) > 1;
    if (one_launch) bar = xcd_barrier_post((unsigned*)(F.ctl + CW_BAR) + args.li * XCD_BAR_WORDS, F.MISC + 8);
    bf16* HN = (bf16*)(F.ws + WS_HN); bf16* YC = (bf16*)(F.ws + WS_YC); bf16* Zb = (bf16*)(F.ws + WS_Z); bf16* U = (bf16*)(F.ws + WS_U);
    float* Y2 = (float*)(F.ws + WS_Y2); float* Mo = (float*)(F.ws + WS_M);
    for (int ph = args.ph_lo; ph < args.ph_hi; ++ph) {
        const int L = ph / PH_PER_LAYER, p = ph % PH_PER_LAYER;
        { int t_ = threadIdx.x; asm volatile("" : "+v"(t_)); F.tid = t_; F.lane = t_ & 63; F.wave = __builtin_amdgcn_readfirstlane(t_ >> 6); }
        switch (p) {
        case 0: ph_convert(F, L); break;
        case 1: { pg8::Gemm g{HN, (const bf16*)(F.ws + WS_WIN), T, (L == 0) ? NIN : NZ, D}; pg8::StaticOrder S; S.init(T, (L == 0) ? NIN : NZ, F.G, (int)blockIdx.x);
                  pg8::EpiBf16<0> E{Zb, NZ}; pg8::gemm_phase<pg8::EpiBf16<0>, pg8::StaticOrder, true, true>(F.lds, g, S, E, F.tid); } break;
        case 2: ph_prep(F, L); break;
        case 3: ph_mixer(F, L); break;
        case 4: ph_post(F, L); break;
        case 5: { pg8::Gemm g{YC, (const bf16*)(F.ws + WS_WOUT), T, D, D}; pg8::StaticOrder S; S.init(T, D, F.G, (int)blockIdx.x);
                  pg8::EpiF32 E{Y2, D}; pg8::gemm_phase<pg8::EpiF32, pg8::StaticOrder, true, true>(F.lds, g, S, E, F.tid); } break;
        case 6: ph_resnorm(F, Y2, (L == 0) ? INP(I_X) : F.out, INP(I_NMIXPOST) + (size_t)L * D, INP(I_NMLPPRE) + (size_t)L * D, F.out, HN); break;
        case 7: { pg8::Gemm g{HN, (const bf16*)(F.ws + WS_WUP), T, FF, D}; pg8::StaticOrder S; S.init(T, FF, F.G, (int)blockIdx.x);
                  pg8::EpiBf16<2> E{U, FF}; pg8::gemm_phase<pg8::EpiBf16<2>, pg8::StaticOrder, true, true>(F.lds, g, S, E, F.tid); } break;
        case 8: { pg8::Gemm g{U, (const bf16*)(F.ws + WS_WDN), T, D, FF}; pg8::StaticOrder S; S.init(T, D, F.G, (int)blockIdx.x);
                  pg8::EpiF32 E{Mo, D}; pg8::gemm_phase<pg8::EpiF32, pg8::StaticOrder, true, true>(F.lds, g, S, E, F.tid); } break;
        case 9: ph_resnorm(F, Mo, F.out, INP(I_NMLPPOST) + (size_t)L * D, (L + 1 < DEPTH) ? INP(I_NMIXPRE) + (size_t)(L + 1) * D : nullptr, F.out, HN); break;
        }
        if (ph + 1 < args.ph_hi) xcd_barrier(bar);
    }
}

extern "C" void kernel_launch(void* const* d_in, const int* in_sizes, int n_in, void* d_out, int out_size, void* d_ws, size_t ws_size, hipStream_t stream) {
    static int grid = 0;
    if (grid == 0) {
        if (n_in != 24 || in_sizes[0] != T * D || out_size != T * D || ws_size < WS_END) { fprintf(stderr, "kernel_launch: unexpected shapes (n_in %d, in0 %d, out %d, ws %zu)\n", n_in, n_in > 0 ? in_sizes[0] : -1, out_size, ws_size); grid = -1; return; }
        int dev = 0, cus = 0, per_cu = 0;
        if (hipGetDevice(&dev) != hipSuccess || hipDeviceGetAttribute(&cus, hipDeviceAttributeMultiprocessorCount, dev) != hipSuccess) { grid = -1; return; }
        if (hipFuncSetAttribute((const void*)mega_fwd, hipFuncAttributeMaxDynamicSharedMemorySize, LDS_BYTES) != hipSuccess) { fprintf(stderr, "kernel_launch: hipFuncSetAttribute failed\n"); grid = -1; return; }
        if (hipOccupancyMaxActiveBlocksPerMultiprocessor(&per_cu, (const void*)mega_fwd, NTHR, LDS_BYTES) != hipSuccess || per_cu < 1) { fprintf(stderr, "kernel_launch: occupancy query says %d\n", per_cu); per_cu = 1; }
        (void)hipGetLastError();
        grid = cus * (per_cu > 1 ? 1 : per_cu);
    }
    if (grid < 0) return;
    (void)hipMemsetAsync((char*)d_ws + WS_CTL, 0, CTL_ZERO_BYTES, stream);
    Args a{};
    for (int i = 0; i < 24; ++i) a.in[i] = (const float*)d_in[i];
    a.out = (float*)d_out; a.ws = (unsigned char*)d_ws;
    const int nl = MK_N_LAUNCHES;
    for (int li = 0; li < nl; ++li) {
        a.li = li; a.ph_lo = (int)((long)NPHASE * li / nl); a.ph_hi = (int)((long)NPHASE * (li + 1) / nl);
        if (a.ph_hi - a.ph_lo > 1) {
            void* kargs[] = {&a};
            hipError_t e = hipLaunchCooperativeKernel((const void*)mega_fwd, dim3(grid), dim3(NTHR), kargs, LDS_BYTES, stream);
            if (e != hipSuccess) fprintf(stderr, "kernel_launch: cooperative launch failed: %s (grid %d)\n", hipGetErrorString(e), grid);
        } else {
            hipLaunchKernelGGL(mega_fwd, dim3(grid), dim3(NTHR), LDS_BYTES, stream, a);
        }
    }
}
```

```cpp
#include <hip/hip_runtime.h>
#include <cstdio>
#include <cstdint>
namespace pg8 {
#define PG8_LAS __attribute__((address_space(3)))
typedef unsigned short bf16_t;
typedef short bf16x8 __attribute__((ext_vector_type(8)));
typedef float f32x4 __attribute__((ext_vector_type(4)));
typedef unsigned u32x4 __attribute__((ext_vector_type(4)));
constexpr int BM = 256, BK = 64, HALF = 128, HTB = HALF * BK * 2  , STAGE_BYTES = 8 * HTB, NXCD = 8, WGM = 8;

__host__ __device__ __forceinline__ int lds_byte(int r, int c) { const int st = (r >> 4) * 2 + (c >> 5), rr = r & 15, cc = c & 31, ob = rr * 64 + cc * 2; return st * 1024 + (ob ^ (((ob >> 9) & 1) << 5)); }
__host__ __device__ __forceinline__ void stage_rc(int b, int& R, int& C) { const int st = b / 1024, sb = b % 1024, swz = sb ^ (((sb >> 9) & 1) << 5); R = (st >> 1) * 16 + swz / 64; C = (st & 1) * 32 + (swz % 64) / 2; }
__host__ __device__ __forceinline__ int perm32(int rho) { const int n = rho >> 4, i = rho & 15; return 8 * (i >> 2) + 4 * n + (i & 3); }

struct Unit { int pm, pn; };
struct Gemm { const bf16_t* A; const bf16_t* Bt; int M, N, K; };

struct StaticOrder {
    int nM, nN, nwg, G, c;
    __host__ __device__ void init(int M, int N, int G_, int c_) { nM = M / BM; nN = N / BM; nwg = nM * nN; G = G_; c = c_; }
    __host__ __device__ bool next(int i, Unit& u) const {
        const long L = (long)i * G + c; if (L >= nwg) return false;
        int wgid = (int)L; { const int q = nwg / NXCD, r = nwg % NXCD, xcd = wgid % NXCD, off = wgid / NXCD; wgid = (xcd < r ? xcd * (q + 1) : r * (q + 1) + (xcd - r) * q) + off; }
        const int nig = WGM * nN, gid = wgid / nig, fm = gid * WGM, gsz = (nM - fm) < WGM ? (nM - fm) : WGM;
        u.pm = fm + ((wgid % nig) % gsz); u.pn = (wgid % nig) / gsz; return true;
    }
    __device__ __forceinline__ void a_ready(const Unit&) const {}
    __device__ __forceinline__ void done(const Unit&) const {}
};

__device__ __forceinline__ unsigned cvt_pk_bf16(float lo, float hi) { unsigned r; asm volatile("v_cvt_pk_bf16_f32 %0, %1, %2" : "=v"(r) : "v"(lo), "v"(hi)); return r; }
struct EpiF32 {
    static constexpr bool PERM = false, AFTER_DRAIN = false;
    float* C; int ldc;
    __device__ __forceinline__ void operator()(const f32x4 (&acc)[2][2][4][2], const Unit& u, int wr, int wc, int fr, int fq) const {
        const int row0 = u.pm * BM + wr * 64 + fr, col0 = u.pn * BM + wc * 32 + 4 * fq;
#pragma unroll
        for (int ai = 0; ai < 2; ++ai)
#pragma unroll
            for (int m = 0; m < 4; ++m) { float* rowp = C + (size_t)(row0 + ai * HALF + m * 16) * ldc + col0;
#pragma unroll
                for (int bj = 0; bj < 2; ++bj)
#pragma unroll
                    for (int n = 0; n < 2; ++n) *(f32x4*)(rowp + bj * HALF + n * 16) = acc[ai][bj][m][n]; }
    }
};
template <int ACT  > struct EpiBf16 {
    static constexpr bool PERM = true, AFTER_DRAIN = false;
    bf16_t* O; int ldc;
    __device__ __forceinline__ void operator()(const f32x4 (&acc)[2][2][4][2], const Unit& u, int wr, int wc, int fr, int fq) const {
        const int row0 = u.pm * BM + wr * 64 + fr; const int col0 = u.pn * BM + wc * 32 + 8 * fq;
#pragma unroll
        for (int ai = 0; ai < 2; ++ai)
#pragma unroll
            for (int m = 0; m < 4; ++m) { bf16_t* rowp = O + (size_t)(row0 + ai * HALF + m * 16) * ldc + col0;
#pragma unroll
                for (int bj = 0; bj < 2; ++bj) { f32x4 v0 = acc[ai][bj][m][0], v1 = acc[ai][bj][m][1];
                    if (ACT == 2) {
#pragma unroll
                        for (int e = 0; e < 4; ++e) { float a = v0[e] > 0.f ? v0[e] : 0.f; v0[e] = a * a; float b = v1[e] > 0.f ? v1[e] : 0.f; v1[e] = b * b; } }
                    u32x4 w; w.x = cvt_pk_bf16(v0[0], v0[1]); w.y = cvt_pk_bf16(v0[2], v0[3]); w.z = cvt_pk_bf16(v1[0], v1[1]); w.w = cvt_pk_bf16(v1[2], v1[3]);
                    *(u32x4*)(rowp + bj * HALF) = w; } }
    }
};

template <class Epi, class Sched, bool ALIGN_EPI = false, bool SP2 = false>
__device__ __forceinline__ void gemm_phase(PG8_LAS unsigned char* lds, const Gemm g, const Sched& S, const Epi& E, const int tid) {
    const int wid = __builtin_amdgcn_readfirstlane(tid >> 6), lane = tid & 63, wr = wid >> 2, wc = wid & 3, fr = lane & 15, fq = lane >> 4;
    const int K = g.K, nt = K / BK;
    unsigned voffA[2], voffB[2];
#pragma unroll
    for (int i = 0; i < 2; ++i) { int R, C; stage_rc(tid * 16 + i * 8192, R, C); const int Rb = Epi::PERM ? ((R & ~31) + perm32(R & 31)) : R;
        voffA[i] = (unsigned)(R * K + C) * 2u; voffB[i] = (unsigned)(Rb * K + C) * 2u; }
    const size_t kstep = (size_t)(BK * 2);
    const size_t hstep = (size_t)HALF * K * 2;
    const size_t tstep = 2 * hstep;
    const unsigned ldsw = (unsigned)wid * 1024u;
    const int aoff = lds_byte(wr * 64 + fr, fq * 8), boff = lds_byte(wc * 32 + fr, fq * 8);
#define PG8_SA(b, h) (((b) * 2 + (h)) * HTB)
#define PG8_SB(b, h) ((4 + (b) * 2 + (h)) * HTB)
#define PG8_STAGE(bufoff, gbase, voff) do { _Pragma("unroll") for (int _i = 0; _i < 2; ++_i) \
        __builtin_amdgcn_global_load_lds((const unsigned*)((const char*)(gbase) + (voff)[_i]), (PG8_LAS unsigned*)(lds + (bufoff) + ldsw + _i * 8192), 16, 0, 0); } while (0)
#define PG8_LDA(dst, b, h) do { _Pragma("unroll") for (int m = 0; m < 4; ++m) _Pragma("unroll") for (int k = 0; k < 2; ++k) dst[m][k] = *(const PG8_LAS bf16x8*)(lds + PG8_SA(b, h) + aoff + m * 2048 + k * 1024); } while (0)
#define PG8_LDB(dst, b, h) do { _Pragma("unroll") for (int n = 0; n < 2; ++n) _Pragma("unroll") for (int k = 0; k < 2; ++k) dst[n][k] = *(const PG8_LAS bf16x8*)(lds + PG8_SB(b, h) + boff + n * 2048 + k * 1024); } while (0)
#define PG8_MMA(ai, bj, At, Bt) do { __builtin_amdgcn_s_setprio(1); _Pragma("unroll") for (int m = 0; m < 4; ++m) _Pragma("unroll") for (int n = 0; n < 2; ++n) _Pragma("unroll") for (int k = 0; k < 2; ++k) \
        acc[ai][bj][m][n] = __builtin_amdgcn_mfma_f32_16x16x32_bf16(Bt[n][k], At[m][k], acc[ai][bj][m][n], 0, 0, 0); __builtin_amdgcn_s_setprio(0); } while (0)
#define PG8_WAIT_V(n) asm volatile("s_waitcnt vmcnt(" #n ")" ::: "memory")
#define PG8_WAIT_L(n) asm volatile("s_waitcnt lgkmcnt(" #n ")" ::: "memory")
#define PG8_BAR __builtin_amdgcn_s_barrier()
#define PG8_SCHED __builtin_amdgcn_sched_barrier(0)
    Unit cur, nxt; int ui = 0;
    if (!S.next(0, cur)) return;
    f32x4 acc[2][2][4][2];
#pragma unroll
    for (int a = 0; a < 2; ++a)
#pragma unroll
        for (int b = 0; b < 2; ++b)
#pragma unroll
            for (int m = 0; m < 4; ++m)
#pragma unroll
                for (int n = 0; n < 2; ++n) acc[a][b][m][n] = (f32x4){0.f, 0.f, 0.f, 0.f};
    bf16x8 At[4][2], B0[2][2], B1[2][2];
    const char* cA = (const char*)g.A + (size_t)cur.pm * tstep; const char* cB = (const char*)g.Bt + (size_t)cur.pn * tstep;
    S.a_ready(cur);
    if constexpr (SP2) {
        PG8_STAGE(PG8_SB(0, 0), cB, voffB); PG8_STAGE(PG8_SB(0, 1), cB + hstep, voffB); PG8_STAGE(PG8_SA(0, 0), cA, voffA); PG8_STAGE(PG8_SA(0, 1), cA + hstep, voffA);
        if (wr == 1) PG8_BAR;
        PG8_WAIT_V(2); PG8_BAR;
        PG8_STAGE(PG8_SB(1, 0), cB + kstep, voffB); PG8_STAGE(PG8_SA(1, 0), cA + kstep, voffA); PG8_STAGE(PG8_SB(1, 1), cB + hstep + kstep, voffB);
        PG8_WAIT_V(6); PG8_BAR;
    } else {
        PG8_STAGE(PG8_SB(0, 0), cB, voffB); PG8_STAGE(PG8_SA(0, 0), cA, voffA); PG8_STAGE(PG8_SB(0, 1), cB + hstep, voffB); PG8_STAGE(PG8_SA(0, 1), cA + hstep, voffA);
        if (wr == 1) PG8_BAR;
        PG8_WAIT_V(4); PG8_BAR;
        PG8_STAGE(PG8_SB(1, 0), cB + kstep, voffB); PG8_STAGE(PG8_SA(1, 0), cA + kstep, voffA); PG8_STAGE(PG8_SB(1, 1), cB + hstep + kstep, voffB);
        PG8_WAIT_V(6); PG8_BAR;
    }
    for (;;) {
        const bool has_next = S.next(ui + 1, nxt);
        const char* nA = has_next ? (const char*)g.A + (size_t)nxt.pm * tstep : cA; const char* nB = has_next ? (const char*)g.Bt + (size_t)nxt.pn * tstep : cB;
        for (int t = 0; t < nt; t += 2) {
            const bool last = (t == nt - 2);
            const char* a1 = cA + (size_t)(t + 1) * kstep;
            const char* a2 = last ? nA : cA + (size_t)(t + 2) * kstep; const char* b2 = last ? nB : cB + (size_t)(t + 2) * kstep;
            const char* a3 = a2 + kstep; const char* b3 = b2 + kstep;
            if (last && has_next) S.a_ready(nxt);
            if constexpr (SP2) {
            PG8_LDB(B0, 0, 0); PG8_LDB(B1, 0, 1); PG8_SCHED; PG8_LDA(At, 0, 0); PG8_STAGE(PG8_SA(1, 1), a1 + hstep, voffA);
            PG8_WAIT_V(8); PG8_WAIT_L(0); PG8_BAR; PG8_MMA(0, 0, At, B0); PG8_MMA(0, 1, At, B1); PG8_BAR; PG8_SCHED;
            PG8_LDA(At, 0, 1); PG8_STAGE(PG8_SB(0, 0), b2, voffB); PG8_STAGE(PG8_SB(0, 1), b2 + hstep, voffB); PG8_STAGE(PG8_SA(0, 0), a2, voffA);
            PG8_WAIT_V(8); PG8_WAIT_L(0); PG8_BAR; PG8_MMA(1, 0, At, B0); PG8_MMA(1, 1, At, B1); PG8_BAR; PG8_SCHED;
            PG8_LDB(B0, 1, 0); PG8_LDB(B1, 1, 1); PG8_SCHED; PG8_LDA(At, 1, 0); PG8_STAGE(PG8_SA(0, 1), a2 + hstep, voffA);
            PG8_WAIT_V(8); PG8_WAIT_L(0); PG8_BAR; PG8_MMA(0, 0, At, B0); PG8_MMA(0, 1, At, B1); PG8_BAR; PG8_SCHED;
            PG8_LDA(At, 1, 1); PG8_STAGE(PG8_SB(1, 0), b3, voffB); PG8_STAGE(PG8_SB(1, 1), b3 + hstep, voffB); PG8_STAGE(PG8_SA(1, 0), a3, voffA);
            PG8_WAIT_V(8); PG8_WAIT_L(0); PG8_BAR; PG8_MMA(1, 0, At, B0); PG8_MMA(1, 1, At, B1); PG8_BAR; PG8_SCHED;
            } else {
            PG8_LDB(B0, 0, 0); PG8_SCHED; PG8_LDA(At, 0, 0); PG8_STAGE(PG8_SA(1, 1), a1 + hstep, voffA);
            PG8_WAIT_L(8); PG8_BAR; PG8_WAIT_L(0); PG8_MMA(0, 0, At, B0); PG8_BAR; PG8_SCHED;
            PG8_LDB(B1, 0, 1); PG8_STAGE(PG8_SB(0, 0), b2, voffB);
            PG8_BAR; PG8_WAIT_L(0); PG8_MMA(0, 1, At, B1); PG8_BAR;
            PG8_LDA(At, 0, 1); PG8_STAGE(PG8_SA(0, 0), a2, voffA);
            PG8_BAR; PG8_WAIT_L(0); PG8_MMA(1, 0, At, B0); PG8_BAR; PG8_SCHED;
            PG8_STAGE(PG8_SB(0, 1), b2 + hstep, voffB);
            PG8_WAIT_V(6); PG8_BAR; PG8_MMA(1, 1, At, B1); PG8_BAR;
            PG8_LDB(B0, 1, 0); PG8_SCHED; PG8_LDA(At, 1, 0); PG8_STAGE(PG8_SA(0, 1), a2 + hstep, voffA);
            PG8_WAIT_L(8); PG8_BAR; PG8_WAIT_L(0); PG8_MMA(0, 0, At, B0); PG8_BAR; PG8_SCHED;
            PG8_LDB(B1, 1, 1); PG8_STAGE(PG8_SB(1, 0), b3, voffB);
            PG8_BAR; PG8_WAIT_L(0); PG8_MMA(0, 1, At, B1); PG8_BAR;
            PG8_LDA(At, 1, 1); PG8_STAGE(PG8_SA(1, 0), a3, voffA);
            PG8_BAR; PG8_WAIT_L(0); PG8_MMA(1, 0, At, B0); PG8_BAR; PG8_SCHED;
            PG8_STAGE(PG8_SB(1, 1), b3 + hstep, voffB);
            PG8_WAIT_V(6); PG8_BAR; PG8_MMA(1, 1, At, B1); PG8_BAR;
            }
        }
        if constexpr (ALIGN_EPI) { if (wr == 0) PG8_BAR; }
        if constexpr (!Epi::AFTER_DRAIN) { E(acc, cur, wr, wc, fr, fq); S.done(cur); }
        if (!has_next) break;
#pragma unroll
        for (int a = 0; a < 2; ++a)
#pragma unroll
            for (int b = 0; b < 2; ++b)
#pragma unroll
                for (int m = 0; m < 4; ++m)
#pragma unroll
                    for (int n = 0; n < 2; ++n) acc[a][b][m][n] = (f32x4){0.f, 0.f, 0.f, 0.f};
        cur = nxt; cA = nA; cB = nB; ++ui;
        if constexpr (ALIGN_EPI) { if (wr == 1) PG8_BAR; }
    }
    PG8_WAIT_V(0);
    if constexpr (!ALIGN_EPI) { if (wr == 0) PG8_BAR; }
    PG8_BAR;
    if constexpr (Epi::AFTER_DRAIN) { E.fused(acc, cur, wr, wc, fr, fq, lds, wid, lane); S.done(cur); }
#undef PG8_SA
#undef PG8_SB
#undef PG8_STAGE
#undef PG8_LDA
#undef PG8_LDB
#undef PG8_MMA
#undef PG8_WAIT_V
#undef PG8_WAIT_L
#undef PG8_BAR
#undef PG8_SCHED
}
}

#define GAS __attribute__((address_space(1)))
#define LAS __attribute__((address_space(3)))
typedef unsigned short bf16;
typedef unsigned v4u __attribute__((ext_vector_type(4)));
typedef unsigned v2u __attribute__((ext_vector_type(2)));
typedef float f32x4 __attribute__((ext_vector_type(4)));
typedef float f32x16 __attribute__((ext_vector_type(16)));
typedef short bf16x8 __attribute__((ext_vector_type(8)));
typedef GAS unsigned gu32;
#define RLX_AGENT __ATOMIC_RELAXED, __HIP_MEMORY_SCOPE_AGENT
#define LDS_WAIT() asm volatile("s_waitcnt lgkmcnt(0)" ::: "memory")
#define VM_WAIT() asm volatile("s_waitcnt vmcnt(0)" ::: "memory")

constexpr int NWAVES = 8, NTHR = 512;
constexpr int BATCH = 2, SEQ = 4096, T = BATCH * SEQ, D = 2048, C = 1024, NH = 16, HD = 64;
constexpr int AH = 8, AD = 128, MB = 256, NBLK = SEQ / MB;
constexpr int NSHIFT = 3328, NIN = 6400, NZ = 6656, FF = 8192;
constexpr int ZQ = 3328, ZK = 4352, ZV = 5376, ZVD = 6400;
constexpr int DEPTH = 2;
constexpr float NORM_EPS = 1e-6f, LNX_EPS = 64e-5f;

constexpr size_t MiB = 1u << 20;
constexpr size_t WS_CTL = 0, CTL_ZERO_BYTES = 1 * MiB;
constexpr size_t WS_WIN = 1 * MiB, WS_WOUT = 27 * MiB, WS_WUP = 35 * MiB, WS_WDN = 67 * MiB;
constexpr size_t WS_VF = 99 * MiB;
constexpr size_t WS_HN = 131 * MiB;
constexpr size_t WS_YC = 163 * MiB;
constexpr size_t WS_Z = 195 * MiB;
constexpr size_t WS_SR = 299 * MiB, WS_SK = 315 * MiB, WS_SV = 331 * MiB, WS_SKK = 347 * MiB, WS_SA = 363 * MiB;
constexpr size_t WS_SW = 379 * MiB;
constexpr size_t WS_SG = 411 * MiB;
constexpr size_t WS_AQ = 427 * MiB, WS_AK = 443 * MiB, WS_AVT = 459 * MiB;
constexpr size_t WS_KM = 475 * MiB;
constexpr size_t WS_U = 195 * MiB;
constexpr size_t WS_Y2 = 195 * MiB;
constexpr size_t WS_M = 131 * MiB;
constexpr size_t WS_END = 476 * MiB;
constexpr int CW_BAR = 4096;

constexpr int RING_BYTES = 131072;
constexpr int LDSCTL_OFF = RING_BYTES, MISC_OFF = LDSCTL_OFF + 320;
constexpr int LDS_BYTES = 147456;
constexpr int PTAB_OFF = MISC_OFF + 128;

__device__ __forceinline__ unsigned f2bf(float f) { unsigned u = __builtin_bit_cast(unsigned, f); return (u + 0x7fffu + ((u >> 16) & 1u)) >> 16; }
__device__ __forceinline__ unsigned pk2(float lo, float hi) { return f2bf(lo) | (f2bf(hi) << 16); }
__device__ __forceinline__ float bf2f(unsigned short b) { return __builtin_bit_cast(float, (unsigned)b << 16); }
__device__ __forceinline__ float bflo(unsigned w) { return __builtin_bit_cast(float, w << 16); }
__device__ __forceinline__ float bfhi(unsigned w) { return __builtin_bit_cast(float, w & 0xffff0000u); }

#define XB_TMO      128
#define XB_XCNT(j)  (256  + 64 * (j))
#define XB_XSUB(j)  (1280 + 64 * (j))
#define XB_XGEN(j)  (2304 + 64 * (j))
#define XB_TOP      3328
#define XB_TOPGEN   3392
#define XCD_BAR_WORDS 3456
#define XB_SPIN_CAP (1u << 20)
__device__ __forceinline__ unsigned xb_ld(unsigned* p)              { return __hip_atomic_load(p, __ATOMIC_RELAXED, __HIP_MEMORY_SCOPE_AGENT); }
__device__ __forceinline__ unsigned xb_add(unsigned* p, unsigned v) { return __hip_atomic_fetch_add(p, v, __ATOMIC_RELAXED, __HIP_MEMORY_SCOPE_AGENT); }
__device__ __forceinline__ unsigned xb_xcc_id() { return (unsigned)__builtin_amdgcn_s_getreg((3 << 11) | 20) & 0xFu; }
#define XB_SPIN(cond, bar) do { unsigned _sp = 0; while (cond) { __builtin_amdgcn_s_sleep(1); \
    if ((++_sp & 255u) == 0u) { if (xb_ld(&(bar)[XB_TMO])) break; if (_sp > XB_SPIN_CAP) { atomicAdd(&(bar)[XB_TMO], 1u); break; } } } } while (0)
struct XcdBarrier { unsigned* bar; unsigned x; volatile LAS unsigned* st; };
__device__ __forceinline__ XcdBarrier xcd_barrier_post(unsigned* bar, volatile LAS unsigned* st) {
    XcdBarrier b; b.bar = bar; b.x = xb_xcc_id(); b.st = st;
    if (threadIdx.x == 0) (void)xb_add(&bar[XB_XCNT(b.x)], 1u);
    return b;
}
__device__ __forceinline__ void xcd_barrier_complete(unsigned* bar, unsigned x, unsigned& nloc, unsigned& nx) {
    const unsigned G = gridDim.x * gridDim.y * gridDim.z;
    unsigned sum, cnt, mine, sp = 0u;
    for (;;) {
        sum = 0u; cnt = 0u; mine = 0u;
#pragma unroll
        for (unsigned j = 0; j < 16; ++j) { const unsigned c = xb_ld(&bar[XB_XCNT(j)]); sum += c; cnt += (c > 0u) ? 1u : 0u; mine = (j == x) ? c : mine; }
        if (sum == G) break;
        __builtin_amdgcn_s_sleep(1);
        if ((++sp & 255u) == 0u) { if (xb_ld(&bar[XB_TMO])) break; if (sp > XB_SPIN_CAP) { atomicAdd(&bar[XB_TMO], 1u); break; } }
    }
    nloc = mine > 0u ? mine : 1u; nx = cnt > 0u ? cnt : 1u;
}
__device__ __forceinline__ void xcd_barrier(const XcdBarrier& b) {
    asm volatile("s_waitcnt vmcnt(0)" ::: "memory");
    __syncthreads();
    if (threadIdx.x == 0) {
        unsigned* bar = b.bar;
        __builtin_amdgcn_s_waitcnt(0);
        unsigned nloc = b.st[0], nx = b.st[1];
        if (nloc == 0u) { xcd_barrier_complete(bar, b.x, nloc, nx); b.st[0] = nloc; b.st[1] = nx; }
        const unsigned old = xb_add(&bar[XB_XSUB(b.x)], 1u);
        const unsigned gen = old / nloc;
        if (old + 1u == (gen + 1u) * nloc) {
            __builtin_amdgcn_fence(__ATOMIC_RELEASE, "agent");
            asm volatile("s_waitcnt vmcnt(0)" ::: "memory");
            const unsigned og = xb_add(&bar[XB_TOP], 1u);
            const unsigned tg = og / nx;
            if (og + 1u == (tg + 1u) * nx) xb_add(&bar[XB_TOPGEN], 1u);
            else XB_SPIN(xb_ld(&bar[XB_TOPGEN]) == tg, bar);
            __builtin_amdgcn_fence(__ATOMIC_ACQUIRE, "agent");
            xb_add(&bar[XB_XGEN(b.x)], 1u);
            asm volatile("s_waitcnt vmcnt(0)" ::: "memory");
        } else {
            XB_SPIN(xb_ld(&bar[XB_XGEN(b.x)]) == gen, bar);
            __builtin_amdgcn_fence(__ATOMIC_ACQUIRE, "agent");
            asm volatile("s_waitcnt vmcnt(0)" ::: "memory");
        }
    }
    __syncthreads();
}

struct Frame {
    LAS unsigned char* lds;
    volatile LAS unsigned* MISC;
    gu32* ctl;
    int tid, lane, wave, vcu, G;
    float* out;
    unsigned char* ws;
};
enum { I_X = 0, I_NMIXPRE, I_NMIXPOST, I_NMLPPRE, I_NMLPPOST, I_WIN, I_WINV, I_MU, I_MUV, I_W0, I_W2, I_A0, I_A2, I_V0, I_V2, I_G2, I_KK, I_KA, I_RK, I_LNG, I_LNB, I_WOUT, I_WUP, I_WDN };

__device__ __forceinline__ const float* inp_(const Frame& F, int i) {
    const unsigned long long v = *(const LAS unsigned long long*)(F.lds + PTAB_OFF + 8 * i);
    const unsigned lo = __builtin_amdgcn_readfirstlane((unsigned)v), hi = __builtin_amdgcn_readfirstlane((unsigned)(v >> 32));
    return (const float*)(((unsigned long long)hi << 32) | lo);
}
#define INP(i) inp_(F, (i))
__device__ __forceinline__ float wave_sum(float v) {
#pragma unroll
    for (int o = 1; o < 64; o <<= 1) v += __shfl_xor(v, o);
    return v;
}
__device__ __forceinline__ void transpose_item(const float* W, int K, int N, bf16* WT, int row_off, LAS float* scr, int item, int lane) {
    const int nblk = N / 32, kb = item / nblk, nb = item % nblk, k0 = 64 * kb, n0 = 32 * nb;
#pragma unroll 8
    for (int i = 0; i < 32; ++i) { const int kk = 2 * i + (lane >> 5); scr[kk * 33 + (lane & 31)] = W[(size_t)(k0 + kk) * N + n0 + (lane & 31)]; }
    LDS_WAIT(); asm volatile("" ::: "memory");
    const int c = lane & 7;
#pragma unroll
    for (int j = 0; j < 4; ++j) { const int n = (lane >> 3) + 8 * j; const LAS float* s = scr + (8 * c) * 33 + n;
        v4u o; o.x = pk2(s[0 * 33], s[1 * 33]); o.y = pk2(s[2 * 33], s[3 * 33]); o.z = pk2(s[4 * 33], s[5 * 33]); o.w = pk2(s[6 * 33], s[7 * 33]);
        *(GAS v4u*)(WT + (size_t)(row_off + n0 + n) * K + k0 + 8 * c) = o; }
    LDS_WAIT(); asm volatile("" ::: "memory");
}
__device__ __forceinline__ void rmsnorm_row_to_bf16(const float* xrow, const float* gain, bf16* orow, int lane) {
    const GAS f32x4* xr = (const GAS f32x4*)xrow + lane; const GAS f32x4* gr = (const GAS f32x4*)gain + lane;
    f32x4 v[8]; float s = 0.f;
#pragma unroll
    for (int j = 0; j < 8; ++j) { v[j] = xr[64 * j]; s += (v[j].x * v[j].x + v[j].y * v[j].y) + (v[j].z * v[j].z + v[j].w * v[j].w); }
    const float rs = 1.0f / sqrtf(wave_sum(s) * (1.f / D) + NORM_EPS);
    GAS v2u* o8 = (GAS v2u*)orow + lane;
#pragma unroll
    for (int j = 0; j < 8; ++j) { const f32x4 g = gr[64 * j]; v2u w; w.x = pk2(v[j].x * rs * g.x, v[j].y * rs * g.y); w.y = pk2(v[j].z * rs * g.z, v[j].w * rs * g.w); o8[64 * j] = w; }
}
__device__ __forceinline__ void ph_convert(Frame& F, int L) {
    LAS float* scr = (LAS float*)(F.lds + F.wave * 16384);
    const int gw = F.vcu * NWAVES + F.wave, NGW = F.G * NWAVES;
    bf16* WinT = (bf16*)(F.ws + WS_WIN); bf16* WoutT = (bf16*)(F.ws + WS_WOUT); bf16* WupT = (bf16*)(F.ws + WS_WUP); bf16* WdnT = (bf16*)(F.ws + WS_WDN);
    constexpr int I_IN = (D / 64) * (NIN / 32), I_VR = (D / 64), I_OUT = (D / 64) * (D / 32), I_UP = (D / 64) * (FF / 32), I_DN = (FF / 64) * (D / 32);
    const int nvr = (L > 0) ? I_VR : 0;
    const int NITEMS = I_IN + nvr + I_OUT + I_UP + I_DN;
    for (int it = gw; it < NITEMS; it += NGW) {
        int r = it;
        if (r < I_IN) { transpose_item(INP(I_WIN) + (size_t)L * D * NIN, D, NIN, WinT, 0, scr, r, F.lane); continue; } r -= I_IN;
        if (r < nvr) { transpose_item(INP(I_WINV) + (size_t)(L - 1) * D * 32, D, 32, WinT, NIN, scr, r, F.lane); continue; } r -= nvr;
        if (r < I_OUT) { transpose_item(INP(I_WOUT) + (size_t)L * D * D, D, D, WoutT, 0, scr, r, F.lane); continue; } r -= I_OUT;
        if (r < I_UP) { transpose_item(INP(I_WUP) + (size_t)L * D * FF, D, FF, WupT, 0, scr, r, F.lane); continue; } r -= I_UP;
        transpose_item(INP(I_WDN) + (size_t)L * FF * D, FF, D, WdnT, 0, scr, r, F.lane);
    }
    if (L > 0) {
        const int gt = F.vcu * NTHR + F.tid, NGT = F.G * NTHR;
        for (int i = gt; i < (NZ - NIN - 32) * (D / 8); i += NGT) *(GAS v4u*)(WinT + (size_t)(NIN + 32) * D + (size_t)i * 8) = (v4u){0u, 0u, 0u, 0u};
    }
    if (L == 0) {
        bf16* HN = (bf16*)(F.ws + WS_HN);
        for (int m = gw; m < T; m += NGW) rmsnorm_row_to_bf16(INP(I_X) + (size_t)m * D, INP(I_NMIXPRE), HN + (size_t)m * D, F.lane);
    }
}
__device__ __forceinline__ void ph_resnorm(Frame& F, const float* y, const float* xin, const float* gA, const float* gB, float* xout, bf16* hn) {
    const int gw = F.vcu * NWAVES + F.wave, NGW = F.G * NWAVES;
    for (int m = gw; m < T; m += NGW) {
        const GAS f32x4* yr = (const GAS f32x4*)(y + (size_t)m * D) + F.lane; const GAS f32x4* xr = (const GAS f32x4*)(xin + (size_t)m * D) + F.lane;
        const GAS f32x4* ga = (const GAS f32x4*)gA + F.lane;
        f32x4 v[8]; float s = 0.f;
#pragma unroll
        for (int j = 0; j < 8; ++j) { v[j] = yr[64 * j]; s += (v[j].x * v[j].x + v[j].y * v[j].y) + (v[j].z * v[j].z + v[j].w * v[j].w); }
        const float rs = 1.0f / sqrtf(wave_sum(s) * (1.f / D) + NORM_EPS);
        float s2 = 0.f;
        GAS f32x4* xo = (GAS f32x4*)(xout + (size_t)m * D) + F.lane;
#pragma unroll
        for (int j = 0; j < 8; ++j) { const f32x4 g = ga[64 * j]; const f32x4 x = xr[64 * j];
            v[j].x = x.x + v[j].x * rs * g.x; v[j].y = x.y + v[j].y * rs * g.y; v[j].z = x.z + v[j].z * rs * g.z; v[j].w = x.w + v[j].w * rs * g.w;
            xo[64 * j] = v[j]; s2 += (v[j].x * v[j].x + v[j].y * v[j].y) + (v[j].z * v[j].z + v[j].w * v[j].w); }
        if (gB) {
            const float rs2 = 1.0f / sqrtf(wave_sum(s2) * (1.f / D) + NORM_EPS);
            const GAS f32x4* gb = (const GAS f32x4*)gB + F.lane; GAS v2u* o8 = (GAS v2u*)(hn + (size_t)m * D) + F.lane;
#pragma unroll
            for (int j = 0; j < 8; ++j) { const f32x4 g = gb[64 * j]; v2u w; w.x = pk2(v[j].x * rs2 * g.x, v[j].y * rs2 * g.y); w.y = pk2(v[j].z * rs2 * g.z, v[j].w * rs2 * g.w); o8[64 * j] = w; }
        }
    }
}
__device__ __forceinline__ float sigmoidf_(float x) { return 1.0f / (1.0f + __expf(-x)); }
__device__ __forceinline__ float softplusf_(float x) { return fmaxf(x, 0.f) + log1pf(__expf(-fabsf(x))); }

__device__ __forceinline__ void prep_rwkv_unit(Frame& F, int L, int unit) {
    const bf16* Z = (const bf16*)(F.ws + WS_Z);
    LAS float* xl = (LAS float*)F.lds;
    const int t0 = unit * 16, tid = F.tid;
    const float* mu = INP(I_MU) + (size_t)L * NSHIFT;
    __syncthreads();
    for (int e = tid; e < 288 * 16; e += NTHR) {
        const int j = e >> 4, tt = e & 15, t = t0 + tt, s = t & (SEQ - 1);
        float f = 0.f;
        if (j < 256 || L > 0) {
            const int col = (j < 256) ? (3072 + j) : (ZVD + (j - 256));
            const float m_ = (j < 256) ? mu[col] : INP(I_MUV)[(size_t)(L - 1) * 32 + (j - 256)];
            const float zc = bf2f(Z[(size_t)t * NZ + col]); const float zp = s ? bf2f(Z[(size_t)(t - 1) * NZ + col]) : 0.f;
            const float zs = zc + (zp - zc) * m_;
            f = (j < 64) ? tanhf(zs) : ((j < 128) ? zs : ((j < 256) ? sigmoidf_(zs) : zs));
        }
        xl[j * 16 + tt] = f;
    }
    __syncthreads();
    const float* w0 = INP(I_W0) + (size_t)L * C; const float* w2 = INP(I_W2) + (size_t)L * 64 * C;
    const float* a0 = INP(I_A0) + (size_t)L * C; const float* a2 = INP(I_A2) + (size_t)L * 64 * C;
    const float* g2 = INP(I_G2) + (size_t)L * 128 * C;
    const float* v0 = INP(I_V0) + (size_t)(L > 0 ? L - 1 : 0) * C; const float* v2 = INP(I_V2) + (size_t)(L > 0 ? L - 1 : 0) * 32 * C;
    const float* kkw = INP(I_KK) + (size_t)L * C; const float* kaw = INP(I_KA) + (size_t)L * C;
    bf16* SR = (bf16*)(F.ws + WS_SR); bf16* SK = (bf16*)(F.ws + WS_SK); bf16* SV = (bf16*)(F.ws + WS_SV); bf16* SKK = (bf16*)(F.ws + WS_SKK); bf16* SA = (bf16*)(F.ws + WS_SA);
    float* SW = (float*)(F.ws + WS_SW); bf16* SG = (bf16*)(F.ws + WS_SG); float* VF = (float*)(F.ws + WS_VF);
    for (int cc = 0; cc < 2; ++cc) {
        const int c = tid + 512 * cc;
        float dec[16], av[16], gv[16], sv[16];
        {   float acc[16];
#pragma unroll
            for (int tt = 0; tt < 16; ++tt) acc[tt] = w0[c];
            for (int j = 0; j < 64; ++j) { const float wv = w2[(size_t)j * C + c]; const LAS f32x4* xp = (const LAS f32x4*)(xl + j * 16);
#pragma unroll
                for (int q = 0; q < 4; ++q) { const f32x4 x = xp[q]; acc[4 * q] += x.x * wv; acc[4 * q + 1] += x.y * wv; acc[4 * q + 2] += x.z * wv; acc[4 * q + 3] += x.w * wv; } }
#pragma unroll
            for (int tt = 0; tt < 16; ++tt) { const float wl = -softplusf_(-acc[tt]) - 0.5f; dec[tt] = __expf(-__expf(wl)); }
        }
        {   float acc[16];
#pragma unroll
            for (int tt = 0; tt < 16; ++tt) acc[tt] = a0[c];
            for (int j = 0; j < 64; ++j) { const float wv = a2[(size_t)j * C + c]; const LAS f32x4* xp = (const LAS f32x4*)(xl + (64 + j) * 16);
#pragma unroll
                for (int q = 0; q < 4; ++q) { const f32x4 x = xp[q]; acc[4 * q] += x.x * wv; acc[4 * q + 1] += x.y * wv; acc[4 * q + 2] += x.z * wv; acc[4 * q + 3] += x.w * wv; } }
#pragma unroll
            for (int tt = 0; tt < 16; ++tt) av[tt] = sigmoidf_(acc[tt]);
        }
        {   float acc[16];
#pragma unroll
            for (int tt = 0; tt < 16; ++tt) acc[tt] = 0.f;
            for (int j = 0; j < 128; ++j) { const float wv = g2[(size_t)j * C + c]; const LAS f32x4* xp = (const LAS f32x4*)(xl + (128 + j) * 16);
#pragma unroll
                for (int q = 0; q < 4; ++q) { const f32x4 x = xp[q]; acc[4 * q] += x.x * wv; acc[4 * q + 1] += x.y * wv; acc[4 * q + 2] += x.z * wv; acc[4 * q + 3] += x.w * wv; } }
#pragma unroll
            for (int tt = 0; tt < 16; ++tt) gv[tt] = acc[tt];
        }
        if (L > 0) {   float acc[16];
#pragma unroll
            for (int tt = 0; tt < 16; ++tt) acc[tt] = v0[c];
            for (int j = 0; j < 32; ++j) { const float wv = v2[(size_t)j * C + c]; const LAS f32x4* xp = (const LAS f32x4*)(xl + (256 + j) * 16);
#pragma unroll
                for (int q = 0; q < 4; ++q) { const f32x4 x = xp[q]; acc[4 * q] += x.x * wv; acc[4 * q + 1] += x.y * wv; acc[4 * q + 2] += x.z * wv; acc[4 * q + 3] += x.w * wv; } }
#pragma unroll
            for (int tt = 0; tt < 16; ++tt) sv[tt] = sigmoidf_(acc[tt]);
        } else {
#pragma unroll
            for (int tt = 0; tt < 16; ++tt) sv[tt] = 0.f;
        }
        const float mur = mu[c], muk = mu[C + c], muv = mu[2 * C + c], kkc = kkw[c], kac = kaw[c];
        float zpr, zpk, zpv;
        { const int s0 = t0 & (SEQ - 1);
          if (s0) { const bf16* zp = Z + (size_t)(t0 - 1) * NZ; zpr = bf2f(zp[c]); zpk = bf2f(zp[C + c]); zpv = bf2f(zp[2 * C + c]); } else { zpr = zpk = zpv = 0.f; } }
#pragma unroll
        for (int tt = 0; tt < 16; ++tt) {
            const int t = t0 + tt; const bf16* zc = Z + (size_t)t * NZ;
            const float zr = bf2f(zc[c]), zk = bf2f(zc[C + c]), zv = bf2f(zc[2 * C + c]);
            const float r = zr + (zpr - zr) * mur, k = zk + (zpk - zk) * muk; float v = zv + (zpv - zv) * muv;
            zpr = zr; zpk = zk; zpv = zv;
            const size_t o = (size_t)t * C + c;
            if (L == 0) VF[o] = v; else v = v + (VF[o] - v) * sv[tt];
            float kk = k * kkc; const float ss = wave_sum(kk * kk); kk = kk / fmaxf(sqrtf(ss), 1e-12f);
            const float k2 = k * (1.f + (av[tt] - 1.f) * kac);
            SR[o] = (bf16)f2bf(r); SK[o] = (bf16)f2bf(k2); SV[o] = (bf16)f2bf(v); SKK[o] = (bf16)f2bf(kk); SA[o] = (bf16)f2bf(av[tt]); SW[o] = dec[tt]; SG[o] = (bf16)f2bf(gv[tt]);
        }
    }
}
__device__ __forceinline__ void prep_attn_unit(Frame& F, int u) {
    const bf16* Z = (const bf16*)(F.ws + WS_Z);
    bf16* AQ = (bf16*)(F.ws + WS_AQ); bf16* AKp = (bf16*)(F.ws + WS_AK); bf16* AVT = (bf16*)(F.ws + WS_AVT); float* KM = (float*)(F.ws + WS_KM);
    const int b = u / (NBLK * AH), rem = u % (NBLK * AH), blk = rem / AH, h = rem % AH;
    const int tid = F.tid, d = tid & 63, tw = tid >> 6;
    const int tb = b * SEQ + blk * MB;
    LAS float* red = (LAS float*)F.lds;
    LAS bf16* vt = (LAS bf16*)(F.lds + 4096);
    __syncthreads();
    const float inv_freq = exp2f(-(float)d * (13.287712379549449f / 64.0f));
    float ks0 = 0.f, ks1 = 0.f;
    for (int i = 0; i < 32; ++i) {
        const int tok = tw + 8 * i; const int s = blk * MB + tok; const size_t t = (size_t)(tb + tok);
        float sn, cs; sincosf((float)s * inv_freq, &sn, &cs);
        const bf16* zq = Z + t * NZ + ZQ + h * AD; const bf16* zk = Z + t * NZ + ZK + h * AD;
        const float q1 = bf2f(zq[d]), q2 = bf2f(zq[d + 64]), k1 = bf2f(zk[d]), k2 = bf2f(zk[d + 64]);
        const float q1r = q1 * cs - q2 * sn, q2r = q2 * cs + q1 * sn, k1r = k1 * cs - k2 * sn, k2r = k2 * cs + k1 * sn;
        AQ[t * C + h * AD + d] = (bf16)f2bf(q1r); AQ[t * C + h * AD + 64 + d] = (bf16)f2bf(q2r);
        AKp[t * C + h * AD + d] = (bf16)f2bf(k1r); AKp[t * C + h * AD + 64 + d] = (bf16)f2bf(k2r);
        ks0 += k1r; ks1 += k2r;
    }
    red[tw * 128 + d] = ks0; red[tw * 128 + 64 + d] = ks1;
    for (int i = 0; i < 64; ++i) { const int idx = tid + NTHR * i; const int tok = idx >> 7, dd = idx & 127;
        vt[dd * 264 + tok] = Z[(size_t)(tb + tok) * NZ + ZV + h * AD + dd]; }
    __syncthreads();
    if (tid < 128) { float s = 0.f;
#pragma unroll
        for (int w = 0; w < 8; ++w) s += red[w * 128 + tid];
        KM[((size_t)(b * AH + h) * NBLK + blk) * AD + tid] = s * (1.0f / MB); }
    for (int i = 0; i < 8; ++i) { const int idx = tid + NTHR * i; const int dd = idx >> 5, ch = idx & 31;
        const v4u v = *(const LAS v4u*)(vt + dd * 264 + ch * 8);
        *(GAS v4u*)(AVT + ((size_t)(b * AH + h) * AD + dd) * SEQ + blk * MB + ch * 8) = v; }
}
__device__ __forceinline__ void ph_prep(Frame& F, int L) {
    for (int u = F.vcu; u < T / 16 + BATCH * NBLK * AH; u += F.G) {
        if (u < T / 16) prep_rwkv_unit(F, L, u); else prep_attn_unit(F, u - T / 16);
    }
}

__device__ __forceinline__ float dpp_f(float v, int) { return v; }
#define DPP_ADD(v, ctrl) ((v) + __builtin_bit_cast(float, __builtin_amdgcn_update_dpp(0, __builtin_bit_cast(int, (v)), (ctrl), 0xF, 0xF, true)))
__device__ __forceinline__ float red8(float v) {
    v = DPP_ADD(v, 0xB1);
    v = DPP_ADD(v, 0x4E);
    v = DPP_ADD(v, 0x141);
    return v;
}
__device__ __forceinline__ void scan_unit(Frame& F, int bh) {
    const int b = bh / NH, h = bh % NH, tid = F.tid, lane = F.lane, wv = F.wave;
    const bf16* SR = (const bf16*)(F.ws + WS_SR); const bf16* SK = (const bf16*)(F.ws + WS_SK); const bf16* SV = (const bf16*)(F.ws + WS_SV);
    const bf16* SKK = (const bf16*)(F.ws + WS_SKK); const bf16* SA = (const bf16*)(F.ws + WS_SA); const float* SW = (const float*)(F.ws + WS_SW);
    float* YR = (float*)(F.ws + WS_HN);
    LAS float* buf = (LAS float*)F.lds;
    constexpr int ARR = 16 * 64, BUFSZ = 6 * ARR;
    const int i_row = 8 * wv + (lane >> 3), jq = lane & 7;
    float st[8];
#pragma unroll
    for (int e = 0; e < 8; ++e) st[e] = 0.f;
    const int ltt = tid >> 5, lch = 2 * (tid & 31);
    const size_t gbase = ((size_t)b * SEQ) * C + (size_t)h * HD + lch;
    unsigned pr, pk, pv, pkk, pa; float pw0, pw1;
#define SCAN_LOAD(cidx) do { const size_t o = gbase + (size_t)((cidx) * 16 + ltt) * C; \
        pr = *(const GAS unsigned*)(SR + o); pk = *(const GAS unsigned*)(SK + o); pv = *(const GAS unsigned*)(SV + o); pkk = *(const GAS unsigned*)(SKK + o); pa = *(const GAS unsigned*)(SA + o); \
        pw0 = SW[o]; pw1 = SW[o + 1]; } while (0)
#define SCAN_STORE(bi) do { LAS float* B_ = buf + (bi) * BUFSZ + ltt * 64 + lch; \
        B_[0] = bflo(pr); B_[1] = bfhi(pr); B_[ARR] = pw0; B_[ARR + 1] = pw1; B_[2 * ARR] = bflo(pk); B_[2 * ARR + 1] = bfhi(pk); \
        { const float k0_ = bflo(pkk), k1_ = bfhi(pkk); B_[3 * ARR] = -k0_; B_[3 * ARR + 1] = -k1_; B_[4 * ARR] = k0_ * bflo(pa); B_[4 * ARR + 1] = k1_ * bfhi(pa); } \
        B_[5 * ARR] = bflo(pv); B_[5 * ARR + 1] = bfhi(pv); } while (0)
    __syncthreads();
    SCAN_LOAD(0); SCAN_STORE(0);
    __syncthreads();
    constexpr int NCH = SEQ / 16;
    for (int ci = 0; ci < NCH; ++ci) {
        if (ci + 1 < NCH) SCAN_LOAD(ci + 1);
        const LAS float* Bc = buf + (ci & 1) * BUFSZ;
#pragma unroll 4
        for (int tt = 0; tt < 16; ++tt) {
            const LAS f32x4* pr_ = (const LAS f32x4*)(Bc + tt * 64 + 8 * jq);
            const f32x4 r0 = pr_[0], r1 = pr_[1];
            const f32x4 w0 = pr_[ARR / 4], w1 = pr_[ARR / 4 + 1];
            const f32x4 k0 = pr_[2 * ARR / 4], k1 = pr_[2 * ARR / 4 + 1];
            const f32x4 a0 = pr_[3 * ARR / 4], a1 = pr_[3 * ARR / 4 + 1];
            const f32x4 b0 = pr_[4 * ARR / 4], b1 = pr_[4 * ARR / 4 + 1];
            const float vi = Bc[5 * ARR + tt * 64 + i_row];
            float sa = st[0] * a0.x + st[1] * a0.y + st[2] * a0.z + st[3] * a0.w + st[4] * a1.x + st[5] * a1.y + st[6] * a1.z + st[7] * a1.w;
            sa = red8(sa);
            st[0] = st[0] * w0.x + sa * b0.x + vi * k0.x; st[1] = st[1] * w0.y + sa * b0.y + vi * k0.y; st[2] = st[2] * w0.z + sa * b0.z + vi * k0.z; st[3] = st[3] * w0.w + sa * b0.w + vi * k0.w;
            st[4] = st[4] * w1.x + sa * b1.x + vi * k1.x; st[5] = st[5] * w1.y + sa * b1.y + vi * k1.y; st[6] = st[6] * w1.z + sa * b1.z + vi * k1.z; st[7] = st[7] * w1.w + sa * b1.w + vi * k1.w;
            float y = st[0] * r0.x + st[1] * r0.y + st[2] * r0.z + st[3] * r0.w + st[4] * r1.x + st[5] * r1.y + st[6] * r1.z + st[7] * r1.w;
            y = red8(y);
            if (jq == 0) YR[((size_t)b * SEQ + ci * 16 + tt) * C + h * HD + i_row] = y;
        }
        if (ci + 1 < NCH) SCAN_STORE((ci + 1) & 1);
        __syncthreads();
    }
#undef SCAN_LOAD
#undef SCAN_STORE
}
__device__ __forceinline__ void ph_post(Frame& F, int L) {
    const bf16* SR = (const bf16*)(F.ws + WS_SR); const bf16* SK = (const bf16*)(F.ws + WS_SK); const bf16* SV = (const bf16*)(F.ws + WS_SV); const bf16* SG = (const bf16*)(F.ws + WS_SG);
    const float* YR = (const float*)(F.ws + WS_HN); bf16* YC = (bf16*)(F.ws + WS_YC);
    const float* rk = INP(I_RK) + (size_t)L * C; const float* lg = INP(I_LNG) + (size_t)L * C; const float* lb = INP(I_LNB) + (size_t)L * C;
    const int gw = F.vcu * NWAVES + F.wave, NGW = F.G * NWAVES, lane = F.lane;
    for (int it = gw; it < T * NH; it += NGW) {
        const int t = it / NH, h = it % NH; const int c = h * HD + lane; const size_t o = (size_t)t * C + c;
        const float y = YR[o];
        const float mean = wave_sum(y) * (1.f / HD); const float dlt = y - mean; const float var = wave_sum(dlt * dlt) * (1.f / HD);
        const float yn = dlt * (1.0f / sqrtf(var + LNX_EPS)) * lg[c] + lb[c];
        const float r = bf2f(SR[o]), k = bf2f(SK[o]), v = bf2f(SV[o]), g = bf2f(SG[o]);
        const float bonus = wave_sum(r * k * rk[c]) * v;
        YC[(size_t)t * D + c] = (bf16)f2bf((yn + bonus) * g);
    }
}
__device__ __forceinline__ int crow(int r, int hi) { return (r & 3) + 8 * (r >> 2) + 4 * hi; }
__device__ __forceinline__ void attn_unit(Frame& F, int b, int h, int qb) {
    const bf16* AQ = (const bf16*)(F.ws + WS_AQ); const bf16* AKp = (const bf16*)(F.ws + WS_AK); const bf16* AVT = (const bf16*)(F.ws + WS_AVT); const float* KM = (const float*)(F.ws + WS_KM);
    bf16* YC = (bf16*)(F.ws + WS_YC);
    const int tid = F.tid, lane = F.lane, wid = F.wave, r32 = lane & 31, hi = lane >> 5;
    constexpr int KBUF = 64 * 256, VPITCH = 136, VBUF = 128 * VPITCH;
    LAS unsigned char* kbuf = F.lds;
    LAS unsigned char* vbuf = F.lds + 2 * KBUF;
    LAS float* kmL = (LAS float*)(F.lds + 2 * KBUF + 2 * VBUF);
    const size_t tb = (size_t)b * SEQ; const int q0 = qb * MB + wid * 32;
    __syncthreads();
    for (int i = tid; i < NBLK * AD; i += NTHR) kmL[i] = KM[(size_t)(b * AH + h) * NBLK * AD + i];
    bf16x8 qr[8];
    { const bf16* Qp = AQ + (tb + q0 + r32) * C + h * AD + hi * 8;
#pragma unroll
      for (int d0 = 0; d0 < 8; ++d0) qr[d0] = *(const GAS bf16x8*)(Qp + d0 * 16); }
    __syncthreads();
    unsigned selmask;
    {
        float g1 = -INFINITY, g2 = -INFINITY, g3 = -INFINITY; int i1 = 0, i2 = 0, i3 = 0;
        for (int n = 0; n < qb; ++n) {
            float acc = 0.f;
#pragma unroll
            for (int d0 = 0; d0 < 8; ++d0) { const LAS f32x4* kp = (const LAS f32x4*)(kmL + n * AD + d0 * 16 + hi * 8); const f32x4 ka = kp[0], kb = kp[1];
                const bf16x8 q = qr[d0];
                acc += bf2f((unsigned short)q[0]) * ka.x + bf2f((unsigned short)q[1]) * ka.y + bf2f((unsigned short)q[2]) * ka.z + bf2f((unsigned short)q[3]) * ka.w
                     + bf2f((unsigned short)q[4]) * kb.x + bf2f((unsigned short)q[5]) * kb.y + bf2f((unsigned short)q[6]) * kb.z + bf2f((unsigned short)q[7]) * kb.w; }
            const float g = acc + __shfl_xor(acc, 32);
            if (g > g1) { g3 = g2; i3 = i2; g2 = g1; i2 = i1; g1 = g; i1 = n; }
            else if (g > g2) { g3 = g2; i3 = i2; g2 = g; i2 = n; }
            else if (g > g3) { g3 = g; i3 = n; }
        }
        selmask = (qb <= 3) ? ((1u << qb) - 1u) : ((1u << i1) | (1u << i2) | (1u << i3));
    }
    const int NT = 4 * (qb + 1);
    v4u kreg[2], vreg[2];
    const bf16* Kg = AKp + tb * C + h * AD; const bf16* Vg = AVT + (size_t)(b * AH + h) * AD * SEQ;
#define TILE_KS(ti) (((ti) < 4) ? (qb * MB + 64 * (ti)) : ((((ti) - 4) >> 2) * MB + 64 * (((ti) - 4) & 3)))
#define ATT_LOAD(ti) do { const int ks_ = TILE_KS(ti); _Pragma("unroll") for (int i_ = 0; i_ < 2; ++i_) { const int idx_ = tid + NTHR * i_; \
        kreg[i_] = *(const GAS v4u*)(Kg + (size_t)(ks_ + (idx_ >> 4)) * C + (idx_ & 15) * 8); \
        vreg[i_] = *(const GAS v4u*)(Vg + (size_t)(idx_ >> 3) * SEQ + ks_ + (idx_ & 7) * 8); } } while (0)
#define ATT_STORE(bi) do { _Pragma("unroll") for (int i_ = 0; i_ < 2; ++i_) { const int idx_ = tid + NTHR * i_; const int row_ = idx_ >> 4, c_ = idx_ & 15; \
        *(LAS v4u*)(kbuf + (bi) * KBUF + row_ * 256 + ((c_ ^ (row_ & 15)) << 4)) = kreg[i_]; \
        LAS v2u* vd_ = (LAS v2u*)(vbuf + (bi) * VBUF + (idx_ >> 3) * VPITCH + (idx_ & 7) * 16); vd_[0] = (v2u){vreg[i_].x, vreg[i_].y}; vd_[1] = (v2u){vreg[i_].z, vreg[i_].w}; } } while (0)
    f32x16 O[4];
#pragma unroll
    for (int dt = 0; dt < 4; ++dt) O[dt] = (f32x16){0.f};
    float m_run = -1e30f, l_run = 0.f;
    const float SC = 0.08838834764831845f * 1.4426950408889634f;
    ATT_LOAD(0); ATT_STORE(0);
    __syncthreads();
    const int qpos = q0 + r32;
    for (int ti = 0; ti < NT; ++ti) {
        if (ti + 1 < NT) ATT_LOAD(ti + 1);
        const LAS unsigned char* kb_ = kbuf + (ti & 1) * KBUF; const LAS unsigned char* vb_ = vbuf + (ti & 1) * VBUF;
        const int ks = TILE_KS(ti);
        f32x16 p[2];
#pragma unroll
        for (int kb2 = 0; kb2 < 2; ++kb2) {
            f32x16 acc = (f32x16){0.f};
            const int row = 32 * kb2 + r32;
#pragma unroll
            for (int d0 = 0; d0 < 8; ++d0) {
                const bf16x8 kf = *(const LAS bf16x8*)(kb_ + row * 256 + (((2 * d0 + hi) ^ (row & 15)) << 4));
                acc = __builtin_amdgcn_mfma_f32_32x32x16_bf16(kf, qr[d0], acc, 0, 0, 0);
            }
            p[kb2] = acc;
        }
        const bool own = ti < 4;
        const bool lane_ok = own || ((selmask >> ((ti - 4) >> 2)) & 1u);
        float mx = -1e30f;
#pragma unroll
        for (int kb2 = 0; kb2 < 2; ++kb2)
#pragma unroll
            for (int r = 0; r < 16; ++r) {
                float s = p[kb2][r] * SC;
                const int kpos = ks + 32 * kb2 + crow(r, hi);
                const bool ok = own ? (kpos <= qpos) : lane_ok;
                s = ok ? s : -1e30f; p[kb2][r] = s; mx = fmaxf(mx, s);
            }
        mx = fmaxf(mx, __shfl_xor(mx, 32));
        const float m_new = fmaxf(m_run, mx);
        const float alpha = exp2f(m_run - m_new);
        m_run = m_new;
        float ls = 0.f;
#pragma unroll
        for (int kb2 = 0; kb2 < 2; ++kb2)
#pragma unroll
            for (int r = 0; r < 16; ++r) { const float e = exp2f(p[kb2][r] - m_new); p[kb2][r] = e; ls += e; }
        l_run = l_run * alpha + ls;
#pragma unroll
        for (int dt = 0; dt < 4; ++dt)
#pragma unroll
            for (int r = 0; r < 16; ++r) O[dt][r] *= alpha;
#pragma unroll
        for (int kb2 = 0; kb2 < 2; ++kb2)
#pragma unroll
            for (int s = 0; s < 2; ++s) {
                v4u pw; pw.x = pk2(p[kb2][8 * s + 0], p[kb2][8 * s + 1]); pw.y = pk2(p[kb2][8 * s + 2], p[kb2][8 * s + 3]); pw.z = pk2(p[kb2][8 * s + 4], p[kb2][8 * s + 5]); pw.w = pk2(p[kb2][8 * s + 6], p[kb2][8 * s + 7]);
                const bf16x8 pf = __builtin_bit_cast(bf16x8, pw);
                const int key0 = 32 * kb2 + 16 * s + 4 * hi;
#pragma unroll
                for (int dt = 0; dt < 4; ++dt) {
                    const LAS unsigned char* vp = vb_ + (32 * dt + r32) * VPITCH + key0 * 2;
                    const v2u lo = *(const LAS v2u*)vp, hi2 = *(const LAS v2u*)(vp + 16);
                    const v4u vw = (v4u){lo.x, lo.y, hi2.x, hi2.y};
                    O[dt] = __builtin_amdgcn_mfma_f32_32x32x16_bf16(__builtin_bit_cast(bf16x8, vw), pf, O[dt], 0, 0, 0);
                }
            }
        if (ti + 1 < NT) ATT_STORE((ti + 1) & 1);
        __syncthreads();
    }
    const float l_tot = l_run + __shfl_xor(l_run, 32);
    const float inv = 1.0f / l_tot;
    bf16* yo = YC + (tb + q0 + r32) * D + C + h * AD;
#pragma unroll
    for (int dt = 0; dt < 4; ++dt)
#pragma unroll
        for (int rq = 0; rq < 4; ++rq) {
            v2u w; w.x = pk2(O[dt][4 * rq] * inv, O[dt][4 * rq + 1] * inv); w.y = pk2(O[dt][4 * rq + 2] * inv, O[dt][4 * rq + 3] * inv);
            *(GAS v2u*)(yo + 32 * dt + 8 * rq + 4 * hi) = w;
        }
#undef TILE_KS
#undef ATT_LOAD
#undef ATT_STORE
}
__device__ __forceinline__ void ph_mixer(Frame& F, int L) {
    constexpr int NSC = BATCH * NH, NAT = BATCH * AH * NBLK;
    if (F.G >= 64) {
        if (F.vcu < NSC) { for (int u = F.vcu; u < NSC; u += NSC) scan_unit(F, u); }
        else { const int na = F.G - NSC; for (int au = F.vcu - NSC; au < NAT; au += na) { const int qb = NBLK - 1 - au / (BATCH * AH), bh = au % (BATCH * AH); attn_unit(F, bh / AH, bh % AH, qb); } }
    } else {
        for (int u = F.vcu; u < NSC; u += F.G) scan_unit(F, u);
        for (int au = F.vcu; au < NAT; au += F.G) { const int qb = NBLK - 1 - au / (BATCH * AH), bh = au % (BATCH * AH); attn_unit(F, bh / AH, bh % AH, qb); }
    }
}

constexpr int PH_PER_LAYER = 10, NPHASE = DEPTH * PH_PER_LAYER;
#ifndef MK_N_LAUNCHES
#define MK_N_LAUNCHES 1
#endif
struct Args { const float* in[24]; float* out; unsigned char* ws; int ph_lo, ph_hi, li, pad; };
__global__ void __launch_bounds__(NTHR, 2) mega_fwd(Args args) {
    extern __shared__ __attribute__((aligned(16))) unsigned char lds[];
    Frame F;
    F.lds = (LAS unsigned char*)lds;
    F.MISC = (volatile LAS unsigned*)(F.lds + MISC_OFF);
    F.tid = threadIdx.x; F.lane = F.tid & 63; F.wave = __builtin_amdgcn_readfirstlane(F.tid >> 6);
    F.G = gridDim.x; { const int bx = blockIdx.x; F.vcu = (F.G % 8 == 0) ? (bx % 8) * (F.G / 8) + bx / 8 : bx; }
    F.ws = args.ws; F.out = args.out; F.ctl = (gu32*)(args.ws + WS_CTL);
    for (int u = F.tid; u < (LDS_BYTES - LDSCTL_OFF) / 4; u += NTHR) ((LAS unsigned*)(F.lds + LDSCTL_OFF))[u] = 0u;
    __syncthreads();
    if (F.tid < 24) *(LAS unsigned long long*)(F.lds + PTAB_OFF + 8 * F.tid) = (unsigned long long)args.in[F.tid];
    __syncthreads();
    XcdBarrier bar; bar.bar = (unsigned*)(F.ctl + CW_BAR) + args.li * XCD_BAR_WORDS; bar.x = 0; bar.st = nullptr;
    const bool one_launch = (args.ph_hi - args.ph_lo) > 1;
    if (one_launch) bar = xcd_barrier_post((unsigned*)(F.ctl + CW_BAR) + args.li * XCD_BAR_WORDS, F.MISC + 8);
    bf16* HN = (bf16*)(F.ws + WS_HN); bf16* YC = (bf16*)(F.ws + WS_YC); bf16* Zb = (bf16*)(F.ws + WS_Z); bf16* U = (bf16*)(F.ws + WS_U);
    float* Y2 = (float*)(F.ws + WS_Y2); float* Mo = (float*)(F.ws + WS_M);
    for (int ph = args.ph_lo; ph < args.ph_hi; ++ph) {
        const int L = ph / PH_PER_LAYER, p = ph % PH_PER_LAYER;
        { int t_ = threadIdx.x; asm volatile("" : "+v"(t_)); F.tid = t_; F.lane = t_ & 63; F.wave = __builtin_amdgcn_readfirstlane(t_ >> 6); }
        switch (p) {
        case 0: ph_convert(F, L); break;
        case 1: { pg8::Gemm g{HN, (const bf16*)(F.ws + WS_WIN), T, (L == 0) ? NIN : NZ, D}; pg8::StaticOrder S; S.init(T, (L == 0) ? NIN : NZ, F.G, (int)blockIdx.x);
                  pg8::EpiBf16<0> E{Zb, NZ}; pg8::gemm_phase<pg8::EpiBf16<0>, pg8::StaticOrder, true, true>(F.lds, g, S, E, F.tid); } break;
        case 2: ph_prep(F, L); break;
        case 3: ph_mixer(F, L); break;
        case 4: ph_post(F, L); break;
        case 5: { pg8::Gemm g{YC, (const bf16*)(F.ws + WS_WOUT), T, D, D}; pg8::StaticOrder S; S.init(T, D, F.G, (int)blockIdx.x);
                  pg8::EpiF32 E{Y2, D}; pg8::gemm_phase<pg8::EpiF32, pg8::StaticOrder, true, true>(F.lds, g, S, E, F.tid); } break;
        case 6: ph_resnorm(F, Y2, (L == 0) ? INP(I_X) : F.out, INP(I_NMIXPOST) + (size_t)L * D, INP(I_NMLPPRE) + (size_t)L * D, F.out, HN); break;
        case 7: { pg8::Gemm g{HN, (const bf16*)(F.ws + WS_WUP), T, FF, D}; pg8::StaticOrder S; S.init(T, FF, F.G, (int)blockIdx.x);
                  pg8::EpiBf16<2> E{U, FF}; pg8::gemm_phase<pg8::EpiBf16<2>, pg8::StaticOrder, true, true>(F.lds, g, S, E, F.tid); } break;
        case 8: { pg8::Gemm g{U, (const bf16*)(F.ws + WS_WDN), T, D, FF}; pg8::StaticOrder S; S.init(T, D, F.G, (int)blockIdx.x);
                  pg8::EpiF32 E{Mo, D}; pg8::gemm_phase<pg8::EpiF32, pg8::StaticOrder, true, true>(F.lds, g, S, E, F.tid); } break;
        case 9: ph_resnorm(F, Mo, F.out, INP(I_NMLPPOST) + (size_t)L * D, (L + 1 < DEPTH) ? INP(I_NMIXPRE) + (size_t)(L + 1) * D : nullptr, F.out, HN); break;
        }
        if (ph + 1 < args.ph_hi) xcd_barrier(bar);
    }
}

extern "C" void kernel_launch(void* const* d_in, const int* in_sizes, int n_in, void* d_out, int out_size, void* d_ws, size_t ws_size, hipStream_t stream) {
    static int grid = 0;
    if (grid == 0) {
        if (n_in != 24 || in_sizes[0] != T * D || out_size != T * D || ws_size < WS_END) { fprintf(stderr, "kernel_launch: unexpected shapes (n_in %d, in0 %d, out %d, ws %zu)\n", n_in, n_in > 0 ? in_sizes[0] : -1, out_size, ws_size); grid = -1; return; }
        int dev = 0, cus = 0, per_cu = 0;
        if (hipGetDevice(&dev) != hipSuccess || hipDeviceGetAttribute(&cus, hipDeviceAttributeMultiprocessorCount, dev) != hipSuccess) { grid = -1; return; }
        if (hipFuncSetAttribute((const void*)mega_fwd, hipFuncAttributeMaxDynamicSharedMemorySize, LDS_BYTES) != hipSuccess) { fprintf(stderr, "kernel_launch: hipFuncSetAttribute failed\n"); grid = -1; return; }
        if (hipOccupancyMaxActiveBlocksPerMultiprocessor(&per_cu, (const void*)mega_fwd, NTHR, LDS_BYTES) != hipSuccess || per_cu < 1) { fprintf(stderr, "kernel_launch: occupancy query says %d\n", per_cu); per_cu = 1; }
        (void)hipGetLastError();
        grid = cus * (per_cu > 1 ? 1 : per_cu);
    }
    if (grid < 0) return;
    (void)hipMemsetAsync((char*)d_ws + WS_CTL, 0, CTL_ZERO_BYTES, stream);
    Args a{};
    for (int i = 0; i < 24; ++i) a.in[i] = (const float*)d_in[i];
    a.out = (float*)d_out; a.ws = (unsigned char*)d_ws;
    const int nl = MK_N_LAUNCHES;
    for (int li = 0; li < nl; ++li) {
        a.li = li; a.ph_lo = (int)((long)NPHASE * li / nl); a.ph_hi = (int)((long)NPHASE * (li + 1) / nl);
        if (a.ph_hi - a.ph_lo > 1) {
            void* kargs[] = {&a};
            hipError_t e = hipLaunchCooperativeKernel((const void*)mega_fwd, dim3(grid), dim3(NTHR), kargs, LDS_BYTES, stream);
            if (e != hipSuccess) fprintf(stderr, "kernel_launch: cooperative launch failed: %s (grid %d)\n", hipGetErrorString(e), grid);
        } else {
            hipLaunchKernelGGL(mega_fwd, dim3(grid), dim3(NTHR), LDS_BYTES, stream, a);
        }
    }
}
```

```cpp
#include <hip/hip_runtime.h>
#include <cstdio>
#include <cstdint>
namespace pg8 {
#define PG8_LAS __attribute__((address_space(3)))
typedef unsigned short bf16_t;
typedef short bf16x8 __attribute__((ext_vector_type(8)));
typedef float f32x4 __attribute__((ext_vector_type(4)));
typedef unsigned u32x4 __attribute__((ext_vector_type(4)));
constexpr int BM = 256, BK = 64, HALF = 128, HTB = HALF * BK * 2  , STAGE_BYTES = 8 * HTB, NXCD = 8, WGM = 8;

__host__ __device__ __forceinline__ int lds_byte(int r, int c) { const int st = (r >> 4) * 2 + (c >> 5), rr = r & 15, cc = c & 31, ob = rr * 64 + cc * 2; return st * 1024 + (ob ^ (((ob >> 9) & 1) << 5)); }
__host__ __device__ __forceinline__ void stage_rc(int b, int& R, int& C) { const int st = b / 1024, sb = b % 1024, swz = sb ^ (((sb >> 9) & 1) << 5); R = (st >> 1) * 16 + swz / 64; C = (st & 1) * 32 + (swz % 64) / 2; }
__host__ __device__ __forceinline__ int perm32(int rho) { const int n = rho >> 4, i = rho & 15; return 8 * (i >> 2) + 4 * n + (i & 3); }

struct Unit { int pm, pn; };
struct Gemm { const bf16_t* A; const bf16_t* Bt; int M, N, K; };

struct StaticOrder {
    int nM, nN, nwg, G, c;
    __host__ __device__ void init(int M, int N, int G_, int c_) { nM = M / BM; nN = N / BM; nwg = nM * nN; G = G_; c = c_; }
    __host__ __device__ bool next(int i, Unit& u) const {
        const long L = (long)i * G + c; if (L >= nwg) return false;
        int wgid = (int)L; { const int q = nwg / NXCD, r = nwg % NXCD, xcd = wgid % NXCD, off = wgid / NXCD; wgid = (xcd < r ? xcd * (q + 1) : r * (q + 1) + (xcd - r) * q) + off; }
        const int nig = WGM * nN, gid = wgid / nig, fm = gid * WGM, gsz = (nM - fm) < WGM ? (nM - fm) : WGM;
        u.pm = fm + ((wgid % nig) % gsz); u.pn = (wgid % nig) / gsz; return true;
    }
    __device__ __forceinline__ void a_ready(const Unit&) const {}
    __device__ __forceinline__ void done(const Unit&) const {}
};

__device__ __forceinline__ unsigned cvt_pk_bf16(float lo, float hi) { unsigned r; asm volatile("v_cvt_pk_bf16_f32 %0, %1, %2" : "=v"(r) : "v"(lo), "v"(hi)); return r; }
struct EpiF32 {
    static constexpr bool PERM = false, AFTER_DRAIN = false;
    float* C; int ldc;
    __device__ __forceinline__ void operator()(const f32x4 (&acc)[2][2][4][2], const Unit& u, int wr, int wc, int fr, int fq) const {
        const int row0 = u.pm * BM + wr * 64 + fr, col0 = u.pn * BM + wc * 32 + 4 * fq;
#pragma unroll
        for (int ai = 0; ai < 2; ++ai)
#pragma unroll
            for (int m = 0; m < 4; ++m) { float* rowp = C + (size_t)(row0 + ai * HALF + m * 16) * ldc + col0;
#pragma unroll
                for (int bj = 0; bj < 2; ++bj)
#pragma unroll
                    for (int n = 0; n < 2; ++n) *(f32x4*)(rowp + bj * HALF + n * 16) = acc[ai][bj][m][n]; }
    }
};
template <int ACT  > struct EpiBf16 {
    static constexpr bool PERM = true, AFTER_DRAIN = false;
    bf16_t* O; int ldc;
    __device__ __forceinline__ void operator()(const f32x4 (&acc)[2][2][4][2], const Unit& u, int wr, int wc, int fr, int fq) const {
        const int row0 = u.pm * BM + wr * 64 + fr; const int col0 = u.pn * BM + wc * 32 + 8 * fq;
#pragma unroll
        for (int ai = 0; ai < 2; ++ai)
#pragma unroll
            for (int m = 0; m < 4; ++m) { bf16_t* rowp = O + (size_t)(row0 + ai * HALF + m * 16) * ldc + col0;
#pragma unroll
                for (int bj = 0; bj < 2; ++bj) { f32x4 v0 = acc[ai][bj][m][0], v1 = acc[ai][bj][m][1];
                    if (ACT == 2) {
#pragma unroll
                        for (int e = 0; e < 4; ++e) { float a = v0[e] > 0.f ? v0[e] : 0.f; v0[e] = a * a; float b = v1[e] > 0.f ? v1[e] : 0.f; v1[e] = b * b; } }
                    u32x4 w; w.x = cvt_pk_bf16(v0[0], v0[1]); w.y = cvt_pk_bf16(v0[2], v0[3]); w.z = cvt_pk_bf16(v1[0], v1[1]); w.w = cvt_pk_bf16(v1[2], v1[3]);
                    *(u32x4*)(rowp + bj * HALF) = w; } }
    }
};

template <class Epi, class Sched, bool ALIGN_EPI = false, bool SP2 = false>
__device__ __forceinline__ void gemm_phase(PG8_LAS unsigned char* lds, const Gemm g, const Sched& S, const Epi& E, const int tid) {
    const int wid = __builtin_amdgcn_readfirstlane(tid >> 6), lane = tid & 63, wr = wid >> 2, wc = wid & 3, fr = lane & 15, fq = lane >> 4;
    const int K = g.K, nt = K / BK;
    unsigned voffA[2], voffB[2];
#pragma unroll
    for (int i = 0; i < 2; ++i) { int R, C; stage_rc(tid * 16 + i * 8192, R, C); const int Rb = Epi::PERM ? ((R & ~31) + perm32(R & 31)) : R;
        voffA[i] = (unsigned)(R * K + C) * 2u; voffB[i] = (unsigned)(Rb * K + C) * 2u; }
    const size_t kstep = (size_t)(BK * 2);
    const size_t hstep = (size_t)HALF * K * 2;
    const size_t tstep = 2 * hstep;
    const unsigned ldsw = (unsigned)wid * 1024u;
    const int aoff = lds_byte(wr * 64 + fr, fq * 8), boff = lds_byte(wc * 32 + fr, fq * 8);
#define PG8_SA(b, h) (((b) * 2 + (h)) * HTB)
#define PG8_SB(b, h) ((4 + (b) * 2 + (h)) * HTB)
#define PG8_STAGE(bufoff, gbase, voff) do { _Pragma("unroll") for (int _i = 0; _i < 2; ++_i) \
        __builtin_amdgcn_global_load_lds((const unsigned*)((const char*)(gbase) + (voff)[_i]), (PG8_LAS unsigned*)(lds + (bufoff) + ldsw + _i * 8192), 16, 0, 0); } while (0)
#define PG8_LDA(dst, b, h) do { _Pragma("unroll") for (int m = 0; m < 4; ++m) _Pragma("unroll") for (int k = 0; k < 2; ++k) dst[m][k] = *(const PG8_LAS bf16x8*)(lds + PG8_SA(b, h) + aoff + m * 2048 + k * 1024); } while (0)
#define PG8_LDB(dst, b, h) do { _Pragma("unroll") for (int n = 0; n < 2; ++n) _Pragma("unroll") for (int k = 0; k < 2; ++k) dst[n][k] = *(const PG8_LAS bf16x8*)(lds + PG8_SB(b, h) + boff + n * 2048 + k * 1024); } while (0)
#define PG8_MMA(ai, bj, At, Bt) do { __builtin_amdgcn_s_setprio(1); _Pragma("unroll") for (int m = 0; m < 4; ++m) _Pragma("unroll") for (int n = 0; n < 2; ++n) _Pragma("unroll") for (int k = 0; k < 2; ++k) \
        acc[ai][bj][m][n] = __builtin_amdgcn_mfma_f32_16x16x32_bf16(Bt[n][k], At[m][k], acc[ai][bj][m][n], 0, 0, 0); __builtin_amdgcn_s_setprio(0); } while (0)
#define PG8_WAIT_V(n) asm volatile("s_waitcnt vmcnt(" #n ")" ::: "memory")
#define PG8_WAIT_L(n) asm volatile("s_waitcnt lgkmcnt(" #n ")" ::: "memory")
#define PG8_BAR __builtin_amdgcn_s_barrier()
#define PG8_SCHED __builtin_amdgcn_sched_barrier(0)
    Unit cur, nxt; int ui = 0;
    if (!S.next(0, cur)) return;
    f32x4 acc[2][2][4][2];
#pragma unroll
    for (int a = 0; a < 2; ++a)
#pragma unroll
        for (int b = 0; b < 2; ++b)
#pragma unroll
            for (int m = 0; m < 4; ++m)
#pragma unroll
                for (int n = 0; n < 2; ++n) acc[a][b][m][n] = (f32x4){0.f, 0.f, 0.f, 0.f};
    bf16x8 At[4][2], B0[2][2], B1[2][2];
    const char* cA = (const char*)g.A + (size_t)cur.pm * tstep; const char* cB = (const char*)g.Bt + (size_t)cur.pn * tstep;
    S.a_ready(cur);
    if constexpr (SP2) {
        PG8_STAGE(PG8_SB(0, 0), cB, voffB); PG8_STAGE(PG8_SB(0, 1), cB + hstep, voffB); PG8_STAGE(PG8_SA(0, 0), cA, voffA); PG8_STAGE(PG8_SA(0, 1), cA + hstep, voffA);
        if (wr == 1) PG8_BAR;
        PG8_WAIT_V(2); PG8_BAR;
        PG8_STAGE(PG8_SB(1, 0), cB + kstep, voffB); PG8_STAGE(PG8_SA(1, 0), cA + kstep, voffA); PG8_STAGE(PG8_SB(1, 1), cB + hstep + kstep, voffB);
        PG8_WAIT_V(6); PG8_BAR;
    } else {
        PG8_STAGE(PG8_SB(0, 0), cB, voffB); PG8_STAGE(PG8_SA(0, 0), cA, voffA); PG8_STAGE(PG8_SB(0, 1), cB + hstep, voffB); PG8_STAGE(PG8_SA(0, 1), cA + hstep, voffA);
        if (wr == 1) PG8_BAR;
        PG8_WAIT_V(4); PG8_BAR;
        PG8_STAGE(PG8_SB(1, 0), cB + kstep, voffB); PG8_STAGE(PG8_SA(1, 0), cA + kstep, voffA); PG8_STAGE(PG8_SB(1, 1), cB + hstep + kstep, voffB);
        PG8_WAIT_V(6); PG8_BAR;
    }
    for (;;) {
        const bool has_next = S.next(ui + 1, nxt);
        const char* nA = has_next ? (const char*)g.A + (size_t)nxt.pm * tstep : cA; const char* nB = has_next ? (const char*)g.Bt + (size_t)nxt.pn * tstep : cB;
        for (int t = 0; t < nt; t += 2) {
            const bool last = (t == nt - 2);
            const char* a1 = cA + (size_t)(t + 1) * kstep;
            const char* a2 = last ? nA : cA + (size_t)(t + 2) * kstep; const char* b2 = last ? nB : cB + (size_t)(t + 2) * kstep;
            const char* a3 = a2 + kstep; const char* b3 = b2 + kstep;
            if (last && has_next) S.a_ready(nxt);
            if constexpr (SP2) {
            PG8_LDB(B0, 0, 0); PG8_LDB(B1, 0, 1); PG8_SCHED; PG8_LDA(At, 0, 0); PG8_STAGE(PG8_SA(1, 1), a1 + hstep, voffA);
            PG8_WAIT_V(8); PG8_WAIT_L(0); PG8_BAR; PG8_MMA(0, 0, At, B0); PG8_MMA(0, 1, At, B1); PG8_BAR; PG8_SCHED;
            PG8_LDA(At, 0, 1); PG8_STAGE(PG8_SB(0, 0), b2, voffB); PG8_STAGE(PG8_SB(0, 1), b2 + hstep, voffB); PG8_STAGE(PG8_SA(0, 0), a2, voffA);
            PG8_WAIT_V(8); PG8_WAIT_L(0); PG8_BAR; PG8_MMA(1, 0, At, B0); PG8_MMA(1, 1, At, B1); PG8_BAR; PG8_SCHED;
            PG8_LDB(B0, 1, 0); PG8_LDB(B1, 1, 1); PG8_SCHED; PG8_LDA(At, 1, 0); PG8_STAGE(PG8_SA(0, 1), a2 + hstep, voffA);
            PG8_WAIT_V(8); PG8_WAIT_L(0); PG8_BAR; PG8_MMA(0, 0, At, B0); PG8_MMA(0, 1, At, B1); PG8_BAR; PG8_SCHED;
            PG8_LDA(At, 1, 1); PG8_STAGE(PG8_SB(1, 0), b3, voffB); PG8_STAGE(PG8_SB(1, 1), b3 + hstep, voffB); PG8_STAGE(PG8_SA(1, 0), a3, voffA);
            PG8_WAIT_V(8); PG8_WAIT_L(0); PG8_BAR; PG8_MMA(1, 0, At, B0); PG8_MMA(1, 1, At, B1); PG8_BAR; PG8_SCHED;
            } else {
            PG8_LDB(B0, 0, 0); PG8_SCHED; PG8_LDA(At, 0, 0); PG8_STAGE(PG8_SA(1, 1), a1 + hstep, voffA);
            PG8_WAIT_L(8); PG8_BAR; PG8_WAIT_L(0); PG8_MMA(0, 0, At, B0); PG8_BAR; PG8_SCHED;
            PG8_LDB(B1, 0, 1); PG8_STAGE(PG8_SB(0, 0), b2, voffB);
            PG8_BAR; PG8_WAIT_L(0); PG8_MMA(0, 1, At, B1); PG8_BAR;
            PG8_LDA(At, 0, 1); PG8_STAGE(PG8_SA(0, 0), a2, voffA);
            PG8_BAR; PG8_WAIT_L(0); PG8_MMA(1, 0, At, B0); PG8_BAR; PG8_SCHED;
            PG8_STAGE(PG8_SB(0, 1), b2 + hstep, voffB);
            PG8_WAIT_V(6); PG8_BAR; PG8_MMA(1, 1, At, B1); PG8_BAR;
            PG8_LDB(B0, 1, 0); PG8_SCHED; PG8_LDA(At, 1, 0); PG8_STAGE(PG8_SA(0, 1), a2 + hstep, voffA);
            PG8_WAIT_L(8); PG8_BAR; PG8_WAIT_L(0); PG8_MMA(0, 0, At, B0); PG8_BAR; PG8_SCHED;
            PG8_LDB(B1, 1, 1); PG8_STAGE(PG8_SB(1, 0), b3, voffB);
            PG8_BAR; PG8_WAIT_L(0); PG8_MMA(0, 1, At, B1); PG8_BAR;
            PG8_LDA(At, 1, 1); PG8_STAGE(PG8_SA(1, 0), a3, voffA);
            PG8_BAR; PG8_WAIT_L(0); PG8_MMA(1, 0, At, B0); PG8_BAR; PG8_SCHED;
            PG8_STAGE(PG8_SB(1, 1), b3 + hstep, voffB);
            PG8_WAIT_V(6); PG8_BAR; PG8_MMA(1, 1, At, B1); PG8_BAR;
            }
        }
        if constexpr (ALIGN_EPI) { if (wr == 0) PG8_BAR; }
        if constexpr (!Epi::AFTER_DRAIN) { E(acc, cur, wr, wc, fr, fq); S.done(cur); }
        if (!has_next) break;
#pragma unroll
        for (int a = 0; a < 2; ++a)
#pragma unroll
            for (int b = 0; b < 2; ++b)
#pragma unroll
                for (int m = 0; m < 4; ++m)
#pragma unroll
                    for (int n = 0; n < 2; ++n) acc[a][b][m][n] = (f32x4){0.f, 0.f, 0.f, 0.f};
        cur = nxt; cA = nA; cB = nB; ++ui;
        if constexpr (ALIGN_EPI) { if (wr == 1) PG8_BAR; }
    }
    PG8_WAIT_V(0);
    if constexpr (!ALIGN_EPI) { if (wr == 0) PG8_BAR; }
    PG8_BAR;
    if constexpr (Epi::AFTER_DRAIN) { E.fused(acc, cur, wr, wc, fr, fq, lds, wid, lane); S.done(cur); }
#undef PG8_SA
#undef PG8_SB
#undef PG8_STAGE
#undef PG8_LDA
#undef PG8_LDB
#undef PG8_MMA
#undef PG8_WAIT_V
#undef PG8_WAIT_L
#undef PG8_BAR
#undef PG8_SCHED
}
}

#define GAS __attribute__((address_space(1)))
#define LAS __attribute__((address_space(3)))
typedef unsigned short bf16;
typedef unsigned v4u __attribute__((ext_vector_type(4)));
typedef unsigned v2u __attribute__((ext_vector_type(2)));
typedef float f32x4 __attribute__((ext_vector_type(4)));
typedef float f32x16 __attribute__((ext_vector_type(16)));
typedef short bf16x8 __attribute__((ext_vector_type(8)));
typedef GAS unsigned gu32;
#define RLX_AGENT __ATOMIC_RELAXED, __HIP_MEMORY_SCOPE_AGENT
#define LDS_WAIT() asm volatile("s_waitcnt lgkmcnt(0)" ::: "memory")
#define VM_WAIT() asm volatile("s_waitcnt vmcnt(0)" ::: "memory")

constexpr int NWAVES = 8, NTHR = 512;
constexpr int BATCH = 2, SEQ = 4096, T = BATCH * SEQ, D = 2048, C = 1024, NH = 16, HD = 64;
constexpr int AH = 8, AD = 128, MB = 256, NBLK = SEQ / MB;
constexpr int NSHIFT = 3328, NIN = 6400, NZ = 6656, FF = 8192;
constexpr int ZQ = 3328, ZK = 4352, ZV = 5376, ZVD = 6400;
constexpr int DEPTH = 2;
constexpr float NORM_EPS = 1e-6f, LNX_EPS = 64e-5f;

constexpr size_t MiB = 1u << 20;
constexpr size_t WS_CTL = 0, CTL_ZERO_BYTES = 1 * MiB;
constexpr size_t WS_WIN = 1 * MiB, WS_WOUT = 27 * MiB, WS_WUP = 35 * MiB, WS_WDN = 67 * MiB;
constexpr size_t WS_VF = 99 * MiB;
constexpr size_t WS_HN = 131 * MiB;
constexpr size_t WS_YC = 163 * MiB;
constexpr size_t WS_Z = 195 * MiB;
constexpr size_t WS_SR = 299 * MiB, WS_SK = 315 * MiB, WS_SV = 331 * MiB, WS_SKK = 347 * MiB, WS_SA = 363 * MiB;
constexpr size_t WS_SW = 379 * MiB;
constexpr size_t WS_SG = 411 * MiB;
constexpr size_t WS_AQ = 427 * MiB, WS_AK = 443 * MiB, WS_AVT = 459 * MiB;
constexpr size_t WS_KM = 475 * MiB;
constexpr size_t WS_U = 195 * MiB;
constexpr size_t WS_Y2 = 195 * MiB;
constexpr size_t WS_M = 131 * MiB;
constexpr size_t WS_END = 476 * MiB;
constexpr int CW_BAR = 4096;

constexpr int RING_BYTES = 131072;
constexpr int LDSCTL_OFF = RING_BYTES, MISC_OFF = LDSCTL_OFF + 320;
constexpr int LDS_BYTES = 147456;
constexpr int PTAB_OFF = MISC_OFF + 128;

__device__ __forceinline__ unsigned f2bf(float f) { unsigned u = __builtin_bit_cast(unsigned, f); return (u + 0x7fffu + ((u >> 16) & 1u)) >> 16; }
__device__ __forceinline__ unsigned pk2(float lo, float hi) { return f2bf(lo) | (f2bf(hi) << 16); }
__device__ __forceinline__ float bf2f(unsigned short b) { return __builtin_bit_cast(float, (unsigned)b << 16); }
__device__ __forceinline__ float bflo(unsigned w) { return __builtin_bit_cast(float, w << 16); }
__device__ __forceinline__ float bfhi(unsigned w) { return __builtin_bit_cast(float, w & 0xffff0000u); }

#define XB_TMO      128
#define XB_XCNT(j)  (256  + 64 * (j))
#define XB_XSUB(j)  (1280 + 64 * (j))
#define XB_XGEN(j)  (2304 + 64 * (j))
#define XB_TOP      3328
#define XB_TOPGEN   3392
#define XCD_BAR_WORDS 3456
#define XB_SPIN_CAP (1u << 20)
__device__ __forceinline__ unsigned xb_ld(unsigned* p)              { return __hip_atomic_load(p, __ATOMIC_RELAXED, __HIP_MEMORY_SCOPE_AGENT); }
__device__ __forceinline__ unsigned xb_add(unsigned* p, unsigned v) { return __hip_atomic_fetch_add(p, v, __ATOMIC_RELAXED, __HIP_MEMORY_SCOPE_AGENT); }
__device__ __forceinline__ unsigned xb_xcc_id() { return (unsigned)__builtin_amdgcn_s_getreg((3 << 11) | 20) & 0xFu; }
#define XB_SPIN(cond, bar) do { unsigned _sp = 0; while (cond) { __builtin_amdgcn_s_sleep(1); \
    if ((++_sp & 255u) == 0u) { if (xb_ld(&(bar)[XB_TMO])) break; if (_sp > XB_SPIN_CAP) { atomicAdd(&(bar)[XB_TMO], 1u); break; } } } } while (0)
struct XcdBarrier { unsigned* bar; unsigned x; volatile LAS unsigned* st; };
__device__ __forceinline__ XcdBarrier xcd_barrier_post(unsigned* bar, volatile LAS unsigned* st) {
    XcdBarrier b; b.bar = bar; b.x = xb_xcc_id(); b.st = st;
    if (threadIdx.x == 0) (void)xb_add(&bar[XB_XCNT(b.x)], 1u);
    return b;
}
__device__ __forceinline__ void xcd_barrier_complete(unsigned* bar, unsigned x, unsigned& nloc, unsigned& nx) {
    const unsigned G = gridDim.x * gridDim.y * gridDim.z;
    unsigned sum, cnt, mine, sp = 0u;
    for (;;) {
        sum = 0u; cnt = 0u; mine = 0u;
#pragma unroll
        for (unsigned j = 0; j < 16; ++j) { const unsigned c = xb_ld(&bar[XB_XCNT(j)]); sum += c; cnt += (c > 0u) ? 1u : 0u; mine = (j == x) ? c : mine; }
        if (sum == G) break;
        __builtin_amdgcn_s_sleep(1);
        if ((++sp & 255u) == 0u) { if (xb_ld(&bar[XB_TMO])) break; if (sp > XB_SPIN_CAP) { atomicAdd(&bar[XB_TMO], 1u); break; } }
    }
    nloc = mine > 0u ? mine : 1u; nx = cnt > 0u ? cnt : 1u;
}
__device__ __forceinline__ void xcd_barrier(const XcdBarrier& b) {
    asm volatile("s_waitcnt vmcnt(0)" ::: "memory");
    __syncthreads();
    if (threadIdx.x == 0) {
        unsigned* bar = b.bar;
        __builtin_amdgcn_s_waitcnt(0);
        unsigned nloc = b.st[0], nx = b.st[1];
        if (nloc == 0u) { xcd_barrier_complete(bar, b.x, nloc, nx); b.st[0] = nloc; b.st[1] = nx; }
        const unsigned old = xb_add(&bar[XB_XSUB(b.x)], 1u);
        const unsigned gen = old / nloc;
        if (old + 1u == (gen + 1u) * nloc) {
            __builtin_amdgcn_fence(__ATOMIC_RELEASE, "agent");
            asm volatile("s_waitcnt vmcnt(0)" ::: "memory");
            const unsigned og = xb_add(&bar[XB_TOP], 1u);
            const unsigned tg = og / nx;
            if (og + 1u == (tg + 1u) * nx) xb_add(&bar[XB_TOPGEN], 1u);
            else XB_SPIN(xb_ld(&bar[XB_TOPGEN]) == tg, bar);
            __builtin_amdgcn_fence(__ATOMIC_ACQUIRE, "agent");
            xb_add(&bar[XB_XGEN(b.x)], 1u);
            asm volatile("s_waitcnt vmcnt(0)" ::: "memory");
        } else {
            XB_SPIN(xb_ld(&bar[XB_XGEN(b.x)]) == gen, bar);
            __builtin_amdgcn_fence(__ATOMIC_ACQUIRE, "agent");
            asm volatile("s_waitcnt vmcnt(0)" ::: "memory");
        }
    }
    __syncthreads();
}

struct Frame {
    LAS unsigned char* lds;
    volatile LAS unsigned* MISC;
    gu32* ctl;
    int tid, lane, wave, vcu, G;
    float* out;
    unsigned char* ws;
};
enum { I_X = 0, I_NMIXPRE, I_NMIXPOST, I_NMLPPRE, I_NMLPPOST, I_WIN, I_WINV, I_MU, I_MUV, I_W0, I_W2, I_A0, I_A2, I_V0, I_V2, I_G2, I_KK, I_KA, I_RK, I_LNG, I_LNB, I_WOUT, I_WUP, I_WDN };

__device__ __forceinline__ const float* inp_(const Frame& F, int i) {
    const unsigned long long v = *(const LAS unsigned long long*)(F.lds + PTAB_OFF + 8 * i);
    const unsigned lo = __builtin_amdgcn_readfirstlane((unsigned)v), hi = __builtin_amdgcn_readfirstlane((unsigned)(v >> 32));
    return (const float*)(((unsigned long long)hi << 32) | lo);
}
#define INP(i) inp_(F, (i))
__device__ __forceinline__ float wave_sum(float v) {
#pragma unroll
    for (int o = 1; o < 64; o <<= 1) v += __shfl_xor(v, o);
    return v;
}
__device__ __forceinline__ void transpose_item(const float* W, int K, int N, bf16* WT, int row_off, LAS float* scr, int item, int lane) {
    const int nblk = N / 32, kb = item / nblk, nb = item % nblk, k0 = 64 * kb, n0 = 32 * nb;
#pragma unroll 8
    for (int i = 0; i < 32; ++i) { const int kk = 2 * i + (lane >> 5); scr[kk * 33 + (lane & 31)] = W[(size_t)(k0 + kk) * N + n0 + (lane & 31)]; }
    LDS_WAIT(); asm volatile("" ::: "memory");
    const int c = lane & 7;
#pragma unroll
    for (int j = 0; j < 4; ++j) { const int n = (lane >> 3) + 8 * j; const LAS float* s = scr + (8 * c) * 33 + n;
        v4u o; o.x = pk2(s[0 * 33], s[1 * 33]); o.y = pk2(s[2 * 33], s[3 * 33]); o.z = pk2(s[4 * 33], s[5 * 33]); o.w = pk2(s[6 * 33], s[7 * 33]);
        *(GAS v4u*)(WT + (size_t)(row_off + n0 + n) * K + k0 + 8 * c) = o; }
    LDS_WAIT(); asm volatile("" ::: "memory");
}
__device__ __forceinline__ void rmsnorm_row_to_bf16(const float* xrow, const float* gain, bf16* orow, int lane) {
    const GAS f32x4* xr = (const GAS f32x4*)xrow + lane; const GAS f32x4* gr = (const GAS f32x4*)gain + lane;
    f32x4 v[8]; float s = 0.f;
#pragma unroll
    for (int j = 0; j < 8; ++j) { v[j] = xr[64 * j]; s += (v[j].x * v[j].x + v[j].y * v[j].y) + (v[j].z * v[j].z + v[j].w * v[j].w); }
    const float rs = 1.0f / sqrtf(wave_sum(s) * (1.f / D) + NORM_EPS);
    GAS v2u* o8 = (GAS v2u*)orow + lane;
#pragma unroll
    for (int j = 0; j < 8; ++j) { const f32x4 g = gr[64 * j]; v2u w; w.x = pk2(v[j].x * rs * g.x, v[j].y * rs * g.y); w.y = pk2(v[j].z * rs * g.z, v[j].w * rs * g.w); o8[64 * j] = w; }
}
__device__ __forceinline__ void ph_convert(Frame& F, int L) {
    LAS float* scr = (LAS float*)(F.lds + F.wave * 16384);
    const int gw = F.vcu * NWAVES + F.wave, NGW = F.G * NWAVES;
    bf16* WinT = (bf16*)(F.ws + WS_WIN); bf16* WoutT = (bf16*)(F.ws + WS_WOUT); bf16* WupT = (bf16*)(F.ws + WS_WUP); bf16* WdnT = (bf16*)(F.ws + WS_WDN);
    constexpr int I_IN = (D / 64) * (NIN / 32), I_VR = (D / 64), I_OUT = (D / 64) * (D / 32), I_UP = (D / 64) * (FF / 32), I_DN = (FF / 64) * (D / 32);
    const int nvr = (L > 0) ? I_VR : 0;
    const int NITEMS = I_IN + nvr + I_OUT + I_UP + I_DN;
    for (int it = gw; it < NITEMS; it += NGW) {
        int r = it;
        if (r < I_IN) { transpose_item(INP(I_WIN) + (size_t)L * D * NIN, D, NIN, WinT, 0, scr, r, F.lane); continue; } r -= I_IN;
        if (r < nvr) { transpose_item(INP(I_WINV) + (size_t)(L - 1) * D * 32, D, 32, WinT, NIN, scr, r, F.lane); continue; } r -= nvr;
        if (r < I_OUT) { transpose_item(INP(I_WOUT) + (size_t)L * D * D, D, D, WoutT, 0, scr, r, F.lane); continue; } r -= I_OUT;
        if (r < I_UP) { transpose_item(INP(I_WUP) + (size_t)L * D * FF, D, FF, WupT, 0, scr, r, F.lane); continue; } r -= I_UP;
        transpose_item(INP(I_WDN) + (size_t)L * FF * D, FF, D, WdnT, 0, scr, r, F.lane);
    }
    if (L > 0) {
        const int gt = F.vcu * NTHR + F.tid, NGT = F.G * NTHR;
        for (int i = gt; i < (NZ - NIN - 32) * (D / 8); i += NGT) *(GAS v4u*)(WinT + (size_t)(NIN + 32) * D + (size_t)i * 8) = (v4u){0u, 0u, 0u, 0u};
    }
    if (L == 0) {
        bf16* HN = (bf16*)(F.ws + WS_HN);
        for (int m = gw; m < T; m += NGW) rmsnorm_row_to_bf16(INP(I_X) + (size_t)m * D, INP(I_NMIXPRE), HN + (size_t)m * D, F.lane);
    }
}
__device__ __forceinline__ void ph_resnorm(Frame& F, const float* y, const float* xin, const float* gA, const float* gB, float* xout, bf16* hn) {
    const int gw = F.vcu * NWAVES + F.wave, NGW = F.G * NWAVES;
    for (int m = gw; m < T; m += NGW) {
        const GAS f32x4* yr = (const GAS f32x4*)(y + (size_t)m * D) + F.lane; const GAS f32x4* xr = (const GAS f32x4*)(xin + (size_t)m * D) + F.lane;
        const GAS f32x4* ga = (const GAS f32x4*)gA + F.lane;
        f32x4 v[8]; float s = 0.f;
#pragma unroll
        for (int j = 0; j < 8; ++j) { v[j] = yr[64 * j]; s += (v[j].x * v[j].x + v[j].y * v[j].y) + (v[j].z * v[j].z + v[j].w * v[j].w); }
        const float rs = 1.0f / sqrtf(wave_sum(s) * (1.f / D) + NORM_EPS);
        float s2 = 0.f;
        GAS f32x4* xo = (GAS f32x4*)(xout + (size_t)m * D) + F.lane;
#pragma unroll
        for (int j = 0; j < 8; ++j) { const f32x4 g = ga[64 * j]; const f32x4 x = xr[64 * j];
            v[j].x = x.x + v[j].x * rs * g.x; v[j].y = x.y + v[j].y * rs * g.y; v[j].z = x.z + v[j].z * rs * g.z; v[j].w = x.w + v[j].w * rs * g.w;
            xo[64 * j] = v[j]; s2 += (v[j].x * v[j].x + v[j].y * v[j].y) + (v[j].z * v[j].z + v[j].w * v[j].w); }
        if (gB) {
            const float rs2 = 1.0f / sqrtf(wave_sum(s2) * (1.f / D) + NORM_EPS);
            const GAS f32x4* gb = (const GAS f32x4*)gB + F.lane; GAS v2u* o8 = (GAS v2u*)(hn + (size_t)m * D) + F.lane;
#pragma unroll
            for (int j = 0; j < 8; ++j) { const f32x4 g = gb[64 * j]; v2u w; w.x = pk2(v[j].x * rs2 * g.x, v[j].y * rs2 * g.y); w.y = pk2(v[j].z * rs2 * g.z, v[j].w * rs2 * g.w); o8[64 * j] = w; }
        }
    }
}
__device__ __forceinline__ float sigmoidf_(float x) { return 1.0f / (1.0f + __expf(-x)); }
__device__ __forceinline__ float softplusf_(float x) { return fmaxf(x, 0.f) + log1pf(__expf(-fabsf(x))); }

__device__ __forceinline__ void prep_rwkv_unit(Frame& F, int L, int unit) {
    const bf16* Z = (const bf16*)(F.ws + WS_Z);
    LAS float* xl = (LAS float*)F.lds;
    const int t0 = unit * 16, tid = F.tid;
    const float* mu = INP(I_MU) + (size_t)L * NSHIFT;
    __syncthreads();
    for (int e = tid; e < 288 * 16; e += NTHR) {
        const int j = e >> 4, tt = e & 15, t = t0 + tt, s = t & (SEQ - 1);
        float f = 0.f;
        if (j < 256 || L > 0) {
            const int col = (j < 256) ? (3072 + j) : (ZVD + (j - 256));
            const float m_ = (j < 256) ? mu[col] : INP(I_MUV)[(size_t)(L - 1) * 32 + (j - 256)];
            const float zc = bf2f(Z[(size_t)t * NZ + col]); const float zp = s ? bf2f(Z[(size_t)(t - 1) * NZ + col]) : 0.f;
            const float zs = zc + (zp - zc) * m_;
            f = (j < 64) ? tanhf(zs) : ((j < 128) ? zs : ((j < 256) ? sigmoidf_(zs) : zs));
        }
        xl[j * 16 + tt] = f;
    }
    __syncthreads();
    const float* w0 = INP(I_W0) + (size_t)L * C; const float* w2 = INP(I_W2) + (size_t)L * 64 * C;
    const float* a0 = INP(I_A0) + (size_t)L * C; const float* a2 = INP(I_A2) + (size_t)L * 64 * C;
    const float* g2 = INP(I_G2) + (size_t)L * 128 * C;
    const float* v0 = INP(I_V0) + (size_t)(L > 0 ? L - 1 : 0) * C; const float* v2 = INP(I_V2) + (size_t)(L > 0 ? L - 1 : 0) * 32 * C;
    const float* kkw = INP(I_KK) + (size_t)L * C; const float* kaw = INP(I_KA) + (size_t)L * C;
    bf16* SR = (bf16*)(F.ws + WS_SR); bf16* SK = (bf16*)(F.ws + WS_SK); bf16* SV = (bf16*)(F.ws + WS_SV); bf16* SKK = (bf16*)(F.ws + WS_SKK); bf16* SA = (bf16*)(F.ws + WS_SA);
    float* SW = (float*)(F.ws + WS_SW); bf16* SG = (bf16*)(F.ws + WS_SG); float* VF = (float*)(F.ws + WS_VF);
    for (int cc = 0; cc < 2; ++cc) {
        const int c = tid + 512 * cc;
        float dec[16], av[16], gv[16], sv[16];
        {   float acc[16];
#pragma unroll
            for (int tt = 0; tt < 16; ++tt) acc[tt] = w0[c];
            for (int j = 0; j < 64; ++j) { const float wv = w2[(size_t)j * C + c]; const LAS f32x4* xp = (const LAS f32x4*)(xl + j * 16);
#pragma unroll
                for (int q = 0; q < 4; ++q) { const f32x4 x = xp[q]; acc[4 * q] += x.x * wv; acc[4 * q + 1] += x.y * wv; acc[4 * q + 2] += x.z * wv; acc[4 * q + 3] += x.w * wv; } }
#pragma unroll
            for (int tt = 0; tt < 16; ++tt) { const float wl = -softplusf_(-acc[tt]) - 0.5f; dec[tt] = -__expf(wl); }
        }
        {   float acc[16];
#pragma unroll
            for (int tt = 0; tt < 16; ++tt) acc[tt] = a0[c];
            for (int j = 0; j < 64; ++j) { const float wv = a2[(size_t)j * C + c]; const LAS f32x4* xp = (const LAS f32x4*)(xl + (64 + j) * 16);
#pragma unroll
                for (int q = 0; q < 4; ++q) { const f32x4 x = xp[q]; acc[4 * q] += x.x * wv; acc[4 * q + 1] += x.y * wv; acc[4 * q + 2] += x.z * wv; acc[4 * q + 3] += x.w * wv; } }
#pragma unroll
            for (int tt = 0; tt < 16; ++tt) av[tt] = sigmoidf_(acc[tt]);
        }
        {   float acc[16];
#pragma unroll
            for (int tt = 0; tt < 16; ++tt) acc[tt] = 0.f;
            for (int j = 0; j < 128; ++j) { const float wv = g2[(size_t)j * C + c]; const LAS f32x4* xp = (const LAS f32x4*)(xl + (128 + j) * 16);
#pragma unroll
                for (int q = 0; q < 4; ++q) { const f32x4 x = xp[q]; acc[4 * q] += x.x * wv; acc[4 * q + 1] += x.y * wv; acc[4 * q + 2] += x.z * wv; acc[4 * q + 3] += x.w * wv; } }
#pragma unroll
            for (int tt = 0; tt < 16; ++tt) gv[tt] = acc[tt];
        }
        if (L > 0) {   float acc[16];
#pragma unroll
            for (int tt = 0; tt < 16; ++tt) acc[tt] = v0[c];
            for (int j = 0; j < 32; ++j) { const float wv = v2[(size_t)j * C + c]; const LAS f32x4* xp = (const LAS f32x4*)(xl + (256 + j) * 16);
#pragma unroll
                for (int q = 0; q < 4; ++q) { const f32x4 x = xp[q]; acc[4 * q] += x.x * wv; acc[4 * q + 1] += x.y * wv; acc[4 * q + 2] += x.z * wv; acc[4 * q + 3] += x.w * wv; } }
#pragma unroll
            for (int tt = 0; tt < 16; ++tt) sv[tt] = sigmoidf_(acc[tt]);
        } else {
#pragma unroll
            for (int tt = 0; tt < 16; ++tt) sv[tt] = 0.f;
        }
        const float mur = mu[c], muk = mu[C + c], muv = mu[2 * C + c], kkc = kkw[c], kac = kaw[c];
        float zpr, zpk, zpv;
        { const int s0 = t0 & (SEQ - 1);
          if (s0) { const bf16* zp = Z + (size_t)(t0 - 1) * NZ; zpr = bf2f(zp[c]); zpk = bf2f(zp[C + c]); zpv = bf2f(zp[2 * C + c]); } else { zpr = zpk = zpv = 0.f; } }
#pragma unroll
        for (int tt = 0; tt < 16; ++tt) {
            const int t = t0 + tt; const bf16* zc = Z + (size_t)t * NZ;
            const float zr = bf2f(zc[c]), zk = bf2f(zc[C + c]), zv = bf2f(zc[2 * C + c]);
            const float r = zr + (zpr - zr) * mur, k = zk + (zpk - zk) * muk; float v = zv + (zpv - zv) * muv;
            zpr = zr; zpk = zk; zpv = zv;
            const size_t o = (size_t)t * C + c;
            if (L == 0) VF[o] = v; else v = v + (VF[o] - v) * sv[tt];
            float kk = k * kkc; const float ss = wave_sum(kk * kk); kk = kk / fmaxf(sqrtf(ss), 1e-12f);
            const float k2 = k * (1.f + (av[tt] - 1.f) * kac);
            SR[o] = (bf16)f2bf(r); SK[o] = (bf16)f2bf(k2); SV[o] = (bf16)f2bf(v); SKK[o] = (bf16)f2bf(kk); SA[o] = (bf16)f2bf(av[tt]); SW[o] = dec[tt]; SG[o] = (bf16)f2bf(gv[tt]);
        }
    }
}
__device__ __forceinline__ void prep_attn_unit(Frame& F, int u) {
    const bf16* Z = (const bf16*)(F.ws + WS_Z);
    bf16* AQ = (bf16*)(F.ws + WS_AQ); bf16* AKp = (bf16*)(F.ws + WS_AK); bf16* AVT = (bf16*)(F.ws + WS_AVT); float* KM = (float*)(F.ws + WS_KM);
    const int b = u / (NBLK * AH), rem = u % (NBLK * AH), blk = rem / AH, h = rem % AH;
    const int tid = F.tid, d = tid & 63, tw = tid >> 6;
    const int tb = b * SEQ + blk * MB;
    LAS float* red = (LAS float*)F.lds;
    LAS bf16* vt = (LAS bf16*)(F.lds + 4096);
    __syncthreads();
    const float inv_freq = exp2f(-(float)d * (13.287712379549449f / 64.0f));
    float ks0 = 0.f, ks1 = 0.f;
    for (int i = 0; i < 32; ++i) {
        const int tok = tw + 8 * i; const int s = blk * MB + tok; const size_t t = (size_t)(tb + tok);
        float sn, cs; sincosf((float)s * inv_freq, &sn, &cs);
        const bf16* zq = Z + t * NZ + ZQ + h * AD; const bf16* zk = Z + t * NZ + ZK + h * AD;
        const float q1 = bf2f(zq[d]), q2 = bf2f(zq[d + 64]), k1 = bf2f(zk[d]), k2 = bf2f(zk[d + 64]);
        const float q1r = q1 * cs - q2 * sn, q2r = q2 * cs + q1 * sn, k1r = k1 * cs - k2 * sn, k2r = k2 * cs + k1 * sn;
        AQ[t * C + h * AD + d] = (bf16)f2bf(q1r); AQ[t * C + h * AD + 64 + d] = (bf16)f2bf(q2r);
        AKp[t * C + h * AD + d] = (bf16)f2bf(k1r); AKp[t * C + h * AD + 64 + d] = (bf16)f2bf(k2r);
        ks0 += k1r; ks1 += k2r;
    }
    red[tw * 128 + d] = ks0; red[tw * 128 + 64 + d] = ks1;
    for (int i = 0; i < 64; ++i) { const int idx = tid + NTHR * i; const int tok = idx >> 7, dd = idx & 127;
        vt[dd * 264 + tok] = Z[(size_t)(tb + tok) * NZ + ZV + h * AD + dd]; }
    __syncthreads();
    if (tid < 128) { float s = 0.f;
#pragma unroll
        for (int w = 0; w < 8; ++w) s += red[w * 128 + tid];
        KM[((size_t)(b * AH + h) * NBLK + blk) * AD + tid] = s * (1.0f / MB); }
    for (int i = 0; i < 8; ++i) { const int idx = tid + NTHR * i; const int dd = idx >> 5, ch = idx & 31;
        const v4u v = *(const LAS v4u*)(vt + dd * 264 + ch * 8);
        *(GAS v4u*)(AVT + ((size_t)(b * AH + h) * AD + dd) * SEQ + blk * MB + ch * 8) = v; }
}
__device__ __forceinline__ void ph_prep(Frame& F, int L) {
    for (int u = F.vcu; u < T / 16 + BATCH * NBLK * AH; u += F.G) {
        if (u < T / 16) prep_rwkv_unit(F, L, u); else prep_attn_unit(F, u - T / 16);
    }
}

typedef short bf16x4 __attribute__((ext_vector_type(4)));
constexpr int NCHK = SEQ / 64;
constexpr int NUNIT = BATCH * NH * NCHK;
constexpr int CP = 144, MATB = 64 * CP;
constexpr int L_ARA = 0, L_ARR = MATB, L_BKB = 2 * MATB, L_BKK = 3 * MATB, L_AT = 4 * MATB, L_BT = 5 * MATB, L_KT = 6 * MATB, L_VT = 7 * MATB;
constexpr int L_AAB = 8 * MATB, L_AAK = 9 * MATB, L_ARB = 10 * MATB, L_ARK = 11 * MATB, L_ND = 12 * MATB, L_TB = L_ND + 4096, L_GL = L_TB + 2048, L_SEG = L_GL + 256;
constexpr int L_W2T = L_ARA, L_PT = L_BKB, L_QT = L_BKK;
static_assert(L_SEG + 2048 <= RING_BYTES, "wkv LDS map");
constexpr size_t WS_CM = WS_Z, WS_CG = WS_CM + (size_t)NUNIT * 8192, WS_CRY = WS_CG + (size_t)NUNIT * 16384, WS_CYC = WS_CRY + (size_t)NUNIT * 8192;
static_assert(WS_CYC + (size_t)NUNIT * 16384 <= WS_SR, "chunk outputs fit the Z region");
constexpr size_t WS_CS = WS_HN;
constexpr size_t WS_BON = WS_HN + (size_t)NUNIT * 8192;
static_assert(WS_BON + (size_t)T * NH * 4 <= WS_YC, "HN region");

__device__ __forceinline__ f32x4 mfma32(bf16x8 a, bf16x8 b, f32x4 c) { return __builtin_amdgcn_mfma_f32_16x16x32_bf16(a, b, c, 0, 0, 0); }
__device__ __forceinline__ f32x4 mfma16(bf16x4 a, bf16x4 b, f32x4 c) { return __builtin_amdgcn_mfma_f32_16x16x16bf16_1k(a, b, c, 0, 0, 0); }
__device__ __forceinline__ v2u pk4(f32x4 v) { v2u w; w.x = pk2(v[0], v[1]); w.y = pk2(v[2], v[3]); return w; }

__device__ __forceinline__ void wkv_r1_unit(Frame& F, int L, int unit) {
    const int c = unit % NCHK, bh = unit / NCHK, h = bh % NH, b = bh / NH;
    const int tid = F.tid, lane = F.lane, w = F.wave, fr = lane & 15, g = lane >> 4;
    LAS unsigned char* lds = F.lds;
    const bf16* SR = (const bf16*)(F.ws + WS_SR); const bf16* SK = (const bf16*)(F.ws + WS_SK); const bf16* SV = (const bf16*)(F.ws + WS_SV);
    const bf16* SKK = (const bf16*)(F.ws + WS_SKK); const bf16* SA = (const bf16*)(F.ws + WS_SA); const float* SW = (const float*)(F.ws + WS_SW);
    const size_t tok0 = (size_t)b * SEQ + (size_t)c * 64;
    __syncthreads();
    {
        const int sg = w, j = lane;
        const float rkj = INP(I_RK)[(size_t)L * C + h * HD + j];
        float lw[8], cum[8]; unsigned short r_[8], k_[8], v_[8], kk_[8], a_[8];
#pragma unroll
        for (int e = 0; e < 8; ++e) { const size_t o = (tok0 + 8 * sg + e) * C + h * HD + j; r_[e] = SR[o]; k_[e] = SK[o]; v_[e] = SV[o]; kk_[e] = SKK[o]; a_[e] = SA[o]; lw[e] = SW[o]; }
        float run = 0.f;
#pragma unroll
        for (int e = 0; e < 8; ++e) { run += lw[e]; cum[e] = run; }
        LAS float* seg = (LAS float*)(lds + L_SEG);
        seg[sg * 64 + j] = run;
        __syncthreads();
        float off = 0.f, tot = 0.f;
#pragma unroll
        for (int s2 = 0; s2 < 8; ++s2) { const float v = seg[s2 * 64 + j]; tot += v; off += (s2 < sg) ? v : 0.f; }
        if (sg == 0) ((LAS float*)(lds + L_GL))[j] = __expf(tot);
        unsigned at8[4], bt8[4], kt8[4], vt8[4];
        float* BON = (float*)(F.ws + WS_BON);
#pragma unroll
        for (int e = 0; e < 8; ++e) {
            const float cu = cum[e] + off, ce = cu - lw[e];
            const float eC = __expf(cu), eE = __expf(ce), eN = __expf(-cu);
            const float rf = bf2f(r_[e]), kf = bf2f(k_[e]), kkf = bf2f(kk_[e]), af = bf2f(a_[e]);
            const unsigned At = f2bf(-kkf * eE), Rt = f2bf(rf * eC), Bt = f2bf(kkf * af * eN), Kt = f2bf(kf * eN);
            const int t = 8 * sg + e;
            *(LAS unsigned short*)(lds + L_ARA + t * CP + j * 2) = (unsigned short)At;
            *(LAS unsigned short*)(lds + L_ARR + t * CP + j * 2) = (unsigned short)Rt;
            *(LAS unsigned short*)(lds + L_BKB + t * CP + j * 2) = (unsigned short)Bt;
            *(LAS unsigned short*)(lds + L_BKK + t * CP + j * 2) = (unsigned short)Kt;
            if (e & 1) { at8[e >> 1] |= At << 16; bt8[e >> 1] |= Bt << 16; kt8[e >> 1] |= Kt << 16; vt8[e >> 1] |= (unsigned)v_[e] << 16; }
            else { at8[e >> 1] = At; bt8[e >> 1] = Bt; kt8[e >> 1] = Kt; vt8[e >> 1] = (unsigned)v_[e]; }
            const float bs = wave_sum(rf * kf * rkj);
            if (j == 0) BON[(tok0 + t) * NH + h] = bs;
        }
        *(LAS v4u*)(lds + L_AT + j * CP + sg * 16) = (v4u){at8[0], at8[1], at8[2], at8[3]};
        *(LAS v4u*)(lds + L_BT + j * CP + sg * 16) = (v4u){bt8[0], bt8[1], bt8[2], bt8[3]};
        *(LAS v4u*)(lds + L_KT + j * CP + sg * 16) = (v4u){kt8[0], kt8[1], kt8[2], kt8[3]};
        *(LAS v4u*)(lds + L_VT + j * CP + sg * 16) = (v4u){vt8[0], vt8[1], vt8[2], vt8[3]};
    }
    __syncthreads();
    {
        const int tq = w & 3; const bool isA = w < 4;
        const LAS unsigned char* Bsrc = lds + (isA ? L_ARA : L_ARR) + (16 * tq + fr) * CP + g * 16;
        const bf16x8 b0 = *(const LAS bf16x8*)Bsrc, b1 = *(const LAS bf16x8*)(Bsrc + 64);
        const int t = 16 * tq + fr;
#pragma unroll
        for (int mt = 0; mt < 8; ++mt) {
            const int sq = mt & 3; const bool isB = mt < 4;
            f32x4 acc = (f32x4){0.f, 0.f, 0.f, 0.f};
            if (sq <= tq) {
                const LAS unsigned char* Asrc = lds + (isB ? L_BKB : L_BKK) + (16 * sq + fr) * CP + g * 16;
                acc = mfma32(*(const LAS bf16x8*)Asrc, b0, acc);
                acc = mfma32(*(const LAS bf16x8*)(Asrc + 64), b1, acc);
            }
            const int s0 = 16 * sq + 4 * g;
#pragma unroll
            for (int i = 0; i < 4; ++i) { const bool keep = isA ? (s0 + i < t) : (s0 + i <= t); acc[i] = keep ? acc[i] : 0.f; }
            const int dst = isB ? (isA ? L_AAB : L_ARB) : (isA ? L_AAK : L_ARK);
            *(LAS v2u*)(lds + dst + t * CP + s0 * 2) = pk4(acc);
            if (isA && isB && sq == tq) *(LAS f32x4*)(lds + L_ND + tq * 1024 + fr * 64 + g * 16) = acc;
        }
    }
    __syncthreads();
    if (w == 0) {
        const int bi = lane >> 4, cc = lane & 15;
        const LAS float* Nb = (const LAS float*)(lds + L_ND + bi * 1024);
        float x[16];
#pragma unroll
        for (int r = 0; r < 16; ++r) {
            float acc = (r == cc) ? 1.f : 0.f;
#pragma unroll
            for (int kq = 0; kq < (r + 3) / 4; ++kq) { const f32x4 n4 = *(const LAS f32x4*)(Nb + r * 16 + 4 * kq);
#pragma unroll
                for (int z = 0; z < 4; ++z) if (4 * kq + z < r) acc += n4[z] * x[4 * kq + z]; }
            x[r] = acc;
            *(LAS unsigned short*)(lds + L_TB + bi * 512 + r * 32 + cc * 2) = (unsigned short)f2bf(acc);
        }
    } else {
        for (int ti = w - 1; ti < 16; ti += 7) {
            const int mt = ti >> 2, nt = ti & 3;
            const LAS unsigned char* Asrc = lds + L_AAK + (16 * mt + fr) * CP + g * 16;
            const LAS unsigned char* Bsrc = lds + L_VT + (16 * nt + fr) * CP + g * 16;
            f32x4 acc = (f32x4){0.f, 0.f, 0.f, 0.f};
            acc = mfma32(*(const LAS bf16x8*)Asrc, *(const LAS bf16x8*)Bsrc, acc);
            acc = mfma32(*(const LAS bf16x8*)(Asrc + 64), *(const LAS bf16x8*)(Bsrc + 64), acc);
            *(LAS v2u*)(lds + L_W2T + (16 * nt + fr) * CP + (16 * mt + 4 * g) * 2) = pk4(acc);
        }
    }
    __syncthreads();
    {
        const LAS unsigned char* rhs = lds + (w < 4 ? L_AT : L_W2T) + (16 * (w & 3) + fr) * CP;
        LAS unsigned char* xout = lds + (w < 4 ? L_PT : L_QT) + (16 * (w & 3) + fr) * CP;
        bf16x4 X[4];
#pragma unroll
        for (int bq = 0; bq < 4; ++bq) {
            const v2u rv = *(const LAS v2u*)(rhs + (16 * bq + 4 * g) * 2);
            f32x4 y = (f32x4){bflo(rv.x), bfhi(rv.x), bflo(rv.y), bfhi(rv.y)};
#pragma unroll
            for (int kb = 0; kb < bq; ++kb) {
                const bf16x4 nf = *(const LAS bf16x4*)(lds + L_AAB + (16 * bq + fr) * CP + (16 * kb + 4 * g) * 2);
                y = mfma16(nf, X[kb], y);
            }
            const v2u yb = pk4(y);
            const bf16x4 tf = *(const LAS bf16x4*)(lds + L_TB + bq * 512 + fr * 32 + g * 8);
            const f32x4 xr = mfma16(tf, __builtin_bit_cast(bf16x4, yb), (f32x4){0.f, 0.f, 0.f, 0.f});
            const v2u xb = pk4(xr);
            X[bq] = __builtin_bit_cast(bf16x4, xb);
            *(LAS v2u*)(xout + (16 * bq + 4 * g) * 2) = xb;
        }
    }
    __syncthreads();
    {
        const int nt = w & 3;
        const LAS float* GL = (const LAS float*)(lds + L_GL);
        if (w < 4) {
            const LAS unsigned char* Bb = lds + L_BT + (16 * nt + fr) * CP + g * 16;
            const bf16x8 bb0 = *(const LAS bf16x8*)Bb, bb1 = *(const LAS bf16x8*)(Bb + 64);
            const LAS unsigned char* Bq = lds + L_QT + (16 * nt + fr) * CP + g * 16;
            const bf16x8 bq0 = *(const LAS bf16x8*)Bq, bq1 = *(const LAS bf16x8*)(Bq + 64);
            const LAS unsigned char* Bv = lds + L_VT + (16 * nt + fr) * CP + g * 16;
            const bf16x8 bv0 = *(const LAS bf16x8*)Bv, bv1 = *(const LAS bf16x8*)(Bv + 64);
            const int jn = 16 * nt + fr; const float glj = GL[jn];
            bf16* Mg = (bf16*)(F.ws + WS_CM) + (size_t)unit * 4096;
            float* Gg = (float*)(F.ws + WS_CG) + (size_t)unit * 4096;
#pragma unroll
            for (int mt = 0; mt < 4; ++mt) {
                const LAS unsigned char* Ap = lds + L_PT + (16 * mt + fr) * CP + g * 16;
                f32x4 acc = (f32x4){0.f, 0.f, 0.f, 0.f};
                acc = mfma32(*(const LAS bf16x8*)Ap, bb0, acc); acc = mfma32(*(const LAS bf16x8*)(Ap + 64), bb1, acc);
#pragma unroll
                for (int i = 0; i < 4; ++i) acc[i] = glj * (acc[i] + ((16 * mt + 4 * g + i == jn) ? 1.f : 0.f));
                *(GAS v2u*)(Mg + jn * 64 + 16 * mt + 4 * g) = pk4(acc);
                const LAS unsigned char* Ab = lds + L_BT + (16 * mt + fr) * CP + g * 16;
                const LAS unsigned char* Ak = lds + L_KT + (16 * mt + fr) * CP + g * 16;
                f32x4 ga = (f32x4){0.f, 0.f, 0.f, 0.f};
                ga = mfma32(*(const LAS bf16x8*)Ab, bq0, ga); ga = mfma32(*(const LAS bf16x8*)(Ab + 64), bq1, ga);
                ga = mfma32(*(const LAS bf16x8*)Ak, bv0, ga); ga = mfma32(*(const LAS bf16x8*)(Ak + 64), bv1, ga);
                const f32x4 gl4 = *(const LAS f32x4*)(GL + 16 * mt + 4 * g);
                ga = ga * gl4;
                *(GAS f32x4*)(Gg + ((nt * 4 + mt) * 64 + lane) * 4) = ga;
            }
        } else {
            const LAS unsigned char* Bb = lds + L_ARB + (16 * nt + fr) * CP + g * 16;
            const bf16x8 bb0 = *(const LAS bf16x8*)Bb, bb1 = *(const LAS bf16x8*)(Bb + 64);
            const LAS unsigned char* Bk = lds + L_ARK + (16 * nt + fr) * CP + g * 16;
            const bf16x8 bk0 = *(const LAS bf16x8*)Bk, bk1 = *(const LAS bf16x8*)(Bk + 64);
            const int tn = 16 * nt + fr;
            bf16* Ryg = (bf16*)(F.ws + WS_CRY) + (size_t)unit * 4096;
            float* Ycg = (float*)(F.ws + WS_CYC) + (size_t)unit * 4096;
#pragma unroll
            for (int mt = 0; mt < 4; ++mt) {
                const LAS unsigned char* Ap = lds + L_PT + (16 * mt + fr) * CP + g * 16;
                const v2u rv = *(const LAS v2u*)(lds + L_ARR + tn * CP + (16 * mt + 4 * g) * 2);
                f32x4 acc = (f32x4){bflo(rv.x), bfhi(rv.x), bflo(rv.y), bfhi(rv.y)};
                acc = mfma32(*(const LAS bf16x8*)Ap, bb0, acc); acc = mfma32(*(const LAS bf16x8*)(Ap + 64), bb1, acc);
                *(GAS v2u*)(Ryg + tn * 64 + 16 * mt + 4 * g) = pk4(acc);
                const LAS unsigned char* Aq = lds + L_QT + (16 * mt + fr) * CP + g * 16;
                const LAS unsigned char* Av = lds + L_VT + (16 * mt + fr) * CP + g * 16;
                f32x4 ya = (f32x4){0.f, 0.f, 0.f, 0.f};
                ya = mfma32(*(const LAS bf16x8*)Aq, bb0, ya); ya = mfma32(*(const LAS bf16x8*)(Aq + 64), bb1, ya);
                ya = mfma32(*(const LAS bf16x8*)Av, bk0, ya); ya = mfma32(*(const LAS bf16x8*)(Av + 64), bk1, ya);
                *(GAS f32x4*)(Ycg + ((mt * 4 + nt) * 64 + lane) * 4) = ya;
            }
        }
    }
}
__device__ __forceinline__ void wkv_r2_wave(Frame& F, int bh, int nt) {
    const int lane = F.lane, fr = lane & 15, g = lane >> 4;
    const bf16* Mg = (const bf16*)(F.ws + WS_CM) + (size_t)bh * NCHK * 4096;
    const float* Gg = (const float*)(F.ws + WS_CG) + (size_t)bh * NCHK * 4096;
    bf16* Sg = (bf16*)(F.ws + WS_CS) + (size_t)bh * NCHK * 4096;
    f32x4 S[4];
#pragma unroll
    for (int mt = 0; mt < 4; ++mt) S[mt] = (f32x4){0.f, 0.f, 0.f, 0.f};
    v2u mA[4][2][2]; f32x4 gC[4];
#define R2_LOAD(cidx) do { const bf16* Mc_ = Mg + (size_t)(cidx) * 4096; const float* Gc_ = Gg + (size_t)(cidx) * 4096; \
        _Pragma("unroll") for (int mt = 0; mt < 4; ++mt) { gC[mt] = *(const GAS f32x4*)(Gc_ + ((nt * 4 + mt) * 64 + lane) * 4); \
            _Pragma("unroll") for (int ks = 0; ks < 2; ++ks) { const bf16* mp = Mc_ + (16 * mt + fr) * 64 + 32 * ks + 4 * g; mA[mt][ks][0] = *(const GAS v2u*)mp; mA[mt][ks][1] = *(const GAS v2u*)(mp + 16); } } } while (0)
    R2_LOAD(0);
    for (int c = 0; c < NCHK; ++c) {
        v2u sb[4];
#pragma unroll
        for (int mt = 0; mt < 4; ++mt) { sb[mt] = pk4(S[mt]); *(GAS v2u*)(Sg + (size_t)c * 4096 + (16 * nt + fr) * 64 + 16 * mt + 4 * g) = sb[mt]; }
        const bf16x8 bf0 = __builtin_bit_cast(bf16x8, (v4u){sb[0].x, sb[0].y, sb[1].x, sb[1].y});
        const bf16x8 bf1 = __builtin_bit_cast(bf16x8, (v4u){sb[2].x, sb[2].y, sb[3].x, sb[3].y});
        f32x4 Sn[4];
#pragma unroll
        for (int mt = 0; mt < 4; ++mt) {
            const bf16x8 a0 = __builtin_bit_cast(bf16x8, (v4u){mA[mt][0][0].x, mA[mt][0][0].y, mA[mt][0][1].x, mA[mt][0][1].y});
            const bf16x8 a1 = __builtin_bit_cast(bf16x8, (v4u){mA[mt][1][0].x, mA[mt][1][0].y, mA[mt][1][1].x, mA[mt][1][1].y});
            Sn[mt] = mfma32(a0, bf0, gC[mt]); Sn[mt] = mfma32(a1, bf1, Sn[mt]);
        }
        if (c + 1 < NCHK) R2_LOAD(c + 1);
#pragma unroll
        for (int mt = 0; mt < 4; ++mt) S[mt] = Sn[mt];
    }
#undef R2_LOAD
}
__device__ __forceinline__ void wkv_r3_wave(Frame& F, int L, int unit) {
    const int c = unit % NCHK, bh = unit / NCHK, h = bh % NH, b = bh / NH;
    const int lane = F.lane, fr = lane & 15, g = lane >> 4;
    const bf16* Sg = (const bf16*)(F.ws + WS_CS) + (size_t)unit * 4096;
    const bf16* Ryg = (const bf16*)(F.ws + WS_CRY) + (size_t)unit * 4096;
    const float* Ycg = (const float*)(F.ws + WS_CYC) + (size_t)unit * 4096;
    const bf16* SV = (const bf16*)(F.ws + WS_SV); const bf16* SG = (const bf16*)(F.ws + WS_SG); const float* BON = (const float*)(F.ws + WS_BON);
    bf16* YC = (bf16*)(F.ws + WS_YC);
    const float* lg = INP(I_LNG) + (size_t)L * C + h * HD; const float* lb = INP(I_LNB) + (size_t)L * C + h * HD;
    const size_t tok0 = (size_t)b * SEQ + (size_t)c * 64;
    bf16x8 sa[4][2];
#pragma unroll
    for (int mt = 0; mt < 4; ++mt)
#pragma unroll
        for (int ks = 0; ks < 2; ++ks) sa[mt][ks] = *(const GAS bf16x8*)(Sg + (16 * mt + fr) * 64 + 32 * ks + 8 * g);
    f32x4 lgv[4], lbv[4];
#pragma unroll
    for (int mt = 0; mt < 4; ++mt) { lgv[mt] = *(const GAS f32x4*)(lg + 16 * mt + 4 * g); lbv[mt] = *(const GAS f32x4*)(lb + 16 * mt + 4 * g); }
#pragma unroll
    for (int nt = 0; nt < 4; ++nt) {
        const int t = 16 * nt + fr;
        const bf16x8 rb0 = *(const GAS bf16x8*)(Ryg + t * 64 + 8 * g), rb1 = *(const GAS bf16x8*)(Ryg + t * 64 + 32 + 8 * g);
        f32x4 y[4]; float s = 0.f;
#pragma unroll
        for (int mt = 0; mt < 4; ++mt) {
            f32x4 acc = *(const GAS f32x4*)(Ycg + ((mt * 4 + nt) * 64 + lane) * 4);
            acc = mfma32(sa[mt][0], rb0, acc); acc = mfma32(sa[mt][1], rb1, acc);
            y[mt] = acc; s += (acc[0] + acc[1]) + (acc[2] + acc[3]);
        }
        s += __shfl_xor(s, 16); s += __shfl_xor(s, 32);
        const float mean = s * (1.f / HD); float q = 0.f;
#pragma unroll
        for (int mt = 0; mt < 4; ++mt) { y[mt] = y[mt] - mean; q += (y[mt][0] * y[mt][0] + y[mt][1] * y[mt][1]) + (y[mt][2] * y[mt][2] + y[mt][3] * y[mt][3]); }
        q += __shfl_xor(q, 16); q += __shfl_xor(q, 32);
        const float rstd = 1.0f / sqrtf(q * (1.f / HD) + LNX_EPS);
        const float bon = BON[(tok0 + t) * NH + h];
#pragma unroll
        for (int mt = 0; mt < 4; ++mt) {
            const size_t o = (tok0 + t) * C + h * HD + 16 * mt + 4 * g;
            const v2u vv = *(const GAS v2u*)(SV + o), gg = *(const GAS v2u*)(SG + o);
            f32x4 r;
            r[0] = (y[mt][0] * rstd * lgv[mt][0] + lbv[mt][0] + bon * bflo(vv.x)) * bflo(gg.x);
            r[1] = (y[mt][1] * rstd * lgv[mt][1] + lbv[mt][1] + bon * bfhi(vv.x)) * bfhi(gg.x);
            r[2] = (y[mt][2] * rstd * lgv[mt][2] + lbv[mt][2] + bon * bflo(vv.y)) * bflo(gg.y);
            r[3] = (y[mt][3] * rstd * lgv[mt][3] + lbv[mt][3] + bon * bfhi(vv.y)) * bfhi(gg.y);
            *(GAS v2u*)(YC + (tok0 + t) * D + h * HD + 16 * mt + 4 * g) = pk4(r);
        }
    }
}

__device__ __forceinline__ int crow(int r, int hi) { return (r & 3) + 8 * (r >> 2) + 4 * hi; }
__device__ __forceinline__ void attn_unit(Frame& F, int b, int h, int qb) {
    const bf16* AQ = (const bf16*)(F.ws + WS_AQ); const bf16* AKp = (const bf16*)(F.ws + WS_AK); const bf16* AVT = (const bf16*)(F.ws + WS_AVT); const float* KM = (const float*)(F.ws + WS_KM);
    bf16* YC = (bf16*)(F.ws + WS_YC);
    const int tid = F.tid, lane = F.lane, wid = F.wave, r32 = lane & 31, hi = lane >> 5;
    constexpr int KBUF = 64 * 256, VPITCH = 136, VBUF = 128 * VPITCH;
    LAS unsigned char* kbuf = F.lds;
    LAS unsigned char* vbuf = F.lds + 2 * KBUF;
    LAS float* kmL = (LAS float*)(F.lds + 2 * KBUF + 2 * VBUF);
    const size_t tb = (size_t)b * SEQ; const int q0 = qb * MB + wid * 32;
    __syncthreads();
    for (int i = tid; i < NBLK * AD; i += NTHR) kmL[i] = KM[(size_t)(b * AH + h) * NBLK * AD + i];
    bf16x8 qr[8];
    { const bf16* Qp = AQ + (tb + q0 + r32) * C + h * AD + hi * 8;
#pragma unroll
      for (int d0 = 0; d0 < 8; ++d0) qr[d0] = *(const GAS bf16x8*)(Qp + d0 * 16); }
    __syncthreads();
    unsigned selmask;
    {
        float g1 = -INFINITY, g2 = -INFINITY, g3 = -INFINITY; int i1 = 0, i2 = 0, i3 = 0;
        for (int n = 0; n < qb; ++n) {
            float acc = 0.f;
#pragma unroll
            for (int d0 = 0; d0 < 8; ++d0) { const LAS f32x4* kp = (const LAS f32x4*)(kmL + n * AD + d0 * 16 + hi * 8); const f32x4 ka = kp[0], kb = kp[1];
                const bf16x8 q = qr[d0];
                acc += bf2f((unsigned short)q[0]) * ka.x + bf2f((unsigned short)q[1]) * ka.y + bf2f((unsigned short)q[2]) * ka.z + bf2f((unsigned short)q[3]) * ka.w
                     + bf2f((unsigned short)q[4]) * kb.x + bf2f((unsigned short)q[5]) * kb.y + bf2f((unsigned short)q[6]) * kb.z + bf2f((unsigned short)q[7]) * kb.w; }
            const float g = acc + __shfl_xor(acc, 32);
            if (g > g1) { g3 = g2; i3 = i2; g2 = g1; i2 = i1; g1 = g; i1 = n; }
            else if (g > g2) { g3 = g2; i3 = i2; g2 = g; i2 = n; }
            else if (g > g3) { g3 = g; i3 = n; }
        }
        selmask = (qb <= 3) ? ((1u << qb) - 1u) : ((1u << i1) | (1u << i2) | (1u << i3));
    }
    const int NT = 4 * (qb + 1);
    v4u kreg[2], vreg[2];
    const bf16* Kg = AKp + tb * C + h * AD; const bf16* Vg = AVT + (size_t)(b * AH + h) * AD * SEQ;
#define TILE_KS(ti) (((ti) < 4) ? (qb * MB + 64 * (ti)) : ((((ti) - 4) >> 2) * MB + 64 * (((ti) - 4) & 3)))
#define ATT_LOAD(ti) do { const int ks_ = TILE_KS(ti); _Pragma("unroll") for (int i_ = 0; i_ < 2; ++i_) { const int idx_ = tid + NTHR * i_; \
        kreg[i_] = *(const GAS v4u*)(Kg + (size_t)(ks_ + (idx_ >> 4)) * C + (idx_ & 15) * 8); \
        vreg[i_] = *(const GAS v4u*)(Vg + (size_t)(idx_ >> 3) * SEQ + ks_ + (idx_ & 7) * 8); } } while (0)
#define ATT_STORE(bi) do { _Pragma("unroll") for (int i_ = 0; i_ < 2; ++i_) { const int idx_ = tid + NTHR * i_; const int row_ = idx_ >> 4, c_ = idx_ & 15; \
        *(LAS v4u*)(kbuf + (bi) * KBUF + row_ * 256 + ((c_ ^ (row_ & 15)) << 4)) = kreg[i_]; \
        LAS v2u* vd_ = (LAS v2u*)(vbuf + (bi) * VBUF + (idx_ >> 3) * VPITCH + (idx_ & 7) * 16); vd_[0] = (v2u){vreg[i_].x, vreg[i_].y}; vd_[1] = (v2u){vreg[i_].z, vreg[i_].w}; } } while (0)
    f32x16 O[4];
#pragma unroll
    for (int dt = 0; dt < 4; ++dt) O[dt] = (f32x16){0.f};
    float m_run = -1e30f, l_run = 0.f;
    const float SC = 0.08838834764831845f * 1.4426950408889634f;
    ATT_LOAD(0); ATT_STORE(0);
    __syncthreads();
    const int qpos = q0 + r32;
    for (int ti = 0; ti < NT; ++ti) {
        if (ti + 1 < NT) ATT_LOAD(ti + 1);
        const LAS unsigned char* kb_ = kbuf + (ti & 1) * KBUF; const LAS unsigned char* vb_ = vbuf + (ti & 1) * VBUF;
        const int ks = TILE_KS(ti);
        f32x16 p[2];
#pragma unroll
        for (int kb2 = 0; kb2 < 2; ++kb2) {
            f32x16 acc = (f32x16){0.f};
            const int row = 32 * kb2 + r32;
#pragma unroll
            for (int d0 = 0; d0 < 8; ++d0) {
                const bf16x8 kf = *(const LAS bf16x8*)(kb_ + row * 256 + (((2 * d0 + hi) ^ (row & 15)) << 4));
                acc = __builtin_amdgcn_mfma_f32_32x32x16_bf16(kf, qr[d0], acc, 0, 0, 0);
            }
            p[kb2] = acc;
        }
        const bool own = ti < 4;
        const bool lane_ok = own || ((selmask >> ((ti - 4) >> 2)) & 1u);
        float mx = -1e30f;
#pragma unroll
        for (int kb2 = 0; kb2 < 2; ++kb2)
#pragma unroll
            for (int r = 0; r < 16; ++r) {
                float s = p[kb2][r] * SC;
                const int kpos = ks + 32 * kb2 + crow(r, hi);
                const bool ok = own ? (kpos <= qpos) : lane_ok;
                s = ok ? s : -1e30f; p[kb2][r] = s; mx = fmaxf(mx, s);
            }
        mx = fmaxf(mx, __shfl_xor(mx, 32));
        const float m_new = fmaxf(m_run, mx);
        const float alpha = exp2f(m_run - m_new);
        m_run = m_new;
        float ls = 0.f;
#pragma unroll
        for (int kb2 = 0; kb2 < 2; ++kb2)
#pragma unroll
            for (int r = 0; r < 16; ++r) { const float e = exp2f(p[kb2][r] - m_new); p[kb2][r] = e; ls += e; }
        l_run = l_run * alpha + ls;
#pragma unroll
        for (int dt = 0; dt < 4; ++dt)
#pragma unroll
            for (int r = 0; r < 16; ++r) O[dt][r] *= alpha;
#pragma unroll
        for (int kb2 = 0; kb2 < 2; ++kb2)
#pragma unroll
            for (int s = 0; s < 2; ++s) {
                v4u pw; pw.x = pk2(p[kb2][8 * s + 0], p[kb2][8 * s + 1]); pw.y = pk2(p[kb2][8 * s + 2], p[kb2][8 * s + 3]); pw.z = pk2(p[kb2][8 * s + 4], p[kb2][8 * s + 5]); pw.w = pk2(p[kb2][8 * s + 6], p[kb2][8 * s + 7]);
                const bf16x8 pf = __builtin_bit_cast(bf16x8, pw);
                const int key0 = 32 * kb2 + 16 * s + 4 * hi;
#pragma unroll
                for (int dt = 0; dt < 4; ++dt) {
                    const LAS unsigned char* vp = vb_ + (32 * dt + r32) * VPITCH + key0 * 2;
                    const v2u lo = *(const LAS v2u*)vp, hi2 = *(const LAS v2u*)(vp + 16);
                    const v4u vw = (v4u){lo.x, lo.y, hi2.x, hi2.y};
                    O[dt] = __builtin_amdgcn_mfma_f32_32x32x16_bf16(__builtin_bit_cast(bf16x8, vw), pf, O[dt], 0, 0, 0);
                }
            }
        if (ti + 1 < NT) ATT_STORE((ti + 1) & 1);
        __syncthreads();
    }
    const float l_tot = l_run + __shfl_xor(l_run, 32);
    const float inv = 1.0f / l_tot;
    bf16* yo = YC + (tb + q0 + r32) * D + C + h * AD;
#pragma unroll
    for (int dt = 0; dt < 4; ++dt)
#pragma unroll
        for (int rq = 0; rq < 4; ++rq) {
            v2u w; w.x = pk2(O[dt][4 * rq] * inv, O[dt][4 * rq + 1] * inv); w.y = pk2(O[dt][4 * rq + 2] * inv, O[dt][4 * rq + 3] * inv);
            *(GAS v2u*)(yo + 32 * dt + 8 * rq + 4 * hi) = w;
        }
#undef TILE_KS
#undef ATT_LOAD
#undef ATT_STORE
}
__device__ __forceinline__ void ph_wkv_r1(Frame& F, int L) { for (int u = F.vcu; u < NUNIT; u += F.G) wkv_r1_unit(F, L, u); }
__device__ __forceinline__ void ph_wkv_r2(Frame& F) { if (F.wave == 0) for (int id = F.vcu; id < BATCH * NH * 4; id += F.G) wkv_r2_wave(F, id >> 2, id & 3); }
__device__ __forceinline__ void ph_mixer(Frame& F, int L) {
    constexpr int NAT = BATCH * AH * NBLK;
    for (int u = F.vcu * NWAVES + F.wave; u < NUNIT; u += F.G * NWAVES) wkv_r3_wave(F, L, u);
    for (int au = F.vcu; au < NAT; au += F.G) { const int qb = NBLK - 1 - au / (BATCH * AH), bh = au % (BATCH * AH); attn_unit(F, bh / AH, bh % AH, qb); }
}

constexpr int PH_PER_LAYER = 11, NPHASE = DEPTH * PH_PER_LAYER;
#ifndef MK_N_LAUNCHES
#define MK_N_LAUNCHES 1
#endif
struct Args { const float* in[24]; float* out; unsigned char* ws; int ph_lo, ph_hi, li, pad; };
__global__ void __launch_bounds__(NTHR, 2) mega_fwd(Args args) {
    extern __shared__ __attribute__((aligned(16))) unsigned char lds[];
    Frame F;
    F.lds = (LAS unsigned char*)lds;
    F.MISC = (volatile LAS unsigned*)(F.lds + MISC_OFF);
    F.tid = threadIdx.x; F.lane = F.tid & 63; F.wave = __builtin_amdgcn_readfirstlane(F.tid >> 6);
    F.G = gridDim.x; { const int bx = blockIdx.x; F.vcu = (F.G % 8 == 0) ? (bx % 8) * (F.G / 8) + bx / 8 : bx; }
    F.ws = args.ws; F.out = args.out; F.ctl = (gu32*)(args.ws + WS_CTL);
    for (int u = F.tid; u < (LDS_BYTES - LDSCTL_OFF) / 4; u += NTHR) ((LAS unsigned*)(F.lds + LDSCTL_OFF))[u] = 0u;
    __syncthreads();
    if (F.tid < 24) *(LAS unsigned long long*)(F.lds + PTAB_OFF + 8 * F.tid) = (unsigned long long)args.in[F.tid];
    __syncthreads();
    XcdBarrier bar; bar.bar = (unsigned*)(F.ctl + CW_BAR) + args.li * XCD_BAR_WORDS; bar.x = 0; bar.st = nullptr;
    const bool one_launch = (args.ph_hi - args.ph_lo) > 1;
    if (one_launch) bar = xcd_barrier_post((unsigned*)(F.ctl + CW_BAR) + args.li * XCD_BAR_WORDS, F.MISC + 8);
    bf16* HN = (bf16*)(F.ws + WS_HN); bf16* YC = (bf16*)(F.ws + WS_YC); bf16* Zb = (bf16*)(F.ws + WS_Z); bf16* U = (bf16*)(F.ws + WS_U);
    float* Y2 = (float*)(F.ws + WS_Y2); float* Mo = (float*)(F.ws + WS_M);
    for (int ph = args.ph_lo; ph < args.ph_hi; ++ph) {
        const int L = ph / PH_PER_LAYER, p = ph % PH_PER_LAYER;
        { int t_ = threadIdx.x; asm volatile("" : "+v"(t_)); F.tid = t_; F.lane = t_ & 63; F.wave = __builtin_amdgcn_readfirstlane(t_ >> 6); }
        switch (p) {
        case 0: ph_convert(F, L); break;
        case 1: { pg8::Gemm g{HN, (const bf16*)(F.ws + WS_WIN), T, (L == 0) ? NIN : NZ, D}; pg8::StaticOrder S; S.init(T, (L == 0) ? NIN : NZ, F.G, (int)blockIdx.x);
                  pg8::EpiBf16<0> E{Zb, NZ}; pg8::gemm_phase<pg8::EpiBf16<0>, pg8::StaticOrder, true, true>(F.lds, g, S, E, F.tid); } break;
        case 2: ph_prep(F, L); break;
        case 3: ph_wkv_r1(F, L); break;
        case 4: ph_wkv_r2(F); break;
        case 5: ph_mixer(F, L); break;
        case 6: { pg8::Gemm g{YC, (const bf16*)(F.ws + WS_WOUT), T, D, D}; pg8::StaticOrder S; S.init(T, D, F.G, (int)blockIdx.x);
                  pg8::EpiF32 E{Y2, D}; pg8::gemm_phase<pg8::EpiF32, pg8::StaticOrder, true, true>(F.lds, g, S, E, F.tid); } break;
        case 7: ph_resnorm(F, Y2, (L == 0) ? INP(I_X) : F.out, INP(I_NMIXPOST) + (size_t)L * D, INP(I_NMLPPRE) + (size_t)L * D, F.out, HN); break;
        case 8: { pg8::Gemm g{HN, (const bf16*)(F.ws + WS_WUP), T, FF, D}; pg8::StaticOrder S; S.init(T, FF, F.G, (int)blockIdx.x);
                  pg8::EpiBf16<2> E{U, FF}; pg8::gemm_phase<pg8::EpiBf16<2>, pg8::StaticOrder, true, true>(F.lds, g, S, E, F.tid); } break;
        case 9: { pg8::Gemm g{U, (const bf16*)(F.ws + WS_WDN), T, D, FF}; pg8::StaticOrder S; S.init(T, D, F.G, (int)blockIdx.x);
                  pg8::EpiF32 E{Mo, D}; pg8::gemm_phase<pg8::EpiF32, pg8::StaticOrder, true, true>(F.lds, g, S, E, F.tid); } break;
        case 10: ph_resnorm(F, Mo, F.out, INP(I_NMLPPOST) + (size_t)L * D, (L + 1 < DEPTH) ? INP(I_NMIXPRE) + (size_t)(L + 1) * D : nullptr, F.out, HN); break;
        }
        if (ph + 1 < args.ph_hi) xcd_barrier(bar);
    }
}

extern "C" void kernel_launch(void* const* d_in, const int* in_sizes, int n_in, void* d_out, int out_size, void* d_ws, size_t ws_size, hipStream_t stream) {
    static int grid = 0;
    if (grid == 0) {
        if (n_in != 24 || in_sizes[0] != T * D || out_size != T * D || ws_size < WS_END) { fprintf(stderr, "kernel_launch: unexpected shapes (n_in %d, in0 %d, out %d, ws %zu)\n", n_in, n_in > 0 ? in_sizes[0] : -1, out_size, ws_size); grid = -1; return; }
        int dev = 0, cus = 0, per_cu = 0;
        if (hipGetDevice(&dev) != hipSuccess || hipDeviceGetAttribute(&cus, hipDeviceAttributeMultiprocessorCount, dev) != hipSuccess) { grid = -1; return; }
        if (hipFuncSetAttribute((const void*)mega_fwd, hipFuncAttributeMaxDynamicSharedMemorySize, LDS_BYTES) != hipSuccess) { fprintf(stderr, "kernel_launch: hipFuncSetAttribute failed\n"); grid = -1; return; }
        if (hipOccupancyMaxActiveBlocksPerMultiprocessor(&per_cu, (const void*)mega_fwd, NTHR, LDS_BYTES) != hipSuccess || per_cu < 1) { fprintf(stderr, "kernel_launch: occupancy query says %d\n", per_cu); per_cu = 1; }
        (void)hipGetLastError();
        grid = cus * (per_cu > 1 ? 1 : per_cu);
    }
    if (grid < 0) return;
    (void)hipMemsetAsync((char*)d_ws + WS_CTL, 0, CTL_ZERO_BYTES, stream);
    Args a{};
    for (int i = 0; i < 24; ++i) a.in[i] = (const float*)d_in[i];
    a.out = (float*)d_out; a.ws = (unsigned char*)d_ws;
    const int nl = MK_N_LAUNCHES;
    for (int li = 0; li < nl; ++li) {
        a.li = li; a.ph_lo = (int)((long)NPHASE * li / nl); a.ph_hi = (int)((long)NPHASE * (li + 1) / nl);
        if (a.ph_hi - a.ph_lo > 1) {
            void* kargs[] = {&a};
            hipError_t e = hipLaunchCooperativeKernel((const void*)mega_fwd, dim3(grid), dim3(NTHR), kargs, LDS_BYTES, stream);
            if (e != hipSuccess) fprintf(stderr, "kernel_launch: cooperative launch failed: %s (grid %d)\n", hipGetErrorString(e), grid);
        } else {
            hipLaunchKernelGGL(mega_fwd, dim3(grid), dim3(NTHR), LDS_BYTES, stream, a);
        }
    }
}
```

```cpp
#include <hip/hip_runtime.h>
#include <cstdio>
#include <cstdint>
namespace pg8 {
#define PG8_LAS __attribute__((address_space(3)))
typedef unsigned short bf16_t;
typedef short bf16x8 __attribute__((ext_vector_type(8)));
typedef float f32x4 __attribute__((ext_vector_type(4)));
typedef unsigned u32x4 __attribute__((ext_vector_type(4)));
constexpr int BM = 256, BK = 64, HALF = 128, HTB = HALF * BK * 2  , STAGE_BYTES = 8 * HTB, NXCD = 8, WGM = 8;

__host__ __device__ __forceinline__ int lds_byte(int r, int c) { const int st = (r >> 4) * 2 + (c >> 5), rr = r & 15, cc = c & 31, ob = rr * 64 + cc * 2; return st * 1024 + (ob ^ (((ob >> 9) & 1) << 5)); }
__host__ __device__ __forceinline__ void stage_rc(int b, int& R, int& C) { const int st = b / 1024, sb = b % 1024, swz = sb ^ (((sb >> 9) & 1) << 5); R = (st >> 1) * 16 + swz / 64; C = (st & 1) * 32 + (swz % 64) / 2; }
__host__ __device__ __forceinline__ int perm32(int rho) { const int n = rho >> 4, i = rho & 15; return 8 * (i >> 2) + 4 * n + (i & 3); }

struct Unit { int pm, pn; };
struct Gemm { const bf16_t* A; const bf16_t* Bt; int M, N, K; };

struct StaticOrder {
    int nM, nN, nwg, G, c;
    __host__ __device__ void init(int M, int N, int G_, int c_) { nM = M / BM; nN = N / BM; nwg = nM * nN; G = G_; c = c_; }
    __host__ __device__ bool next(int i, Unit& u) const {
        const long L = (long)i * G + c; if (L >= nwg) return false;
        int wgid = (int)L; { const int q = nwg / NXCD, r = nwg % NXCD, xcd = wgid % NXCD, off = wgid / NXCD; wgid = (xcd < r ? xcd * (q + 1) : r * (q + 1) + (xcd - r) * q) + off; }
        const int nig = WGM * nN, gid = wgid / nig, fm = gid * WGM, gsz = (nM - fm) < WGM ? (nM - fm) : WGM;
        u.pm = fm + ((wgid % nig) % gsz); u.pn = (wgid % nig) / gsz; return true;
    }
    __device__ __forceinline__ void a_ready(const Unit&) const {}
    __device__ __forceinline__ void done(const Unit&) const {}
};

__device__ __forceinline__ unsigned cvt_pk_bf16(float lo, float hi) { unsigned r; asm volatile("v_cvt_pk_bf16_f32 %0, %1, %2" : "=v"(r) : "v"(lo), "v"(hi)); return r; }
struct EpiF32 {
    static constexpr bool PERM = false, AFTER_DRAIN = false;
    float* C; int ldc;
    __device__ __forceinline__ void operator()(const f32x4 (&acc)[2][2][4][2], const Unit& u, int wr, int wc, int fr, int fq) const {
        const int row0 = u.pm * BM + wr * 64 + fr, col0 = u.pn * BM + wc * 32 + 4 * fq;
#pragma unroll
        for (int ai = 0; ai < 2; ++ai)
#pragma unroll
            for (int m = 0; m < 4; ++m) { float* rowp = C + (size_t)(row0 + ai * HALF + m * 16) * ldc + col0;
#pragma unroll
                for (int bj = 0; bj < 2; ++bj)
#pragma unroll
                    for (int n = 0; n < 2; ++n) *(f32x4*)(rowp + bj * HALF + n * 16) = acc[ai][bj][m][n]; }
    }
};
template <int ACT  > struct EpiBf16 {
    static constexpr bool PERM = true, AFTER_DRAIN = false;
    bf16_t* O; int ldc;
    __device__ __forceinline__ void operator()(const f32x4 (&acc)[2][2][4][2], const Unit& u, int wr, int wc, int fr, int fq) const {
        const int row0 = u.pm * BM + wr * 64 + fr; const int col0 = u.pn * BM + wc * 32 + 8 * fq;
#pragma unroll
        for (int ai = 0; ai < 2; ++ai)
#pragma unroll
            for (int m = 0; m < 4; ++m) { bf16_t* rowp = O + (size_t)(row0 + ai * HALF + m * 16) * ldc + col0;
#pragma unroll
                for (int bj = 0; bj < 2; ++bj) { f32x4 v0 = acc[ai][bj][m][0], v1 = acc[ai][bj][m][1];
                    if (ACT == 2) {
#pragma unroll
                        for (int e = 0; e < 4; ++e) { float a = v0[e] > 0.f ? v0[e] : 0.f; v0[e] = a * a; float b = v1[e] > 0.f ? v1[e] : 0.f; v1[e] = b * b; } }
                    u32x4 w; w.x = cvt_pk_bf16(v0[0], v0[1]); w.y = cvt_pk_bf16(v0[2], v0[3]); w.z = cvt_pk_bf16(v1[0], v1[1]); w.w = cvt_pk_bf16(v1[2], v1[3]);
                    *(u32x4*)(rowp + bj * HALF) = w; } }
    }
};

template <class Epi, class Sched, bool ALIGN_EPI = false, bool SP2 = false>
__device__ __forceinline__ void gemm_phase(PG8_LAS unsigned char* lds, const Gemm g, const Sched& S, const Epi& E, const int tid) {
    const int wid = __builtin_amdgcn_readfirstlane(tid >> 6), lane = tid & 63, wr = wid >> 2, wc = wid & 3, fr = lane & 15, fq = lane >> 4;
    const int K = g.K, nt = K / BK;
    unsigned voffA[2], voffB[2];
#pragma unroll
    for (int i = 0; i < 2; ++i) { int R, C; stage_rc(tid * 16 + i * 8192, R, C); const int Rb = Epi::PERM ? ((R & ~31) + perm32(R & 31)) : R;
        voffA[i] = (unsigned)(R * K + C) * 2u; voffB[i] = (unsigned)(Rb * K + C) * 2u; }
    const size_t kstep = (size_t)(BK * 2);
    const size_t hstep = (size_t)HALF * K * 2;
    const size_t tstep = 2 * hstep;
    const unsigned ldsw = (unsigned)wid * 1024u;
    const int aoff = lds_byte(wr * 64 + fr, fq * 8), boff = lds_byte(wc * 32 + fr, fq * 8);
#define PG8_SA(b, h) (((b) * 2 + (h)) * HTB)
#define PG8_SB(b, h) ((4 + (b) * 2 + (h)) * HTB)
#define PG8_STAGE(bufoff, gbase, voff) do { _Pragma("unroll") for (int _i = 0; _i < 2; ++_i) \
        __builtin_amdgcn_global_load_lds((const unsigned*)((const char*)(gbase) + (voff)[_i]), (PG8_LAS unsigned*)(lds + (bufoff) + ldsw + _i * 8192), 16, 0, 0); } while (0)
#define PG8_LDA(dst, b, h) do { _Pragma("unroll") for (int m = 0; m < 4; ++m) _Pragma("unroll") for (int k = 0; k < 2; ++k) dst[m][k] = *(const PG8_LAS bf16x8*)(lds + PG8_SA(b, h) + aoff + m * 2048 + k * 1024); } while (0)
#define PG8_LDB(dst, b, h) do { _Pragma("unroll") for (int n = 0; n < 2; ++n) _Pragma("unroll") for (int k = 0; k < 2; ++k) dst[n][k] = *(const PG8_LAS bf16x8*)(lds + PG8_SB(b, h) + boff + n * 2048 + k * 1024); } while (0)
#define PG8_MMA(ai, bj, At, Bt) do { __builtin_amdgcn_s_setprio(1); _Pragma("unroll") for (int m = 0; m < 4; ++m) _Pragma("unroll") for (int n = 0; n < 2; ++n) _Pragma("unroll") for (int k = 0; k < 2; ++k) \
        acc[ai][bj][m][n] = __builtin_amdgcn_mfma_f32_16x16x32_bf16(Bt[n][k], At[m][k], acc[ai][bj][m][n], 0, 0, 0); __builtin_amdgcn_s_setprio(0); } while (0)
#define PG8_WAIT_V(n) asm volatile("s_waitcnt vmcnt(" #n ")" ::: "memory")
#define PG8_WAIT_L(n) asm volatile("s_waitcnt lgkmcnt(" #n ")" ::: "memory")
#define PG8_BAR __builtin_amdgcn_s_barrier()
#define PG8_SCHED __builtin_amdgcn_sched_barrier(0)
    Unit cur, nxt; int ui = 0;
    if (!S.next(0, cur)) return;
    f32x4 acc[2][2][4][2];
#pragma unroll
    for (int a = 0; a < 2; ++a)
#pragma unroll
        for (int b = 0; b < 2; ++b)
#pragma unroll
            for (int m = 0; m < 4; ++m)
#pragma unroll
                for (int n = 0; n < 2; ++n) acc[a][b][m][n] = (f32x4){0.f, 0.f, 0.f, 0.f};
    bf16x8 At[4][2], B0[2][2], B1[2][2];
    const char* cA = (const char*)g.A + (size_t)cur.pm * tstep; const char* cB = (const char*)g.Bt + (size_t)cur.pn * tstep;
    S.a_ready(cur);
    if constexpr (SP2) {
        PG8_STAGE(PG8_SB(0, 0), cB, voffB); PG8_STAGE(PG8_SB(0, 1), cB + hstep, voffB); PG8_STAGE(PG8_SA(0, 0), cA, voffA); PG8_STAGE(PG8_SA(0, 1), cA + hstep, voffA);
        if (wr == 1) PG8_BAR;
        PG8_WAIT_V(2); PG8_BAR;
        PG8_STAGE(PG8_SB(1, 0), cB + kstep, voffB); PG8_STAGE(PG8_SA(1, 0), cA + kstep, voffA); PG8_STAGE(PG8_SB(1, 1), cB + hstep + kstep, voffB);
        PG8_WAIT_V(6); PG8_BAR;
    } else {
        PG8_STAGE(PG8_SB(0, 0), cB, voffB); PG8_STAGE(PG8_SA(0, 0), cA, voffA); PG8_STAGE(PG8_SB(0, 1), cB + hstep, voffB); PG8_STAGE(PG8_SA(0, 1), cA + hstep, voffA);
        if (wr == 1) PG8_BAR;
        PG8_WAIT_V(4); PG8_BAR;
        PG8_STAGE(PG8_SB(1, 0), cB + kstep, voffB); PG8_STAGE(PG8_SA(1, 0), cA + kstep, voffA); PG8_STAGE(PG8_SB(1, 1), cB + hstep + kstep, voffB);
        PG8_WAIT_V(6); PG8_BAR;
    }
    for (;;) {
        const bool has_next = S.next(ui + 1, nxt);
        const char* nA = has_next ? (const char*)g.A + (size_t)nxt.pm * tstep : cA; const char* nB = has_next ? (const char*)g.Bt + (size_t)nxt.pn * tstep : cB;
        for (int t = 0; t < nt; t += 2) {
            const bool last = (t == nt - 2);
            const char* a1 = cA + (size_t)(t + 1) * kstep;
            const char* a2 = last ? nA : cA + (size_t)(t + 2) * kstep; const char* b2 = last ? nB : cB + (size_t)(t + 2) * kstep;
            const char* a3 = a2 + kstep; const char* b3 = b2 + kstep;
            if (last && has_next) S.a_ready(nxt);
            if constexpr (SP2) {
            PG8_LDB(B0, 0, 0); PG8_LDB(B1, 0, 1); PG8_SCHED; PG8_LDA(At, 0, 0); PG8_STAGE(PG8_SA(1, 1), a1 + hstep, voffA);
            PG8_WAIT_V(8); PG8_WAIT_L(0); PG8_BAR; PG8_MMA(0, 0, At, B0); PG8_MMA(0, 1, At, B1); PG8_BAR; PG8_SCHED;
            PG8_LDA(At, 0, 1); PG8_STAGE(PG8_SB(0, 0), b2, voffB); PG8_STAGE(PG8_SB(0, 1), b2 + hstep, voffB); PG8_STAGE(PG8_SA(0, 0), a2, voffA);
            PG8_WAIT_V(8); PG8_WAIT_L(0); PG8_BAR; PG8_MMA(1, 0, At, B0); PG8_MMA(1, 1, At, B1); PG8_BAR; PG8_SCHED;
            PG8_LDB(B0, 1, 0); PG8_LDB(B1, 1, 1); PG8_SCHED; PG8_LDA(At, 1, 0); PG8_STAGE(PG8_SA(0, 1), a2 + hstep, voffA);
            PG8_WAIT_V(8); PG8_WAIT_L(0); PG8_BAR; PG8_MMA(0, 0, At, B0); PG8_MMA(0, 1, At, B1); PG8_BAR; PG8_SCHED;
            PG8_LDA(At, 1, 1); PG8_STAGE(PG8_SB(1, 0), b3, voffB); PG8_STAGE(PG8_SB(1, 1), b3 + hstep, voffB); PG8_STAGE(PG8_SA(1, 0), a3, voffA);
            PG8_WAIT_V(8); PG8_WAIT_L(0); PG8_BAR; PG8_MMA(1, 0, At, B0); PG8_MMA(1, 1, At, B1); PG8_BAR; PG8_SCHED;
            } else {
            PG8_LDB(B0, 0, 0); PG8_SCHED; PG8_LDA(At, 0, 0); PG8_STAGE(PG8_SA(1, 1), a1 + hstep, voffA);
            PG8_WAIT_L(8); PG8_BAR; PG8_WAIT_L(0); PG8_MMA(0, 0, At, B0); PG8_BAR; PG8_SCHED;
            PG8_LDB(B1, 0, 1); PG8_STAGE(PG8_SB(0, 0), b2, voffB);
            PG8_BAR; PG8_WAIT_L(0); PG8_MMA(0, 1, At, B1); PG8_BAR;
            PG8_LDA(At, 0, 1); PG8_STAGE(PG8_SA(0, 0), a2, voffA);
            PG8_BAR; PG8_WAIT_L(0); PG8_MMA(1, 0, At, B0); PG8_BAR; PG8_SCHED;
            PG8_STAGE(PG8_SB(0, 1), b2 + hstep, voffB);
            PG8_WAIT_V(6); PG8_BAR; PG8_MMA(1, 1, At, B1); PG8_BAR;
            PG8_LDB(B0, 1, 0); PG8_SCHED; PG8_LDA(At, 1, 0); PG8_STAGE(PG8_SA(0, 1), a2 + hstep, voffA);
            PG8_WAIT_L(8); PG8_BAR; PG8_WAIT_L(0); PG8_MMA(0, 0, At, B0); PG8_BAR; PG8_SCHED;
            PG8_LDB(B1, 1, 1); PG8_STAGE(PG8_SB(1, 0), b3, voffB);
            PG8_BAR; PG8_WAIT_L(0); PG8_MMA(0, 1, At, B1); PG8_BAR;
            PG8_LDA(At, 1, 1); PG8_STAGE(PG8_SA(1, 0), a3, voffA);
            PG8_BAR; PG8_WAIT_L(0); PG8_MMA(1, 0, At, B0); PG8_BAR; PG8_SCHED;
            PG8_STAGE(PG8_SB(1, 1), b3 + hstep, voffB);
            PG8_WAIT_V(6); PG8_BAR; PG8_MMA(1, 1, At, B1); PG8_BAR;
            }
        }
        if constexpr (ALIGN_EPI) { if (wr == 0) PG8_BAR; }
        if constexpr (!Epi::AFTER_DRAIN) { E(acc, cur, wr, wc, fr, fq); S.done(cur); }
        if (!has_next) break;
#pragma unroll
        for (int a = 0; a < 2; ++a)
#pragma unroll
            for (int b = 0; b < 2; ++b)
#pragma unroll
                for (int m = 0; m < 4; ++m)
#pragma unroll
                    for (int n = 0; n < 2; ++n) acc[a][b][m][n] = (f32x4){0.f, 0.f, 0.f, 0.f};
        cur = nxt; cA = nA; cB = nB; ++ui;
        if constexpr (ALIGN_EPI) { if (wr == 1) PG8_BAR; }
    }
    PG8_WAIT_V(0);
    if constexpr (!ALIGN_EPI) { if (wr == 0) PG8_BAR; }
    PG8_BAR;
    if constexpr (Epi::AFTER_DRAIN) { E.fused(acc, cur, wr, wc, fr, fq, lds, wid, lane); S.done(cur); }
#undef PG8_SA
#undef PG8_SB
#undef PG8_STAGE
#undef PG8_LDA
#undef PG8_LDB
#undef PG8_MMA
#undef PG8_WAIT_V
#undef PG8_WAIT_L
#undef PG8_BAR
#undef PG8_SCHED
}
}

#define GAS __attribute__((address_space(1)))
#define LAS __attribute__((address_space(3)))
typedef unsigned short bf16;
typedef unsigned v4u __attribute__((ext_vector_type(4)));
typedef unsigned v2u __attribute__((ext_vector_type(2)));
typedef float f32x4 __attribute__((ext_vector_type(4)));
typedef float f32x16 __attribute__((ext_vector_type(16)));
typedef short bf16x8 __attribute__((ext_vector_type(8)));
typedef GAS unsigned gu32;
#define RLX_AGENT __ATOMIC_RELAXED, __HIP_MEMORY_SCOPE_AGENT
#define LDS_WAIT() asm volatile("s_waitcnt lgkmcnt(0)" ::: "memory")
#define VM_WAIT() asm volatile("s_waitcnt vmcnt(0)" ::: "memory")

constexpr int NWAVES = 8, NTHR = 512;
constexpr int BATCH = 2, SEQ = 4096, T = BATCH * SEQ, D = 2048, C = 1024, NH = 16, HD = 64;
constexpr int AH = 8, AD = 128, MB = 256, NBLK = SEQ / MB;
constexpr int NSHIFT = 3328, NIN = 6400, NZ = 6656, FF = 8192;
constexpr int ZQ = 3328, ZK = 4352, ZV = 5376, ZVD = 6400;
constexpr int DEPTH = 2;
constexpr float NORM_EPS = 1e-6f, LNX_EPS = 64e-5f;

constexpr size_t MiB = 1u << 20;
constexpr size_t WS_CTL = 0, CTL_ZERO_BYTES = 1 * MiB;
constexpr size_t WS_WIN = 1 * MiB, WS_WOUT = 27 * MiB, WS_WUP = 35 * MiB, WS_WDN = 67 * MiB;
constexpr size_t WS_VF = 99 * MiB;
constexpr size_t WS_HN = 131 * MiB;
constexpr size_t WS_YC = 163 * MiB;
constexpr size_t WS_Z = 195 * MiB;
constexpr size_t WS_XL = 299 * MiB;
constexpr size_t WS_LW = 304 * MiB;
constexpr size_t WS_ROPE = 323 * MiB;
constexpr size_t WS_SV = 325 * MiB;
constexpr size_t WS_SG = 341 * MiB;
constexpr size_t WS_AQ = 357 * MiB, WS_AK = 373 * MiB, WS_AVT = 389 * MiB;
constexpr size_t WS_KM = 405 * MiB;
constexpr size_t WS_CHUNK = 406 * MiB;
constexpr size_t WS_U = 195 * MiB;
constexpr size_t WS_Y2 = 195 * MiB;
constexpr size_t WS_M = 131 * MiB;
constexpr size_t WS_END = 502 * MiB;
constexpr int CW_BAR = 4096;

constexpr int RING_BYTES = 147456;
constexpr int LDSCTL_OFF = RING_BYTES, MISC_OFF = LDSCTL_OFF + 320;
constexpr int LDS_BYTES = RING_BYTES + 1024;
constexpr int PTAB_OFF = MISC_OFF + 128;

__device__ __forceinline__ unsigned f2bf(float f) { unsigned u = __builtin_bit_cast(unsigned, f); return (u + 0x7fffu + ((u >> 16) & 1u)) >> 16; }
__device__ __forceinline__ unsigned pk2(float lo, float hi) { return f2bf(lo) | (f2bf(hi) << 16); }
__device__ __forceinline__ float bf2f(unsigned short b) { return __builtin_bit_cast(float, (unsigned)b << 16); }
__device__ __forceinline__ float bflo(unsigned w) { return __builtin_bit_cast(float, w << 16); }
__device__ __forceinline__ float bfhi(unsigned w) { return __builtin_bit_cast(float, w & 0xffff0000u); }

#define XB_TMO      128
#define XB_XCNT(j)  (256  + 64 * (j))
#define XB_XSUB(j)  (1280 + 64 * (j))
#define XB_XGEN(j)  (2304 + 64 * (j))
#define XB_TOP      3328
#define XB_TOPGEN   3392
#define XCD_BAR_WORDS 3456
#define XB_SPIN_CAP (1u << 20)
__device__ __forceinline__ unsigned xb_ld(unsigned* p)              { return __hip_atomic_load(p, __ATOMIC_RELAXED, __HIP_MEMORY_SCOPE_AGENT); }
__device__ __forceinline__ unsigned xb_add(unsigned* p, unsigned v) { return __hip_atomic_fetch_add(p, v, __ATOMIC_RELAXED, __HIP_MEMORY_SCOPE_AGENT); }
__device__ __forceinline__ unsigned xb_xcc_id() { return (unsigned)__builtin_amdgcn_s_getreg((3 << 11) | 20) & 0xFu; }
#define XB_SPIN(cond, bar) do { unsigned _sp = 0; while (cond) { __builtin_amdgcn_s_sleep(1); \
    if ((++_sp & 255u) == 0u) { if (xb_ld(&(bar)[XB_TMO])) break; if (_sp > XB_SPIN_CAP) { atomicAdd(&(bar)[XB_TMO], 1u); break; } } } } while (0)
struct XcdBarrier { unsigned* bar; unsigned x; volatile LAS unsigned* st; };
__device__ __forceinline__ XcdBarrier xcd_barrier_post(unsigned* bar, volatile LAS unsigned* st) {
    XcdBarrier b; b.bar = bar; b.x = xb_xcc_id(); b.st = st;
    if (threadIdx.x == 0) (void)xb_add(&bar[XB_XCNT(b.x)], 1u);
    return b;
}
__device__ __forceinline__ void xcd_barrier_complete(unsigned* bar, unsigned x, unsigned& nloc, unsigned& nx) {
    const unsigned G = gridDim.x * gridDim.y * gridDim.z;
    unsigned sum, cnt, mine, sp = 0u;
    for (;;) {
        sum = 0u; cnt = 0u; mine = 0u;
#pragma unroll
        for (unsigned j = 0; j < 16; ++j) { const unsigned c = xb_ld(&bar[XB_XCNT(j)]); sum += c; cnt += (c > 0u) ? 1u : 0u; mine = (j == x) ? c : mine; }
        if (sum == G) break;
        __builtin_amdgcn_s_sleep(1);
        if ((++sp & 255u) == 0u) { if (xb_ld(&bar[XB_TMO])) break; if (sp > XB_SPIN_CAP) { atomicAdd(&bar[XB_TMO], 1u); break; } }
    }
    nloc = mine > 0u ? mine : 1u; nx = cnt > 0u ? cnt : 1u;
}
__device__ __forceinline__ void xcd_barrier(const XcdBarrier& b) {
    asm volatile("s_waitcnt vmcnt(0)" ::: "memory");
    __syncthreads();
    if (threadIdx.x == 0) {
        unsigned* bar = b.bar;
        __builtin_amdgcn_s_waitcnt(0);
        unsigned nloc = b.st[0], nx = b.st[1];
        if (nloc == 0u) { xcd_barrier_complete(bar, b.x, nloc, nx); b.st[0] = nloc; b.st[1] = nx; }
        const unsigned old = xb_add(&bar[XB_XSUB(b.x)], 1u);
        const unsigned gen = old / nloc;
        if (old + 1u == (gen + 1u) * nloc) {
            __builtin_amdgcn_fence(__ATOMIC_RELEASE, "agent");
            asm volatile("s_waitcnt vmcnt(0)" ::: "memory");
            const unsigned og = xb_add(&bar[XB_TOP], 1u);
            const unsigned tg = og / nx;
            if (og + 1u == (tg + 1u) * nx) xb_add(&bar[XB_TOPGEN], 1u);
            else XB_SPIN(xb_ld(&bar[XB_TOPGEN]) == tg, bar);
            __builtin_amdgcn_fence(__ATOMIC_ACQUIRE, "agent");
            xb_add(&bar[XB_XGEN(b.x)], 1u);
            asm volatile("s_waitcnt vmcnt(0)" ::: "memory");
        } else {
            XB_SPIN(xb_ld(&bar[XB_XGEN(b.x)]) == gen, bar);
            __builtin_amdgcn_fence(__ATOMIC_ACQUIRE, "agent");
            asm volatile("s_waitcnt vmcnt(0)" ::: "memory");
        }
    }
    __syncthreads();
}

struct Frame {
    LAS unsigned char* lds;
    volatile LAS unsigned* MISC;
    gu32* ctl;
    int tid, lane, wave, vcu, G, bx;
    float* out;
    unsigned char* ws;
};
enum { I_X = 0, I_NMIXPRE, I_NMIXPOST, I_NMLPPRE, I_NMLPPOST, I_WIN, I_WINV, I_MU, I_MUV, I_W0, I_W2, I_A0, I_A2, I_V0, I_V2, I_G2, I_KK, I_KA, I_RK, I_LNG, I_LNB, I_WOUT, I_WUP, I_WDN };

__device__ __forceinline__ const float* inp_(const Frame& F, int i) {
    const unsigned long long v = *(const LAS unsigned long long*)(F.lds + PTAB_OFF + 8 * i);
    const unsigned lo = __builtin_amdgcn_readfirstlane((unsigned)v), hi = __builtin_amdgcn_readfirstlane((unsigned)(v >> 32));
    return (const float*)(((unsigned long long)hi << 32) | lo);
}
#define INP(i) inp_(F, (i))
#define DPP_ADD(v, ctrl) ((v) + __builtin_bit_cast(float, __builtin_amdgcn_update_dpp(0, __builtin_bit_cast(int, (v)), (ctrl), 0xF, 0xF, true)))
__device__ __forceinline__ float wave_sum(float v) {
    v = DPP_ADD(v, 0xB1);
    v = DPP_ADD(v, 0x4E);
    v = DPP_ADD(v, 0x141);
    v = DPP_ADD(v, 0x140);
    v += __shfl_xor(v, 16); v += __shfl_xor(v, 32);
    return v;
}
__device__ __forceinline__ void transpose_item(const float* W, int K, int N, bf16* WT, int row_off, LAS float* scr, int item, int lane) {
    const int nblk = N / 32, kb = item / nblk, nb = item % nblk, k0 = 64 * kb, n0 = 32 * nb;
#pragma unroll 8
    for (int i = 0; i < 32; ++i) { const int kk = 2 * i + (lane >> 5); scr[kk * 33 + (lane & 31)] = W[(size_t)(k0 + kk) * N + n0 + (lane & 31)]; }
    LDS_WAIT(); asm volatile("" ::: "memory");
    const int c = lane & 7;
#pragma unroll
    for (int j = 0; j < 4; ++j) { const int n = (lane >> 3) + 8 * j; const LAS float* s = scr + (8 * c) * 33 + n;
        v4u o; o.x = pk2(s[0 * 33], s[1 * 33]); o.y = pk2(s[2 * 33], s[3 * 33]); o.z = pk2(s[4 * 33], s[5 * 33]); o.w = pk2(s[6 * 33], s[7 * 33]);
        *(GAS v4u*)(WT + (size_t)(row_off + n0 + n) * K + k0 + 8 * c) = o; }
    LDS_WAIT(); asm volatile("" ::: "memory");
}
__device__ __forceinline__ void rmsnorm_row_to_bf16(const float* xrow, const float* gain, bf16* orow, int lane) {
    const GAS f32x4* xr = (const GAS f32x4*)xrow + lane; const GAS f32x4* gr = (const GAS f32x4*)gain + lane;
    f32x4 v[8]; float s = 0.f;
#pragma unroll
    for (int j = 0; j < 8; ++j) { v[j] = xr[64 * j]; s += (v[j].x * v[j].x + v[j].y * v[j].y) + (v[j].z * v[j].z + v[j].w * v[j].w); }
    const float rs = 1.0f / sqrtf(wave_sum(s) * (1.f / D) + NORM_EPS);
    GAS v2u* o8 = (GAS v2u*)orow + lane;
#pragma unroll
    for (int j = 0; j < 8; ++j) { const f32x4 g = gr[64 * j]; v2u w; w.x = pk2(v[j].x * rs * g.x, v[j].y * rs * g.y); w.y = pk2(v[j].z * rs * g.z, v[j].w * rs * g.w); o8[64 * j] = w; }
}
__device__ __forceinline__ void ph_convert(Frame& F, int L) {
    LAS float* scr = (LAS float*)(F.lds + F.wave * 16384);
    const int gw = F.vcu * NWAVES + F.wave, NGW = F.G * NWAVES;
    bf16* WinT = (bf16*)(F.ws + WS_WIN); bf16* WoutT = (bf16*)(F.ws + WS_WOUT); bf16* WupT = (bf16*)(F.ws + WS_WUP); bf16* WdnT = (bf16*)(F.ws + WS_WDN);
    constexpr int I_IN = (D / 64) * (NIN / 32), I_VR = (D / 64), I_OUT = (D / 64) * (D / 32), I_UP = (D / 64) * (FF / 32), I_DN = (FF / 64) * (D / 32);
    const int nvr = (L > 0) ? I_VR : 0;
    const int NITEMS = I_IN + nvr + I_OUT + I_UP + I_DN;
    for (int it = gw; it < NITEMS; it += NGW) {
        int r = it;
        if (r < I_IN) { transpose_item(INP(I_WIN) + (size_t)L * D * NIN, D, NIN, WinT, 0, scr, r, F.lane); continue; } r -= I_IN;
        if (r < nvr) { transpose_item(INP(I_WINV) + (size_t)(L - 1) * D * 32, D, 32, WinT, NIN, scr, r, F.lane); continue; } r -= nvr;
        if (r < I_OUT) { transpose_item(INP(I_WOUT) + (size_t)L * D * D, D, D, WoutT, 0, scr, r, F.lane); continue; } r -= I_OUT;
        if (r < I_UP) { transpose_item(INP(I_WUP) + (size_t)L * D * FF, D, FF, WupT, 0, scr, r, F.lane); continue; } r -= I_UP;
        transpose_item(INP(I_WDN) + (size_t)L * FF * D, FF, D, WdnT, 0, scr, r, F.lane);
    }
    if (L > 0) {
        const int gt = F.vcu * NTHR + F.tid, NGT = F.G * NTHR;
        for (int i = gt; i < (NZ - NIN - 32) * (D / 8); i += NGT) *(GAS v4u*)(WinT + (size_t)(NIN + 32) * D + (size_t)i * 8) = (v4u){0u, 0u, 0u, 0u};
    }
    {
        bf16* W2T = (bf16*)(F.ws + WS_LW); bf16* A2T = W2T + C * 64; bf16* G2T = A2T + C * 64; bf16* V2T = G2T + C * 128;
        for (int it = gw; it < 32 + 32 + 64; it += NGW) {
            if (it < 32) transpose_item(INP(I_W2) + (size_t)L * 64 * C, 64, C, W2T, 0, scr, it, F.lane);
            else if (it < 64) transpose_item(INP(I_A2) + (size_t)L * 64 * C, 64, C, A2T, 0, scr, it - 32, F.lane);
            else transpose_item(INP(I_G2) + (size_t)L * 128 * C, 128, C, G2T, 0, scr, it - 64, F.lane);
        }
        const int gt = F.vcu * NTHR + F.tid, NGT = F.G * NTHR;
        if (L > 0) { const float* v2 = INP(I_V2) + (size_t)(L - 1) * 32 * C; for (int i = gt; i < 32 * C; i += NGT) { const int cch = i >> 5, k = i & 31; V2T[i] = (bf16)f2bf(v2[(size_t)k * C + cch]); } }
        if (L == 0) { float* RC = (float*)(F.ws + WS_ROPE); float* RS = RC + SEQ * 64;
            for (int i = gt; i < SEQ * 64; i += NGT) { const int pos = i >> 6, d = i & 63; const float inv_freq = exp2f(-(float)d * (13.287712379549449f / 64.0f)); float sn, cs; sincosf((float)pos * inv_freq, &sn, &cs); RC[i] = cs; RS[i] = sn; } }
    }
    if (L == 0) {
        bf16* HN = (bf16*)(F.ws + WS_HN);
        for (int m = gw; m < T; m += NGW) rmsnorm_row_to_bf16(INP(I_X) + (size_t)m * D, INP(I_NMIXPRE), HN + (size_t)m * D, F.lane);
    }
}
__device__ __forceinline__ void ph_resnorm(Frame& F, const float* y, const float* xin, const float* gA, const float* gB, float* xout, bf16* hn) {
    const int gw = F.vcu * NWAVES + F.wave, NGW = F.G * NWAVES;
    for (int m = gw; m < T; m += NGW) {
        const GAS f32x4* yr = (const GAS f32x4*)(y + (size_t)m * D) + F.lane; const GAS f32x4* xr = (const GAS f32x4*)(xin + (size_t)m * D) + F.lane;
        const GAS f32x4* ga = (const GAS f32x4*)gA + F.lane;
        f32x4 v[8]; float s = 0.f;
#pragma unroll
        for (int j = 0; j < 8; ++j) { v[j] = yr[64 * j]; s += (v[j].x * v[j].x + v[j].y * v[j].y) + (v[j].z * v[j].z + v[j].w * v[j].w); }
        const float rs = 1.0f / sqrtf(wave_sum(s) * (1.f / D) + NORM_EPS);
        float s2 = 0.f;
        GAS f32x4* xo = (GAS f32x4*)(xout + (size_t)m * D) + F.lane;
#pragma unroll
        for (int j = 0; j < 8; ++j) { const f32x4 g = ga[64 * j]; const f32x4 x = xr[64 * j];
            v[j].x = x.x + v[j].x * rs * g.x; v[j].y = x.y + v[j].y * rs * g.y; v[j].z = x.z + v[j].z * rs * g.z; v[j].w = x.w + v[j].w * rs * g.w;
            xo[64 * j] = v[j]; s2 += (v[j].x * v[j].x + v[j].y * v[j].y) + (v[j].z * v[j].z + v[j].w * v[j].w); }
        if (gB) {
            const float rs2 = 1.0f / sqrtf(wave_sum(s2) * (1.f / D) + NORM_EPS);
            const GAS f32x4* gb = (const GAS f32x4*)gB + F.lane; GAS v2u* o8 = (GAS v2u*)(hn + (size_t)m * D) + F.lane;
#pragma unroll
            for (int j = 0; j < 8; ++j) { const f32x4 g = gb[64 * j]; v2u w; w.x = pk2(v[j].x * rs2 * g.x, v[j].y * rs2 * g.y); w.y = pk2(v[j].z * rs2 * g.z, v[j].w * rs2 * g.w); o8[64 * j] = w; }
        }
    }
}
__device__ __forceinline__ float sigmoidf_(float x) { return 1.0f / (1.0f + __expf(-x)); }
__device__ __forceinline__ float softplusf_(float x) { return fmaxf(x, 0.f) + log1pf(__expf(-fabsf(x))); }

__device__ __forceinline__ void prep_xl_items(Frame& F, int L) {
    const bf16* Z = (const bf16*)(F.ws + WS_Z); bf16* XL = (bf16*)(F.ws + WS_XL);
    const float* mu = INP(I_MU) + (size_t)L * NSHIFT; const float* muv = INP(I_MUV) + (size_t)(L > 0 ? L - 1 : 0) * 32;
    const int gt = F.vcu * NTHR + F.tid, NGT = F.G * NTHR;
    for (int it = gt; it < T * 36; it += NGT) {
        const int t = it / 36, j8 = it - t * 36, s = t & (SEQ - 1);
        v4u o = (v4u){0u, 0u, 0u, 0u};
        if (j8 < 32 || L > 0) {
            const int col = (j8 < 32) ? (3072 + 8 * j8) : (ZVD + 8 * (j8 - 32));
            const float* mup = (j8 < 32) ? (mu + col) : (muv + 8 * (j8 - 32));
            const v4u zc = *(const GAS v4u*)(Z + (size_t)t * NZ + col);
            v4u zp = (v4u){0u, 0u, 0u, 0u}; if (s) zp = *(const GAS v4u*)(Z + (size_t)(t - 1) * NZ + col);
            const f32x4 m0 = *(const GAS f32x4*)mup, m1 = *(const GAS f32x4*)(mup + 4);
            float f[8];
#pragma unroll
            for (int q = 0; q < 4; ++q) { const float c0 = bflo(zc[q]), c1 = bfhi(zc[q]), p0 = bflo(zp[q]), p1 = bfhi(zp[q]);
                const float ma = (q < 2) ? m0[2 * q] : m1[2 * q - 4], mb = (q < 2) ? m0[2 * q + 1] : m1[2 * q - 3];
                f[2 * q] = c0 + (p0 - c0) * ma; f[2 * q + 1] = c1 + (p1 - c1) * mb; }
            if (j8 < 8) {
#pragma unroll
                for (int q = 0; q < 8; ++q) f[q] = tanhf(f[q]);
            } else if (j8 >= 16 && j8 < 32) {
#pragma unroll
                for (int q = 0; q < 8; ++q) f[q] = sigmoidf_(f[q]);
            }
            o = (v4u){pk2(f[0], f[1]), pk2(f[2], f[3]), pk2(f[4], f[5]), pk2(f[6], f[7])};
        }
        *(GAS v4u*)(XL + (size_t)t * 288 + 8 * j8) = o;
    }
}
__device__ __forceinline__ void prep_attn_unit(Frame& F, int u) {
    const bf16* Z = (const bf16*)(F.ws + WS_Z);
    bf16* AQ = (bf16*)(F.ws + WS_AQ); bf16* AKp = (bf16*)(F.ws + WS_AK); bf16* AVT = (bf16*)(F.ws + WS_AVT); float* KM = (float*)(F.ws + WS_KM);
    const float* RC = (const float*)(F.ws + WS_ROPE); const float* RS = RC + SEQ * 64;
    const int b = u / (NBLK * AH), rem = u % (NBLK * AH), blk = rem / AH, h = rem % AH;
    const int tid = F.tid, d = 8 * (tid & 7), tg = tid >> 3;
    const int tb = b * SEQ + blk * MB;
    LAS float* red = (LAS float*)F.lds;
    LAS bf16* vt = (LAS bf16*)(F.lds + 32768);
    __syncthreads();
    float ks[16];
#pragma unroll
    for (int q = 0; q < 16; ++q) ks[q] = 0.f;
#pragma unroll
    for (int i = 0; i < 4; ++i) {
        const int tok = tg + 64 * i; const int pos = blk * MB + tok; const size_t t = (size_t)(tb + tok);
        const f32x4 c0 = *(const GAS f32x4*)(RC + pos * 64 + d), c1 = *(const GAS f32x4*)(RC + pos * 64 + d + 4);
        const f32x4 s0 = *(const GAS f32x4*)(RS + pos * 64 + d), s1 = *(const GAS f32x4*)(RS + pos * 64 + d + 4);
        const v4u ql = *(const GAS v4u*)(Z + t * NZ + ZQ + h * AD + d), qh = *(const GAS v4u*)(Z + t * NZ + ZQ + h * AD + 64 + d);
        const v4u kl = *(const GAS v4u*)(Z + t * NZ + ZK + h * AD + d), kh = *(const GAS v4u*)(Z + t * NZ + ZK + h * AD + 64 + d);
        float qlo[8], qhi[8], klo[8], khi[8];
#pragma unroll
        for (int q = 0; q < 4; ++q) { qlo[2 * q] = bflo(ql[q]); qlo[2 * q + 1] = bfhi(ql[q]); qhi[2 * q] = bflo(qh[q]); qhi[2 * q + 1] = bfhi(qh[q]);
            klo[2 * q] = bflo(kl[q]); klo[2 * q + 1] = bfhi(kl[q]); khi[2 * q] = bflo(kh[q]); khi[2 * q + 1] = bfhi(kh[q]); }
        float oq1[8], oq2[8], ok1[8], ok2[8];
#pragma unroll
        for (int q = 0; q < 8; ++q) { const float cs = (q < 4) ? c0[q] : c1[q - 4], sn = (q < 4) ? s0[q] : s1[q - 4];
            oq1[q] = qlo[q] * cs - qhi[q] * sn; oq2[q] = qhi[q] * cs + qlo[q] * sn; ok1[q] = klo[q] * cs - khi[q] * sn; ok2[q] = khi[q] * cs + klo[q] * sn;
            ks[q] += ok1[q]; ks[8 + q] += ok2[q]; }
        *(GAS v4u*)(AQ + t * C + h * AD + d) = (v4u){pk2(oq1[0], oq1[1]), pk2(oq1[2], oq1[3]), pk2(oq1[4], oq1[5]), pk2(oq1[6], oq1[7])};
        *(GAS v4u*)(AQ + t * C + h * AD + 64 + d) = (v4u){pk2(oq2[0], oq2[1]), pk2(oq2[2], oq2[3]), pk2(oq2[4], oq2[5]), pk2(oq2[6], oq2[7])};
        *(GAS v4u*)(AKp + t * C + h * AD + d) = (v4u){pk2(ok1[0], ok1[1]), pk2(ok1[2], ok1[3]), pk2(ok1[4], ok1[5]), pk2(ok1[6], ok1[7])};
        *(GAS v4u*)(AKp + t * C + h * AD + 64 + d) = (v4u){pk2(ok2[0], ok2[1]), pk2(ok2[2], ok2[3]), pk2(ok2[4], ok2[5]), pk2(ok2[6], ok2[7])};
    }
    *(LAS f32x4*)(red + tg * 128 + d) = (f32x4){ks[0], ks[1], ks[2], ks[3]}; *(LAS f32x4*)(red + tg * 128 + d + 4) = (f32x4){ks[4], ks[5], ks[6], ks[7]};
    *(LAS f32x4*)(red + tg * 128 + 64 + d) = (f32x4){ks[8], ks[9], ks[10], ks[11]}; *(LAS f32x4*)(red + tg * 128 + 64 + d + 4) = (f32x4){ks[12], ks[13], ks[14], ks[15]};
    for (int i = 0; i < 64; ++i) { const int idx = tid + NTHR * i; const int tok = idx >> 7, dd = idx & 127;
        vt[dd * 264 + tok] = Z[(size_t)(tb + tok) * NZ + ZV + h * AD + dd]; }
    __syncthreads();
    if (tid < 128) { float s = 0.f;
#pragma unroll 8
        for (int w = 0; w < 64; ++w) s += red[w * 128 + tid];
        KM[((size_t)(b * AH + h) * NBLK + blk) * AD + tid] = s * (1.0f / MB); }
    for (int i = 0; i < 8; ++i) { const int idx = tid + NTHR * i; const int dd = idx >> 5, ch = idx & 31;
        const v4u v = *(const LAS v4u*)(vt + dd * 264 + ch * 8);
        *(GAS v4u*)(AVT + ((size_t)(b * AH + h) * AD + dd) * SEQ + blk * MB + ch * 8) = v; }
}
__device__ __forceinline__ void ph_prep(Frame& F, int L) {
    prep_xl_items(F, L);
    for (int u = F.vcu; u < BATCH * NBLK * AH; u += F.G) prep_attn_unit(F, u);
}

typedef short bf16x4 __attribute__((ext_vector_type(4)));
constexpr int NCHK = SEQ / 64;
constexpr int NUNIT = BATCH * NH * NCHK;
constexpr int CP = 144, MATB = 64 * CP;
constexpr int L_ARA = 0, L_ARR = MATB, L_BKB = 2 * MATB, L_BKK = 3 * MATB, L_AT = 4 * MATB, L_BT = 5 * MATB, L_KT = 6 * MATB, L_VT = 7 * MATB;
constexpr int L_AAB = 8 * MATB, L_AAK = 9 * MATB, L_ARB = 10 * MATB, L_ARK = 11 * MATB, L_ND = 12 * MATB, L_TB = L_ND + 4096;
constexpr int XLP = 592;
constexpr int L_XL = 8 * MATB, L_LW = L_XL + 64 * XLP, L_LA = L_LW + 16384, L_LV = L_LA + 8192, L_SEG = L_LV + 8192, L_GL = L_SEG + 2048;
static_assert(L_TB + 2048 <= L_SEG && L_GL + 256 <= RING_BYTES, "wkv LDS map");
constexpr int L_W2T = L_ARA, L_PT = L_BKB, L_QT = L_BKK;
constexpr size_t WS_CM = WS_CHUNK, WS_CG = WS_CM + (size_t)NUNIT * 8192, WS_CRY = WS_CG + (size_t)NUNIT * 16384, WS_CYC = WS_CRY + (size_t)NUNIT * 8192;
static_assert(WS_CYC + (size_t)NUNIT * 16384 <= WS_END, "chunk outputs");
constexpr size_t WS_CS = WS_HN;
constexpr size_t WS_BON = WS_HN + (size_t)NUNIT * 8192;
static_assert(WS_BON + (size_t)T * NH * 4 <= WS_YC, "HN region");

__device__ __forceinline__ f32x4 mfma32(bf16x8 a, bf16x8 b, f32x4 c) { return __builtin_amdgcn_mfma_f32_16x16x32_bf16(a, b, c, 0, 0, 0); }
__device__ __forceinline__ f32x4 mfma16(bf16x4 a, bf16x4 b, f32x4 c) { return __builtin_amdgcn_mfma_f32_16x16x16bf16_1k(a, b, c, 0, 0, 0); }
__device__ __forceinline__ v2u pk4(f32x4 v) { v2u w; w.x = pk2(v[0], v[1]); w.y = pk2(v[2], v[3]); return w; }

__device__ __forceinline__ void wkv_r1_unit(Frame& F, int L, int unit) {
    const int c = unit % NCHK, bh = unit / NCHK, h = bh % NH, b = bh / NH;
    const int tid = F.tid, lane = F.lane, w = F.wave, fr = lane & 15, g = lane >> 4;
    LAS unsigned char* lds = F.lds;
    const bf16* Z = (const bf16*)(F.ws + WS_Z);
    const size_t tok0 = (size_t)b * SEQ + (size_t)c * 64;
    __syncthreads();
    { const bf16* XLg = (const bf16*)(F.ws + WS_XL) + tok0 * 288;
      for (int idx = tid; idx < 64 * 36; idx += NTHR) { const int row = idx / 36, ch = idx - row * 36;
          *(LAS v4u*)(lds + L_XL + row * XLP + ch * 16) = *(const GAS v4u*)(XLg + row * 288 + ch * 8); } }
    __syncthreads();
    {
        const int nt = w & 3, mt0 = 2 * (w >> 2), cl = 16 * nt + fr, ch = h * HD + cl;
        const bf16* W2T = (const bf16*)(F.ws + WS_LW); const bf16* A2T = W2T + C * 64; const bf16* G2T = A2T + C * 64; const bf16* V2T = G2T + C * 128;
        bf16* SG = (bf16*)(F.ws + WS_SG);
        const float w0c = INP(I_W0)[(size_t)L * C + ch], a0c = INP(I_A0)[(size_t)L * C + ch];
        const LAS unsigned char* xa0 = lds + L_XL + (16 * mt0 + fr) * XLP + g * 16; const LAS unsigned char* xa1 = xa0 + 16 * XLP;
        {
            const bf16x8 b0 = *(const GAS bf16x8*)(W2T + (size_t)ch * 64 + 8 * g), b1 = *(const GAS bf16x8*)(W2T + (size_t)ch * 64 + 32 + 8 * g);
            f32x4 c0 = (f32x4){0.f, 0.f, 0.f, 0.f}, c1 = c0;
            c0 = mfma32(*(const LAS bf16x8*)(xa0), b0, c0); c0 = mfma32(*(const LAS bf16x8*)(xa0 + 64), b1, c0);
            c1 = mfma32(*(const LAS bf16x8*)(xa1), b0, c1); c1 = mfma32(*(const LAS bf16x8*)(xa1 + 64), b1, c1);
#pragma unroll
            for (int i = 0; i < 4; ++i) { const float wl0 = -softplusf_(-(c0[i] + w0c)) - 0.5f, wl1 = -softplusf_(-(c1[i] + w0c)) - 0.5f;
                ((LAS float*)(lds + L_LW))[(16 * mt0 + 4 * g + i) * 64 + cl] = -__expf(wl0); ((LAS float*)(lds + L_LW))[(16 * mt0 + 16 + 4 * g + i) * 64 + cl] = -__expf(wl1); }
        }
        {
            const bf16x8 b0 = *(const GAS bf16x8*)(A2T + (size_t)ch * 64 + 8 * g), b1 = *(const GAS bf16x8*)(A2T + (size_t)ch * 64 + 32 + 8 * g);
            f32x4 c0 = (f32x4){0.f, 0.f, 0.f, 0.f}, c1 = c0;
            c0 = mfma32(*(const LAS bf16x8*)(xa0 + 128), b0, c0); c0 = mfma32(*(const LAS bf16x8*)(xa0 + 192), b1, c0);
            c1 = mfma32(*(const LAS bf16x8*)(xa1 + 128), b0, c1); c1 = mfma32(*(const LAS bf16x8*)(xa1 + 192), b1, c1);
#pragma unroll
            for (int i = 0; i < 4; ++i) { ((LAS unsigned short*)(lds + L_LA))[(16 * mt0 + 4 * g + i) * 64 + cl] = (unsigned short)f2bf(sigmoidf_(c0[i] + a0c));
                ((LAS unsigned short*)(lds + L_LA))[(16 * mt0 + 16 + 4 * g + i) * 64 + cl] = (unsigned short)f2bf(sigmoidf_(c1[i] + a0c)); }
        }
        {
            f32x4 c0 = (f32x4){0.f, 0.f, 0.f, 0.f}, c1 = c0;
#pragma unroll
            for (int ks = 0; ks < 4; ++ks) { const bf16x8 bb = *(const GAS bf16x8*)(G2T + (size_t)ch * 128 + 32 * ks + 8 * g);
                c0 = mfma32(*(const LAS bf16x8*)(xa0 + 256 + 64 * ks), bb, c0); c1 = mfma32(*(const LAS bf16x8*)(xa1 + 256 + 64 * ks), bb, c1); }
#pragma unroll
            for (int i = 0; i < 4; ++i) { SG[(tok0 + 16 * mt0 + 4 * g + i) * C + ch] = (bf16)f2bf(c0[i]); SG[(tok0 + 16 * mt0 + 16 + 4 * g + i) * C + ch] = (bf16)f2bf(c1[i]); }
        }
        if (L > 0) {
            const float v0c = INP(I_V0)[(size_t)(L - 1) * C + ch];
            const bf16x8 b0 = *(const GAS bf16x8*)(V2T + (size_t)ch * 32 + 8 * g);
            f32x4 c0 = (f32x4){0.f, 0.f, 0.f, 0.f}, c1 = c0;
            c0 = mfma32(*(const LAS bf16x8*)(xa0 + 512), b0, c0); c1 = mfma32(*(const LAS bf16x8*)(xa1 + 512), b0, c1);
#pragma unroll
            for (int i = 0; i < 4; ++i) { ((LAS unsigned short*)(lds + L_LV))[(16 * mt0 + 4 * g + i) * 64 + cl] = (unsigned short)f2bf(sigmoidf_(c0[i] + v0c));
                ((LAS unsigned short*)(lds + L_LV))[(16 * mt0 + 16 + 4 * g + i) * 64 + cl] = (unsigned short)f2bf(sigmoidf_(c1[i] + v0c)); }
        }
    }
    __syncthreads();
    {
        const int sg = w, j = lane, ch = h * HD + j;
        const float* mu = INP(I_MU) + (size_t)L * NSHIFT;
        const float mur = mu[ch], muk = mu[C + ch], muv = mu[2 * C + ch];
        const float kkc = INP(I_KK)[(size_t)L * C + ch], kac = INP(I_KA)[(size_t)L * C + ch], rkj = INP(I_RK)[(size_t)L * C + ch];
        float* VF = (float*)(F.ws + WS_VF); bf16* SVg = (bf16*)(F.ws + WS_SV);
        const size_t tokA = tok0 + 8 * sg;
        float zpr = 0.f, zpk = 0.f, zpv = 0.f;
        if (c != 0 || sg != 0) { const bf16* zp = Z + (tokA - 1) * NZ; zpr = bf2f(zp[ch]); zpk = bf2f(zp[C + ch]); zpv = bf2f(zp[2 * C + ch]); }
        float lw[8], cum[8], rf[8], kf[8], kkf[8], af[8]; unsigned vb[8];
#pragma unroll
        for (int e = 0; e < 8; ++e) {
            const bf16* zc = Z + (tokA + e) * NZ; const int t = 8 * sg + e;
            const float zr = bf2f(zc[ch]), zk = bf2f(zc[C + ch]), zv = bf2f(zc[2 * C + ch]);
            const float r = zr + (zpr - zr) * mur, k = zk + (zpk - zk) * muk; float v = zv + (zpv - zv) * muv;
            zpr = zr; zpk = zk; zpv = zv;
            lw[e] = ((const LAS float*)(lds + L_LW))[t * 64 + j];
            const float a = bf2f(((const LAS unsigned short*)(lds + L_LA))[t * 64 + j]);
            const size_t o = (tokA + e) * C + ch;
            if (L == 0) VF[o] = v; else { const float sv = bf2f(((const LAS unsigned short*)(lds + L_LV))[t * 64 + j]); v = v + (VF[o] - v) * sv; }
            vb[e] = f2bf(v); SVg[o] = (bf16)vb[e];
            float kk = k * kkc; const float ss = wave_sum(kk * kk); kk = kk / fmaxf(sqrtf(ss), 1e-12f);
            rf[e] = r; kf[e] = k * (1.f + (a - 1.f) * kac); kkf[e] = kk; af[e] = a;
        }
        float run = 0.f;
#pragma unroll
        for (int e = 0; e < 8; ++e) { run += lw[e]; cum[e] = run; }
        LAS float* seg = (LAS float*)(lds + L_SEG);
        seg[sg * 64 + j] = run;
        __syncthreads();
        float off = 0.f, tot = 0.f;
#pragma unroll
        for (int s2 = 0; s2 < 8; ++s2) { const float v = seg[s2 * 64 + j]; tot += v; off += (s2 < sg) ? v : 0.f; }
        if (sg == 0) ((LAS float*)(lds + L_GL))[j] = __expf(tot);
        unsigned at8[4], bt8[4], kt8[4], vt8[4];
        float* BON = (float*)(F.ws + WS_BON);
#pragma unroll
        for (int e = 0; e < 8; ++e) {
            const float cu = cum[e] + off, ce = cu - lw[e];
            const float eC = __expf(cu), eE = __expf(ce), eN = __expf(-cu);
            const unsigned At = f2bf(-kkf[e] * eE), Rt = f2bf(rf[e] * eC), Bt = f2bf(kkf[e] * af[e] * eN), Kt = f2bf(kf[e] * eN);
            const int t = 8 * sg + e;
            *(LAS unsigned short*)(lds + L_ARA + t * CP + j * 2) = (unsigned short)At;
            *(LAS unsigned short*)(lds + L_ARR + t * CP + j * 2) = (unsigned short)Rt;
            *(LAS unsigned short*)(lds + L_BKB + t * CP + j * 2) = (unsigned short)Bt;
            *(LAS unsigned short*)(lds + L_BKK + t * CP + j * 2) = (unsigned short)Kt;
            if (e & 1) { at8[e >> 1] |= At << 16; bt8[e >> 1] |= Bt << 16; kt8[e >> 1] |= Kt << 16; vt8[e >> 1] |= vb[e] << 16; }
            else { at8[e >> 1] = At; bt8[e >> 1] = Bt; kt8[e >> 1] = Kt; vt8[e >> 1] = vb[e]; }
            const float bs = wave_sum(rf[e] * kf[e] * rkj);
            if (j == 0) BON[(tok0 + t) * NH + h] = bs;
        }
        *(LAS v4u*)(lds + L_AT + j * CP + sg * 16) = (v4u){at8[0], at8[1], at8[2], at8[3]};
        *(LAS v4u*)(lds + L_BT + j * CP + sg * 16) = (v4u){bt8[0], bt8[1], bt8[2], bt8[3]};
        *(LAS v4u*)(lds + L_KT + j * CP + sg * 16) = (v4u){kt8[0], kt8[1], kt8[2], kt8[3]};
        *(LAS v4u*)(lds + L_VT + j * CP + sg * 16) = (v4u){vt8[0], vt8[1], vt8[2], vt8[3]};
    }
    __syncthreads();
    {
        const int tq = w & 3; const bool isA = w < 4;
        const LAS unsigned char* Bsrc = lds + (isA ? L_ARA : L_ARR) + (16 * tq + fr) * CP + g * 16;
        const bf16x8 b0 = *(const LAS bf16x8*)Bsrc, b1 = *(const LAS bf16x8*)(Bsrc + 64);
        const int t = 16 * tq + fr;
#pragma unroll
        for (int mt = 0; mt < 8; ++mt) {
            const int sq = mt & 3; const bool isB = mt < 4;
            f32x4 acc = (f32x4){0.f, 0.f, 0.f, 0.f};
            if (sq <= tq) {
                const LAS unsigned char* Asrc = lds + (isB ? L_BKB : L_BKK) + (16 * sq + fr) * CP + g * 16;
                acc = mfma32(*(const LAS bf16x8*)Asrc, b0, acc);
                acc = mfma32(*(const LAS bf16x8*)(Asrc + 64), b1, acc);
            }
            const int s0 = 16 * sq + 4 * g;
#pragma unroll
            for (int i = 0; i < 4; ++i) { const bool keep = isA ? (s0 + i < t) : (s0 + i <= t); acc[i] = keep ? acc[i] : 0.f; }
            const int dst = isB ? (isA ? L_AAB : L_ARB) : (isA ? L_AAK : L_ARK);
            *(LAS v2u*)(lds + dst + t * CP + s0 * 2) = pk4(acc);
            if (isA && isB && sq == tq) *(LAS f32x4*)(lds + L_ND + tq * 1024 + fr * 64 + g * 16) = acc;
        }
    }
    __syncthreads();
    if (w == 0) {
        const int bi = lane >> 4, cc = lane & 15;
        const LAS float* Nb = (const LAS float*)(lds + L_ND + bi * 1024);
        float x[16];
#pragma unroll
        for (int r = 0; r < 16; ++r) {
            float acc = (r == cc) ? 1.f : 0.f;
#pragma unroll
            for (int kq = 0; kq < (r + 3) / 4; ++kq) { const f32x4 n4 = *(const LAS f32x4*)(Nb + r * 16 + 4 * kq);
#pragma unroll
                for (int z = 0; z < 4; ++z) if (4 * kq + z < r) acc += n4[z] * x[4 * kq + z]; }
            x[r] = acc;
            *(LAS unsigned short*)(lds + L_TB + bi * 512 + r * 32 + cc * 2) = (unsigned short)f2bf(acc);
        }
    } else {
        for (int ti = w - 1; ti < 16; ti += 7) {
            const int mt = ti >> 2, nt = ti & 3;
            const LAS unsigned char* Asrc = lds + L_AAK + (16 * mt + fr) * CP + g * 16;
            const LAS unsigned char* Bsrc = lds + L_VT + (16 * nt + fr) * CP + g * 16;
            f32x4 acc = (f32x4){0.f, 0.f, 0.f, 0.f};
            acc = mfma32(*(const LAS bf16x8*)Asrc, *(const LAS bf16x8*)Bsrc, acc);
            acc = mfma32(*(const LAS bf16x8*)(Asrc + 64), *(const LAS bf16x8*)(Bsrc + 64), acc);
            *(LAS v2u*)(lds + L_W2T + (16 * nt + fr) * CP + (16 * mt + 4 * g) * 2) = pk4(acc);
        }
    }
    __syncthreads();
    {
        const LAS unsigned char* rhs = lds + (w < 4 ? L_AT : L_W2T) + (16 * (w & 3) + fr) * CP;
        LAS unsigned char* xout = lds + (w < 4 ? L_PT : L_QT) + (16 * (w & 3) + fr) * CP;
        bf16x4 X[4];
#pragma unroll
        for (int bq = 0; bq < 4; ++bq) {
            const v2u rv = *(const LAS v2u*)(rhs + (16 * bq + 4 * g) * 2);
            f32x4 y = (f32x4){bflo(rv.x), bfhi(rv.x), bflo(rv.y), bfhi(rv.y)};
#pragma unroll
            for (int kb = 0; kb < bq; ++kb) {
                const bf16x4 nf = *(const LAS bf16x4*)(lds + L_AAB + (16 * bq + fr) * CP + (16 * kb + 4 * g) * 2);
                y = mfma16(nf, X[kb], y);
            }
            const v2u yb = pk4(y);
            const bf16x4 tf = *(const LAS bf16x4*)(lds + L_TB + bq * 512 + fr * 32 + g * 8);
            const f32x4 xr = mfma16(tf, __builtin_bit_cast(bf16x4, yb), (f32x4){0.f, 0.f, 0.f, 0.f});
            const v2u xb = pk4(xr);
            X[bq] = __builtin_bit_cast(bf16x4, xb);
            *(LAS v2u*)(xout + (16 * bq + 4 * g) * 2) = xb;
        }
    }
    __syncthreads();
    {
        const int nt = w & 3;
        const LAS float* GL = (const LAS float*)(lds + L_GL);
        if (w < 4) {
            const LAS unsigned char* Bb = lds + L_BT + (16 * nt + fr) * CP + g * 16;
            const bf16x8 bb0 = *(const LAS bf16x8*)Bb, bb1 = *(const LAS bf16x8*)(Bb + 64);
            const LAS unsigned char* Bq = lds + L_QT + (16 * nt + fr) * CP + g * 16;
            const bf16x8 bq0 = *(const LAS bf16x8*)Bq, bq1 = *(const LAS bf16x8*)(Bq + 64);
            const LAS unsigned char* Bv = lds + L_VT + (16 * nt + fr) * CP + g * 16;
            const bf16x8 bv0 = *(const LAS bf16x8*)Bv, bv1 = *(const LAS bf16x8*)(Bv + 64);
            const int jn = 16 * nt + fr; const float glj = GL[jn];
            bf16* Mg = (bf16*)(F.ws + WS_CM) + (size_t)unit * 4096;
            float* Gg = (float*)(F.ws + WS_CG) + (size_t)unit * 4096;
#pragma unroll
            for (int mt = 0; mt < 4; ++mt) {
                const LAS unsigned char* Ap = lds + L_PT + (16 * mt + fr) * CP + g * 16;
                f32x4 acc = (f32x4){0.f, 0.f, 0.f, 0.f};
                acc = mfma32(*(const LAS bf16x8*)Ap, bb0, acc); acc = mfma32(*(const LAS bf16x8*)(Ap + 64), bb1, acc);
#pragma unroll
                for (int i = 0; i < 4; ++i) acc[i] = glj * (acc[i] + ((16 * mt + 4 * g + i == jn) ? 1.f : 0.f));
                *(GAS v2u*)(Mg + jn * 64 + 16 * mt + 4 * g) = pk4(acc);
                const LAS unsigned char* Ab = lds + L_BT + (16 * mt + fr) * CP + g * 16;
                const LAS unsigned char* Ak = lds + L_KT + (16 * mt + fr) * CP + g * 16;
                f32x4 ga = (f32x4){0.f, 0.f, 0.f, 0.f};
                ga = mfma32(*(const LAS bf16x8*)Ab, bq0, ga); ga = mfma32(*(const LAS bf16x8*)(Ab + 64), bq1, ga);
                ga = mfma32(*(const LAS bf16x8*)Ak, bv0, ga); ga = mfma32(*(const LAS bf16x8*)(Ak + 64), bv1, ga);
                const f32x4 gl4 = *(const LAS f32x4*)(GL + 16 * mt + 4 * g);
                ga = ga * gl4;
                *(GAS f32x4*)(Gg + ((nt * 4 + mt) * 64 + lane) * 4) = ga;
            }
        } else {
            const LAS unsigned char* Bb = lds + L_ARB + (16 * nt + fr) * CP + g * 16;
            const bf16x8 bb0 = *(const LAS bf16x8*)Bb, bb1 = *(const LAS bf16x8*)(Bb + 64);
            const LAS unsigned char* Bk = lds + L_ARK + (16 * nt + fr) * CP + g * 16;
            const bf16x8 bk0 = *(const LAS bf16x8*)Bk, bk1 = *(const LAS bf16x8*)(Bk + 64);
            const int tn = 16 * nt + fr;
            bf16* Ryg = (bf16*)(F.ws + WS_CRY) + (size_t)unit * 4096;
            float* Ycg = (float*)(F.ws + WS_CYC) + (size_t)unit * 4096;
#pragma unroll
            for (int mt = 0; mt < 4; ++mt) {
                const LAS unsigned char* Ap = lds + L_PT + (16 * mt + fr) * CP + g * 16;
                const v2u rv = *(const LAS v2u*)(lds + L_ARR + tn * CP + (16 * mt + 4 * g) * 2);
                f32x4 acc = (f32x4){bflo(rv.x), bfhi(rv.x), bflo(rv.y), bfhi(rv.y)};
                acc = mfma32(*(const LAS bf16x8*)Ap, bb0, acc); acc = mfma32(*(const LAS bf16x8*)(Ap + 64), bb1, acc);
                *(GAS v2u*)(Ryg + tn * 64 + 16 * mt + 4 * g) = pk4(acc);
                const LAS unsigned char* Aq = lds + L_QT + (16 * mt + fr) * CP + g * 16;
                const LAS unsigned char* Av = lds + L_VT + (16 * mt + fr) * CP + g * 16;
                f32x4 ya = (f32x4){0.f, 0.f, 0.f, 0.f};
                ya = mfma32(*(const LAS bf16x8*)Aq, bb0, ya); ya = mfma32(*(const LAS bf16x8*)(Aq + 64), bb1, ya);
                ya = mfma32(*(const LAS bf16x8*)Av, bk0, ya); ya = mfma32(*(const LAS bf16x8*)(Av + 64), bk1, ya);
                *(GAS f32x4*)(Ycg + ((mt * 4 + nt) * 64 + lane) * 4) = ya;
            }
        }
    }
}
__device__ __forceinline__ void wkv_r2_wave(Frame& F, int bh, int nt) {
    const int lane = F.lane, fr = lane & 15, g = lane >> 4;
    const bf16* Mg = (const bf16*)(F.ws + WS_CM) + (size_t)bh * NCHK * 4096;
    const float* Gg = (const float*)(F.ws + WS_CG) + (size_t)bh * NCHK * 4096;
    bf16* Sg = (bf16*)(F.ws + WS_CS) + (size_t)bh * NCHK * 4096;
    f32x4 S[4];
#pragma unroll
    for (int mt = 0; mt < 4; ++mt) S[mt] = (f32x4){0.f, 0.f, 0.f, 0.f};
    v2u mA[4][2][2]; f32x4 gC[4];
#define R2_LOAD(cidx) do { const bf16* Mc_ = Mg + (size_t)(cidx) * 4096; const float* Gc_ = Gg + (size_t)(cidx) * 4096; \
        _Pragma("unroll") for (int mt = 0; mt < 4; ++mt) { gC[mt] = *(const GAS f32x4*)(Gc_ + ((nt * 4 + mt) * 64 + lane) * 4); \
            _Pragma("unroll") for (int ks = 0; ks < 2; ++ks) { const bf16* mp = Mc_ + (16 * mt + fr) * 64 + 32 * ks + 4 * g; mA[mt][ks][0] = *(const GAS v2u*)mp; mA[mt][ks][1] = *(const GAS v2u*)(mp + 16); } } } while (0)
    R2_LOAD(0);
    for (int c = 0; c < NCHK; ++c) {
        v2u sb[4];
#pragma unroll
        for (int mt = 0; mt < 4; ++mt) { sb[mt] = pk4(S[mt]); *(GAS v2u*)(Sg + (size_t)c * 4096 + (16 * nt + fr) * 64 + 16 * mt + 4 * g) = sb[mt]; }
        const bf16x8 bf0 = __builtin_bit_cast(bf16x8, (v4u){sb[0].x, sb[0].y, sb[1].x, sb[1].y});
        const bf16x8 bf1 = __builtin_bit_cast(bf16x8, (v4u){sb[2].x, sb[2].y, sb[3].x, sb[3].y});
        f32x4 Sn[4];
#pragma unroll
        for (int mt = 0; mt < 4; ++mt) {
            const bf16x8 a0 = __builtin_bit_cast(bf16x8, (v4u){mA[mt][0][0].x, mA[mt][0][0].y, mA[mt][0][1].x, mA[mt][0][1].y});
            const bf16x8 a1 = __builtin_bit_cast(bf16x8, (v4u){mA[mt][1][0].x, mA[mt][1][0].y, mA[mt][1][1].x, mA[mt][1][1].y});
            Sn[mt] = mfma32(a0, bf0, gC[mt]); Sn[mt] = mfma32(a1, bf1, Sn[mt]);
        }
        if (c + 1 < NCHK) R2_LOAD(c + 1);
#pragma unroll
        for (int mt = 0; mt < 4; ++mt) S[mt] = Sn[mt];
    }
#undef R2_LOAD
}
__device__ __forceinline__ void wkv_r3_wave(Frame& F, int L, int unit) {
    const int c = unit % NCHK, bh = unit / NCHK, h = bh % NH, b = bh / NH;
    const int lane = F.lane, fr = lane & 15, g = lane >> 4;
    const bf16* Sg = (const bf16*)(F.ws + WS_CS) + (size_t)unit * 4096;
    const bf16* Ryg = (const bf16*)(F.ws + WS_CRY) + (size_t)unit * 4096;
    const float* Ycg = (const float*)(F.ws + WS_CYC) + (size_t)unit * 4096;
    const bf16* SV = (const bf16*)(F.ws + WS_SV); const bf16* SG = (const bf16*)(F.ws + WS_SG); const float* BON = (const float*)(F.ws + WS_BON);
    bf16* YC = (bf16*)(F.ws + WS_YC);
    const float* lg = INP(I_LNG) + (size_t)L * C + h * HD; const float* lb = INP(I_LNB) + (size_t)L * C + h * HD;
    const size_t tok0 = (size_t)b * SEQ + (size_t)c * 64;
    bf16x8 sa[4][2];
#pragma unroll
    for (int mt = 0; mt < 4; ++mt)
#pragma unroll
        for (int ks = 0; ks < 2; ++ks) sa[mt][ks] = *(const GAS bf16x8*)(Sg + (16 * mt + fr) * 64 + 32 * ks + 8 * g);
    f32x4 lgv[4], lbv[4];
#pragma unroll
    for (int mt = 0; mt < 4; ++mt) { lgv[mt] = *(const GAS f32x4*)(lg + 16 * mt + 4 * g); lbv[mt] = *(const GAS f32x4*)(lb + 16 * mt + 4 * g); }
#pragma unroll
    for (int nt = 0; nt < 4; ++nt) {
        const int t = 16 * nt + fr;
        const bf16x8 rb0 = *(const GAS bf16x8*)(Ryg + t * 64 + 8 * g), rb1 = *(const GAS bf16x8*)(Ryg + t * 64 + 32 + 8 * g);
        f32x4 y[4]; float s = 0.f;
#pragma unroll
        for (int mt = 0; mt < 4; ++mt) {
            f32x4 acc = *(const GAS f32x4*)(Ycg + ((mt * 4 + nt) * 64 + lane) * 4);
            acc = mfma32(sa[mt][0], rb0, acc); acc = mfma32(sa[mt][1], rb1, acc);
            y[mt] = acc; s += (acc[0] + acc[1]) + (acc[2] + acc[3]);
        }
        s += __shfl_xor(s, 16); s += __shfl_xor(s, 32);
        const float mean = s * (1.f / HD); float q = 0.f;
#pragma unroll
        for (int mt = 0; mt < 4; ++mt) { y[mt] = y[mt] - mean; q += (y[mt][0] * y[mt][0] + y[mt][1] * y[mt][1]) + (y[mt][2] * y[mt][2] + y[mt][3] * y[mt][3]); }
        q += __shfl_xor(q, 16); q += __shfl_xor(q, 32);
        const float rstd = 1.0f / sqrtf(q * (1.f / HD) + LNX_EPS);
        const float bon = BON[(tok0 + t) * NH + h];
#pragma unroll
        for (int mt = 0; mt < 4; ++mt) {
            const size_t o = (tok0 + t) * C + h * HD + 16 * mt + 4 * g;
            const v2u vv = *(const GAS v2u*)(SV + o), gg = *(const GAS v2u*)(SG + o);
            f32x4 r;
            r[0] = (y[mt][0] * rstd * lgv[mt][0] + lbv[mt][0] + bon * bflo(vv.x)) * bflo(gg.x);
            r[1] = (y[mt][1] * rstd * lgv[mt][1] + lbv[mt][1] + bon * bfhi(vv.x)) * bfhi(gg.x);
            r[2] = (y[mt][2] * rstd * lgv[mt][2] + lbv[mt][2] + bon * bflo(vv.y)) * bflo(gg.y);
            r[3] = (y[mt][3] * rstd * lgv[mt][3] + lbv[mt][3] + bon * bfhi(vv.y)) * bfhi(gg.y);
            *(GAS v2u*)(YC + (tok0 + t) * D + h * HD + 16 * mt + 4 * g) = pk4(r);
        }
    }
}

__device__ __forceinline__ int crow(int r, int hi) { return (r & 3) + 8 * (r >> 2) + 4 * hi; }
__device__ __forceinline__ void attn_unit(Frame& F, int b, int h, int qb) {
    const bf16* AQ = (const bf16*)(F.ws + WS_AQ); const bf16* AKp = (const bf16*)(F.ws + WS_AK); const bf16* AVT = (const bf16*)(F.ws + WS_AVT); const float* KM = (const float*)(F.ws + WS_KM);
    bf16* YC = (bf16*)(F.ws + WS_YC);
    const int tid = F.tid, lane = F.lane, wid = F.wave, r32 = lane & 31, hi = lane >> 5;
    constexpr int KBUF = 64 * 256, VPITCH = 136, VBUF = 128 * VPITCH;
    LAS unsigned char* kbuf = F.lds;
    LAS unsigned char* vbuf = F.lds + 2 * KBUF;
    LAS float* kmL = (LAS float*)(F.lds + 2 * KBUF + 2 * VBUF);
    const size_t tb = (size_t)b * SEQ; const int q0 = qb * MB + wid * 32;
    __syncthreads();
    for (int i = tid; i < NBLK * AD; i += NTHR) kmL[i] = KM[(size_t)(b * AH + h) * NBLK * AD + i];
    bf16x8 qr[8];
    { const bf16* Qp = AQ + (tb + q0 + r32) * C + h * AD + hi * 8;
#pragma unroll
      for (int d0 = 0; d0 < 8; ++d0) qr[d0] = *(const GAS bf16x8*)(Qp + d0 * 16); }
    __syncthreads();
    unsigned selmask;
    {
        float g1 = -INFINITY, g2 = -INFINITY, g3 = -INFINITY; int i1 = 0, i2 = 0, i3 = 0;
        for (int n = 0; n < qb; ++n) {
            float acc = 0.f;
#pragma unroll
            for (int d0 = 0; d0 < 8; ++d0) { const LAS f32x4* kp = (const LAS f32x4*)(kmL + n * AD + d0 * 16 + hi * 8); const f32x4 ka = kp[0], kb = kp[1];
                const bf16x8 q = qr[d0];
                acc += bf2f((unsigned short)q[0]) * ka.x + bf2f((unsigned short)q[1]) * ka.y + bf2f((unsigned short)q[2]) * ka.z + bf2f((unsigned short)q[3]) * ka.w
                     + bf2f((unsigned short)q[4]) * kb.x + bf2f((unsigned short)q[5]) * kb.y + bf2f((unsigned short)q[6]) * kb.z + bf2f((unsigned short)q[7]) * kb.w; }
            const float g = acc + __shfl_xor(acc, 32);
            if (g > g1) { g3 = g2; i3 = i2; g2 = g1; i2 = i1; g1 = g; i1 = n; }
            else if (g > g2) { g3 = g2; i3 = i2; g2 = g; i2 = n; }
            else if (g > g3) { g3 = g; i3 = n; }
        }
        selmask = (qb <= 3) ? ((1u << qb) - 1u) : ((1u << i1) | (1u << i2) | (1u << i3));
    }
    const int NT = 4 * (qb + 1);
    v4u kreg[2], vreg[2];
    const bf16* Kg = AKp + tb * C + h * AD; const bf16* Vg = AVT + (size_t)(b * AH + h) * AD * SEQ;
#define TILE_KS(ti) (((ti) < 4) ? (qb * MB + 64 * (ti)) : ((((ti) - 4) >> 2) * MB + 64 * (((ti) - 4) & 3)))
#define ATT_LOAD(ti) do { const int ks_ = TILE_KS(ti); _Pragma("unroll") for (int i_ = 0; i_ < 2; ++i_) { const int idx_ = tid + NTHR * i_; \
        kreg[i_] = *(const GAS v4u*)(Kg + (size_t)(ks_ + (idx_ >> 4)) * C + (idx_ & 15) * 8); \
        vreg[i_] = *(const GAS v4u*)(Vg + (size_t)(idx_ >> 3) * SEQ + ks_ + (idx_ & 7) * 8); } } while (0)
#define ATT_STORE(bi) do { _Pragma("unroll") for (int i_ = 0; i_ < 2; ++i_) { const int idx_ = tid + NTHR * i_; const int row_ = idx_ >> 4, c_ = idx_ & 15; \
        *(LAS v4u*)(kbuf + (bi) * KBUF + row_ * 256 + ((c_ ^ (row_ & 15)) << 4)) = kreg[i_]; \
        LAS v2u* vd_ = (LAS v2u*)(vbuf + (bi) * VBUF + (idx_ >> 3) * VPITCH + (idx_ & 7) * 16); vd_[0] = (v2u){vreg[i_].x, vreg[i_].y}; vd_[1] = (v2u){vreg[i_].z, vreg[i_].w}; } } while (0)
    f32x16 O[4];
#pragma unroll
    for (int dt = 0; dt < 4; ++dt) O[dt] = (f32x16){0.f};
    float m_run = -1e30f, l_run = 0.f;
    const float SC = 0.08838834764831845f * 1.4426950408889634f;
    ATT_LOAD(0); ATT_STORE(0);
    __syncthreads();
    const int qpos = q0 + r32;
    for (int ti = 0; ti < NT; ++ti) {
        if (ti + 1 < NT) ATT_LOAD(ti + 1);
        const LAS unsigned char* kb_ = kbuf + (ti & 1) * KBUF; const LAS unsigned char* vb_ = vbuf + (ti & 1) * VBUF;
        const int ks = TILE_KS(ti);
        f32x16 p[2];
#pragma unroll
        for (int kb2 = 0; kb2 < 2; ++kb2) {
            f32x16 acc = (f32x16){0.f};
            const int row = 32 * kb2 + r32;
#pragma unroll
            for (int d0 = 0; d0 < 8; ++d0) {
                const bf16x8 kf = *(const LAS bf16x8*)(kb_ + row * 256 + (((2 * d0 + hi) ^ (row & 15)) << 4));
                acc = __builtin_amdgcn_mfma_f32_32x32x16_bf16(kf, qr[d0], acc, 0, 0, 0);
            }
            p[kb2] = acc;
        }
        const bool own = ti < 4;
        const bool lane_ok = own || ((selmask >> ((ti - 4) >> 2)) & 1u);
        float mx = -1e30f;
#pragma unroll
        for (int kb2 = 0; kb2 < 2; ++kb2)
#pragma unroll
            for (int r = 0; r < 16; ++r) {
                float s = p[kb2][r] * SC;
                const int kpos = ks + 32 * kb2 + crow(r, hi);
                const bool ok = own ? (kpos <= qpos) : lane_ok;
                s = ok ? s : -1e30f; p[kb2][r] = s; mx = fmaxf(mx, s);
            }
        mx = fmaxf(mx, __shfl_xor(mx, 32));
        const float m_new = fmaxf(m_run, mx);
        const float alpha = exp2f(m_run - m_new);
        m_run = m_new;
        float ls = 0.f;
#pragma unroll
        for (int kb2 = 0; kb2 < 2; ++kb2)
#pragma unroll
            for (int r = 0; r < 16; ++r) { const float e = exp2f(p[kb2][r] - m_new); p[kb2][r] = e; ls += e; }
        l_run = l_run * alpha + ls;
#pragma unroll
        for (int dt = 0; dt < 4; ++dt)
#pragma unroll
            for (int r = 0; r < 16; ++r) O[dt][r] *= alpha;
#pragma unroll
        for (int kb2 = 0; kb2 < 2; ++kb2)
#pragma unroll
            for (int s = 0; s < 2; ++s) {
                v4u pw; pw.x = pk2(p[kb2][8 * s + 0], p[kb2][8 * s + 1]); pw.y = pk2(p[kb2][8 * s + 2], p[kb2][8 * s + 3]); pw.z = pk2(p[kb2][8 * s + 4], p[kb2][8 * s + 5]); pw.w = pk2(p[kb2][8 * s + 6], p[kb2][8 * s + 7]);
                const bf16x8 pf = __builtin_bit_cast(bf16x8, pw);
                const int key0 = 32 * kb2 + 16 * s + 4 * hi;
#pragma unroll
                for (int dt = 0; dt < 4; ++dt) {
                    const LAS unsigned char* vp = vb_ + (32 * dt + r32) * VPITCH + key0 * 2;
                    const v2u lo = *(const LAS v2u*)vp, hi2 = *(const LAS v2u*)(vp + 16);
                    const v4u vw = (v4u){lo.x, lo.y, hi2.x, hi2.y};
                    O[dt] = __builtin_amdgcn_mfma_f32_32x32x16_bf16(__builtin_bit_cast(bf16x8, vw), pf, O[dt], 0, 0, 0);
                }
            }
        if (ti + 1 < NT) ATT_STORE((ti + 1) & 1);
        __syncthreads();
    }
    const float l_tot = l_run + __shfl_xor(l_run, 32);
    const float inv = 1.0f / l_tot;
    bf16* yo = YC + (tb + q0 + r32) * D + C + h * AD;
#pragma unroll
    for (int dt = 0; dt < 4; ++dt)
#pragma unroll
        for (int rq = 0; rq < 4; ++rq) {
            v2u w; w.x = pk2(O[dt][4 * rq] * inv, O[dt][4 * rq + 1] * inv); w.y = pk2(O[dt][4 * rq + 2] * inv, O[dt][4 * rq + 3] * inv);
            *(GAS v2u*)(yo + 32 * dt + 8 * rq + 4 * hi) = w;
        }
#undef TILE_KS
#undef ATT_LOAD
#undef ATT_STORE
}
__device__ __forceinline__ void ph_wkv_r1(Frame& F, int L) { for (int u = F.vcu; u < NUNIT; u += F.G) wkv_r1_unit(F, L, u); }
__device__ __forceinline__ void ph_wkv_r2(Frame& F) { if (F.wave == 0) for (int id = F.vcu; id < BATCH * NH * 4; id += F.G) wkv_r2_wave(F, id >> 2, id & 3); }
__device__ __forceinline__ void ph_mixer(Frame& F, int L) {
    constexpr int NAT = BATCH * AH * NBLK;
    for (int u = F.vcu * NWAVES + F.wave; u < NUNIT; u += F.G * NWAVES) wkv_r3_wave(F, L, u);
    for (int au = F.vcu; au < NAT; au += F.G) { const int qb = NBLK - 1 - au / (BATCH * AH), bh = au % (BATCH * AH); attn_unit(F, bh / AH, bh % AH, qb); }
}

constexpr int PH_PER_LAYER = 11, NPHASE = DEPTH * PH_PER_LAYER;
#ifndef MK_N_LAUNCHES
#define MK_N_LAUNCHES 1
#endif
struct Args { const float* in[24]; float* out; unsigned char* ws; int ph_lo, ph_hi, li, pad; };
__global__ void __launch_bounds__(NTHR, 2) mega_fwd(Args args) {
    extern __shared__ __attribute__((aligned(16))) unsigned char lds[];
    Frame F;
    F.lds = (LAS unsigned char*)lds;
    F.MISC = (volatile LAS unsigned*)(F.lds + MISC_OFF);
    F.tid = threadIdx.x; F.lane = F.tid & 63; F.wave = __builtin_amdgcn_readfirstlane(F.tid >> 6);
    F.G = gridDim.x; { const int bx = blockIdx.x; F.vcu = (F.G % 8 == 0) ? (bx % 8) * (F.G / 8) + bx / 8 : bx; }
    F.ws = args.ws; F.out = args.out; F.ctl = (gu32*)(args.ws + WS_CTL);
    for (int u = F.tid; u < (LDS_BYTES - LDSCTL_OFF) / 4; u += NTHR) ((LAS unsigned*)(F.lds + LDSCTL_OFF))[u] = 0u;
    __syncthreads();
    if (F.tid < 24) *(LAS unsigned long long*)(F.lds + PTAB_OFF + 8 * F.tid) = (unsigned long long)args.in[F.tid];
    __syncthreads();
    XcdBarrier bar; bar.bar = (unsigned*)(F.ctl + CW_BAR) + args.li * XCD_BAR_WORDS; bar.x = 0; bar.st = nullptr;
    const bool one_launch = (args.ph_hi - args.ph_lo) > 1;
    if (one_launch) bar = xcd_barrier_post((unsigned*)(F.ctl + CW_BAR) + args.li * XCD_BAR_WORDS, F.MISC + 8);
    bf16* HN = (bf16*)(F.ws + WS_HN); bf16* YC = (bf16*)(F.ws + WS_YC); bf16* Zb = (bf16*)(F.ws + WS_Z); bf16* U = (bf16*)(F.ws + WS_U);
    float* Y2 = (float*)(F.ws + WS_Y2); float* Mo = (float*)(F.ws + WS_M);
#ifdef PROBE_DUP_MASK
    bool dup_done = false;
#endif
    for (int ph = args.ph_lo; ph < args.ph_hi; ++ph) {
        const int L = ph / PH_PER_LAYER, p = ph % PH_PER_LAYER;
        { int t_ = threadIdx.x; asm volatile("" : "+v"(t_)); F.tid = t_; F.lane = t_ & 63; F.wave = __builtin_amdgcn_readfirstlane(t_ >> 6); }
        { unsigned long long w_ = (unsigned long long)args.ws, o_ = (unsigned long long)args.out; asm volatile("" : "+s"(w_), "+s"(o_)); F.ws = (unsigned char*)w_; F.out = (float*)o_; F.ctl = (gu32*)w_; }
        { int g_ = gridDim.x, b_ = blockIdx.x; asm volatile("" : "+s"(g_), "+s"(b_)); F.G = g_; F.bx = b_; F.vcu = (g_ % 8 == 0) ? (b_ % 8) * (g_ / 8) + b_ / 8 : b_; }
        { unsigned l_ = (unsigned)(unsigned long long)(LAS unsigned char*)lds; asm volatile("" : "+s"(l_)); F.lds = (LAS unsigned char*)(unsigned long long)l_; }
        switch (p) {
        case 0: ph_convert(F, L); break;
        case 1: { pg8::Gemm g{HN, (const bf16*)(F.ws + WS_WIN), T, (L == 0) ? NIN : NZ, D}; pg8::StaticOrder S; S.init(T, (L == 0) ? NIN : NZ, F.G, F.bx);
                  pg8::EpiBf16<0> E{Zb, NZ}; pg8::gemm_phase<pg8::EpiBf16<0>, pg8::StaticOrder, true, true>(F.lds, g, S, E, F.tid); } break;
        case 2: ph_prep(F, L); break;
        case 3: ph_wkv_r1(F, L); break;
        case 4: ph_wkv_r2(F); break;
        case 5: ph_mixer(F, L); break;
        case 6: { pg8::Gemm g{YC, (const bf16*)(F.ws + WS_WOUT), T, D, D}; pg8::StaticOrder S; S.init(T, D, F.G, F.bx);
                  pg8::EpiF32 E{Y2, D}; pg8::gemm_phase<pg8::EpiF32, pg8::StaticOrder, true, true>(F.lds, g, S, E, F.tid); } break;
        case 7: ph_resnorm(F, Y2, (L == 0) ? INP(I_X) : F.out, INP(I_NMIXPOST) + (size_t)L * D, INP(I_NMLPPRE) + (size_t)L * D, F.out, HN); break;
        case 8: { pg8::Gemm g{HN, (const bf16*)(F.ws + WS_WUP), T, FF, D}; pg8::StaticOrder S; S.init(T, FF, F.G, F.bx);
                  pg8::EpiBf16<2> E{U, FF}; pg8::gemm_phase<pg8::EpiBf16<2>, pg8::StaticOrder, true, true>(F.lds, g, S, E, F.tid); } break;
        case 9: { pg8::Gemm g{U, (const bf16*)(F.ws + WS_WDN), T, D, FF}; pg8::StaticOrder S; S.init(T, D, F.G, F.bx);
                  pg8::EpiF32 E{Mo, D}; pg8::gemm_phase<pg8::EpiF32, pg8::StaticOrder, true, true>(F.lds, g, S, E, F.tid); } break;
        case 10: ph_resnorm(F, Mo, F.out, INP(I_NMLPPOST) + (size_t)L * D, (L + 1 < DEPTH) ? INP(I_NMIXPRE) + (size_t)(L + 1) * D : nullptr, F.out, HN); break;
        }
        if (ph + 1 < args.ph_hi) xcd_barrier(bar);
#ifdef PROBE_DUP_MASK
        if (((PROBE_DUP_MASK >> p) & 1) && !dup_done) { dup_done = true; --ph; } else dup_done = false;
#endif
    }
}

extern "C" void kernel_launch(void* const* d_in, const int* in_sizes, int n_in, void* d_out, int out_size, void* d_ws, size_t ws_size, hipStream_t stream) {
    static int grid = 0;
    if (grid == 0) {
        if (n_in != 24 || in_sizes[0] != T * D || out_size != T * D || ws_size < WS_END) { fprintf(stderr, "kernel_launch: unexpected shapes (n_in %d, in0 %d, out %d, ws %zu)\n", n_in, n_in > 0 ? in_sizes[0] : -1, out_size, ws_size); grid = -1; return; }
        int dev = 0, cus = 0, per_cu = 0;
        if (hipGetDevice(&dev) != hipSuccess || hipDeviceGetAttribute(&cus, hipDeviceAttributeMultiprocessorCount, dev) != hipSuccess) { grid = -1; return; }
        if (hipFuncSetAttribute((const void*)mega_fwd, hipFuncAttributeMaxDynamicSharedMemorySize, LDS_BYTES) != hipSuccess) { fprintf(stderr, "kernel_launch: hipFuncSetAttribute failed\n"); grid = -1; return; }
        if (hipOccupancyMaxActiveBlocksPerMultiprocessor(&per_cu, (const void*)mega_fwd, NTHR, LDS_BYTES) != hipSuccess || per_cu < 1) { fprintf(stderr, "kernel_launch: occupancy query says %d\n", per_cu); per_cu = 1; }
        (void)hipGetLastError();
        grid = cus * (per_cu > 1 ? 1 : per_cu);
    }
    if (grid < 0) return;
    (void)hipMemsetAsync((char*)d_ws + WS_CTL, 0, CTL_ZERO_BYTES, stream);
    Args a{};
    for (int i = 0; i < 24; ++i) a.in[i] = (const float*)d_in[i];
    a.out = (float*)d_out; a.ws = (unsigned char*)d_ws;
    const int nl = MK_N_LAUNCHES;
    for (int li = 0; li < nl; ++li) {
        a.li = li; a.ph_lo = (int)((long)NPHASE * li / nl); a.ph_hi = (int)((long)NPHASE * (li + 1) / nl);
        if (a.ph_hi - a.ph_lo > 1) {
            void* kargs[] = {&a};
            hipError_t e = hipLaunchCooperativeKernel((const void*)mega_fwd, dim3(grid), dim3(NTHR), kargs, LDS_BYTES, stream);
            if (e != hipSuccess) fprintf(stderr, "kernel_launch: cooperative launch failed: %s (grid %d)\n", hipGetErrorString(e), grid);
        } else {
            hipLaunchKernelGGL(mega_fwd, dim3(grid), dim3(NTHR), LDS_BYTES, stream, a);
        }
    }
}
```

```cpp
#include <hip/hip_runtime.h>
#include <cstdio>
#include <cstdint>
namespace pg8 {
#define PG8_LAS __attribute__((address_space(3)))
typedef unsigned short bf16_t;
typedef short bf16x8 __attribute__((ext_vector_type(8)));
typedef float f32x4 __attribute__((ext_vector_type(4)));
typedef unsigned u32x4 __attribute__((ext_vector_type(4)));
constexpr int BM = 256, BK = 64, HALF = 128, HTB = HALF * BK * 2  , STAGE_BYTES = 8 * HTB, NXCD = 8, WGM = 8;

__host__ __device__ __forceinline__ int lds_byte(int r, int c) { const int st = (r >> 4) * 2 + (c >> 5), rr = r & 15, cc = c & 31, ob = rr * 64 + cc * 2; return st * 1024 + (ob ^ (((ob >> 9) & 1) << 5)); }
__host__ __device__ __forceinline__ void stage_rc(int b, int& R, int& C) { const int st = b / 1024, sb = b % 1024, swz = sb ^ (((sb >> 9) & 1) << 5); R = (st >> 1) * 16 + swz / 64; C = (st & 1) * 32 + (swz % 64) / 2; }
__host__ __device__ __forceinline__ int perm32(int rho) { const int n = rho >> 4, i = rho & 15; return 8 * (i >> 2) + 4 * n + (i & 3); }

struct Unit { int pm, pn; };
struct Gemm { const bf16_t* A; const bf16_t* Bt; int M, N, K; };

struct StaticOrder {
    int nM, nN, nwg, G, c;
    __host__ __device__ void init(int M, int N, int G_, int c_) { nM = M / BM; nN = N / BM; nwg = nM * nN; G = G_; c = c_; }
    __host__ __device__ bool next(int i, Unit& u) const {
        const long L = (long)i * G + c; if (L >= nwg) return false;
        int wgid = (int)L; { const int q = nwg / NXCD, r = nwg % NXCD, xcd = wgid % NXCD, off = wgid / NXCD; wgid = (xcd < r ? xcd * (q + 1) : r * (q + 1) + (xcd - r) * q) + off; }
        const int nig = WGM * nN, gid = wgid / nig, fm = gid * WGM, gsz = (nM - fm) < WGM ? (nM - fm) : WGM;
        u.pm = fm + ((wgid % nig) % gsz); u.pn = (wgid % nig) / gsz; return true;
    }
    __device__ __forceinline__ void a_ready(const Unit&) const {}
    __device__ __forceinline__ void done(const Unit&) const {}
};

__device__ __forceinline__ unsigned cvt_pk_bf16(float lo, float hi) { unsigned r; asm volatile("v_cvt_pk_bf16_f32 %0, %1, %2" : "=v"(r) : "v"(lo), "v"(hi)); return r; }
struct EpiF32 {
    static constexpr bool PERM = false, AFTER_DRAIN = false;
    float* C; int ldc;
    __device__ __forceinline__ void operator()(const f32x4 (&acc)[2][2][4][2], const Unit& u, int wr, int wc, int fr, int fq) const {
        const int row0 = u.pm * BM + wr * 64 + fr, col0 = u.pn * BM + wc * 32 + 4 * fq;
#pragma unroll
        for (int ai = 0; ai < 2; ++ai)
#pragma unroll
            for (int m = 0; m < 4; ++m) { float* rowp = C + (size_t)(row0 + ai * HALF + m * 16) * ldc + col0;
#pragma unroll
                for (int bj = 0; bj < 2; ++bj)
#pragma unroll
                    for (int n = 0; n < 2; ++n) *(f32x4*)(rowp + bj * HALF + n * 16) = acc[ai][bj][m][n]; }
    }
};
template <int ACT  > struct EpiBf16 {
    static constexpr bool PERM = true, AFTER_DRAIN = false;
    bf16_t* O; int ldc;
    __device__ __forceinline__ void operator()(const f32x4 (&acc)[2][2][4][2], const Unit& u, int wr, int wc, int fr, int fq) const {
        const int row0 = u.pm * BM + wr * 64 + fr; const int col0 = u.pn * BM + wc * 32 + 8 * fq;
#pragma unroll
        for (int ai = 0; ai < 2; ++ai)
#pragma unroll
            for (int m = 0; m < 4; ++m) { bf16_t* rowp = O + (size_t)(row0 + ai * HALF + m * 16) * ldc + col0;
#pragma unroll
                for (int bj = 0; bj < 2; ++bj) { f32x4 v0 = acc[ai][bj][m][0], v1 = acc[ai][bj][m][1];
                    if (ACT == 2) {
#pragma unroll
                        for (int e = 0; e < 4; ++e) { float a = v0[e] > 0.f ? v0[e] : 0.f; v0[e] = a * a; float b = v1[e] > 0.f ? v1[e] : 0.f; v1[e] = b * b; } }
                    u32x4 w; w.x = cvt_pk_bf16(v0[0], v0[1]); w.y = cvt_pk_bf16(v0[2], v0[3]); w.z = cvt_pk_bf16(v1[0], v1[1]); w.w = cvt_pk_bf16(v1[2], v1[3]);
                    *(u32x4*)(rowp + bj * HALF) = w; } }
    }
};

template <class Epi, class Sched, bool ALIGN_EPI = false, bool SP2 = false>
__device__ __forceinline__ void gemm_phase(PG8_LAS unsigned char* lds, const Gemm g, const Sched& S, const Epi& E, const int tid) {
    const int wid = __builtin_amdgcn_readfirstlane(tid >> 6), lane = tid & 63, wr = wid >> 2, wc = wid & 3, fr = lane & 15, fq = lane >> 4;
    const int K = g.K, nt = K / BK;
    unsigned voffA[2], voffB[2];
#pragma unroll
    for (int i = 0; i < 2; ++i) { int R, C; stage_rc(tid * 16 + i * 8192, R, C); const int Rb = Epi::PERM ? ((R & ~31) + perm32(R & 31)) : R;
        voffA[i] = (unsigned)(R * K + C) * 2u; voffB[i] = (unsigned)(Rb * K + C) * 2u; }
    const size_t kstep = (size_t)(BK * 2);
    const size_t hstep = (size_t)HALF * K * 2;
    const size_t tstep = 2 * hstep;
    const unsigned ldsw = (unsigned)wid * 1024u;
    const int aoff = lds_byte(wr * 64 + fr, fq * 8), boff = lds_byte(wc * 32 + fr, fq * 8);
#define PG8_SA(b, h) (((b) * 2 + (h)) * HTB)
#define PG8_SB(b, h) ((4 + (b) * 2 + (h)) * HTB)
#define PG8_STAGE(bufoff, gbase, voff) do { _Pragma("unroll") for (int _i = 0; _i < 2; ++_i) \
        __builtin_amdgcn_global_load_lds((const unsigned*)((const char*)(gbase) + (voff)[_i]), (PG8_LAS unsigned*)(lds + (bufoff) + ldsw + _i * 8192), 16, 0, 0); } while (0)
#define PG8_LDA(dst, b, h) do { _Pragma("unroll") for (int m = 0; m < 4; ++m) _Pragma("unroll") for (int k = 0; k < 2; ++k) dst[m][k] = *(const PG8_LAS bf16x8*)(lds + PG8_SA(b, h) + aoff + m * 2048 + k * 1024); } while (0)
#define PG8_LDB(dst, b, h) do { _Pragma("unroll") for (int n = 0; n < 2; ++n) _Pragma("unroll") for (int k = 0; k < 2; ++k) dst[n][k] = *(const PG8_LAS bf16x8*)(lds + PG8_SB(b, h) + boff + n * 2048 + k * 1024); } while (0)
#define PG8_MMA(ai, bj, At, Bt) do { __builtin_amdgcn_s_setprio(1); _Pragma("unroll") for (int m = 0; m < 4; ++m) _Pragma("unroll") for (int n = 0; n < 2; ++n) _Pragma("unroll") for (int k = 0; k < 2; ++k) \
        acc[ai][bj][m][n] = __builtin_amdgcn_mfma_f32_16x16x32_bf16(Bt[n][k], At[m][k], acc[ai][bj][m][n], 0, 0, 0); __builtin_amdgcn_s_setprio(0); } while (0)
#define PG8_WAIT_V(n) asm volatile("s_waitcnt vmcnt(" #n ")" ::: "memory")
#define PG8_WAIT_L(n) asm volatile("s_waitcnt lgkmcnt(" #n ")" ::: "memory")
#define PG8_BAR __builtin_amdgcn_s_barrier()
#define PG8_SCHED __builtin_amdgcn_sched_barrier(0)
    Unit cur, nxt; int ui = 0;
    if (!S.next(0, cur)) return;
    f32x4 acc[2][2][4][2];
#pragma unroll
    for (int a = 0; a < 2; ++a)
#pragma unroll
        for (int b = 0; b < 2; ++b)
#pragma unroll
            for (int m = 0; m < 4; ++m)
#pragma unroll
                for (int n = 0; n < 2; ++n) acc[a][b][m][n] = (f32x4){0.f, 0.f, 0.f, 0.f};
    bf16x8 At[4][2], B0[2][2], B1[2][2];
    const char* cA = (const char*)g.A + (size_t)cur.pm * tstep; const char* cB = (const char*)g.Bt + (size_t)cur.pn * tstep;
    S.a_ready(cur);
    if constexpr (SP2) {
        PG8_STAGE(PG8_SB(0, 0), cB, voffB); PG8_STAGE(PG8_SB(0, 1), cB + hstep, voffB); PG8_STAGE(PG8_SA(0, 0), cA, voffA); PG8_STAGE(PG8_SA(0, 1), cA + hstep, voffA);
        if (wr == 1) PG8_BAR;
        PG8_WAIT_V(2); PG8_BAR;
        PG8_STAGE(PG8_SB(1, 0), cB + kstep, voffB); PG8_STAGE(PG8_SA(1, 0), cA + kstep, voffA); PG8_STAGE(PG8_SB(1, 1), cB + hstep + kstep, voffB);
        PG8_WAIT_V(6); PG8_BAR;
    } else {
        PG8_STAGE(PG8_SB(0, 0), cB, voffB); PG8_STAGE(PG8_SA(0, 0), cA, voffA); PG8_STAGE(PG8_SB(0, 1), cB + hstep, voffB); PG8_STAGE(PG8_SA(0, 1), cA + hstep, voffA);
        if (wr == 1) PG8_BAR;
        PG8_WAIT_V(4); PG8_BAR;
        PG8_STAGE(PG8_SB(1, 0), cB + kstep, voffB); PG8_STAGE(PG8_SA(1, 0), cA + kstep, voffA); PG8_STAGE(PG8_SB(1, 1), cB + hstep + kstep, voffB);
        PG8_WAIT_V(6); PG8_BAR;
    }
    for (;;) {
        const bool has_next = S.next(ui + 1, nxt);
        const char* nA = has_next ? (const char*)g.A + (size_t)nxt.pm * tstep : cA; const char* nB = has_next ? (const char*)g.Bt + (size_t)nxt.pn * tstep : cB;
        for (int t = 0; t < nt; t += 2) {
            const bool last = (t == nt - 2);
            const char* a1 = cA + (size_t)(t + 1) * kstep;
            const char* a2 = last ? nA : cA + (size_t)(t + 2) * kstep; const char* b2 = last ? nB : cB + (size_t)(t + 2) * kstep;
            const char* a3 = a2 + kstep; const char* b3 = b2 + kstep;
            if (last && has_next) S.a_ready(nxt);
            if constexpr (SP2) {
            PG8_LDB(B0, 0, 0); PG8_LDB(B1, 0, 1); PG8_SCHED; PG8_LDA(At, 0, 0); PG8_STAGE(PG8_SA(1, 1), a1 + hstep, voffA);
            PG8_WAIT_V(8); PG8_WAIT_L(0); PG8_BAR; PG8_MMA(0, 0, At, B0); PG8_MMA(0, 1, At, B1); PG8_BAR; PG8_SCHED;
            PG8_LDA(At, 0, 1); PG8_STAGE(PG8_SB(0, 0), b2, voffB); PG8_STAGE(PG8_SB(0, 1), b2 + hstep, voffB); PG8_STAGE(PG8_SA(0, 0), a2, voffA);
            PG8_WAIT_V(8); PG8_WAIT_L(0); PG8_BAR; PG8_MMA(1, 0, At, B0); PG8_MMA(1, 1, At, B1); PG8_BAR; PG8_SCHED;
            PG8_LDB(B0, 1, 0); PG8_LDB(B1, 1, 1); PG8_SCHED; PG8_LDA(At, 1, 0); PG8_STAGE(PG8_SA(0, 1), a2 + hstep, voffA);
            PG8_WAIT_V(8); PG8_WAIT_L(0); PG8_BAR; PG8_MMA(0, 0, At, B0); PG8_MMA(0, 1, At, B1); PG8_BAR; PG8_SCHED;
            PG8_LDA(At, 1, 1); PG8_STAGE(PG8_SB(1, 0), b3, voffB); PG8_STAGE(PG8_SB(1, 1), b3 + hstep, voffB); PG8_STAGE(PG8_SA(1, 0), a3, voffA);
            PG8_WAIT_V(8); PG8_WAIT_L(0); PG8_BAR; PG8_MMA(1, 0, At, B0); PG8_MMA(1, 1, At, B1); PG8_BAR; PG8_SCHED;
            } else {
            PG8_LDB(B0, 0, 0); PG8_SCHED; PG8_LDA(At, 0, 0); PG8_STAGE(PG8_SA(1, 1), a1 + hstep, voffA);
            PG8_WAIT_L(8); PG8_BAR; PG8_WAIT_L(0); PG8_MMA(0, 0, At, B0); PG8_BAR; PG8_SCHED;
            PG8_LDB(B1, 0, 1); PG8_STAGE(PG8_SB(0, 0), b2, voffB);
            PG8_BAR; PG8_WAIT_L(0); PG8_MMA(0, 1, At, B1); PG8_BAR;
            PG8_LDA(At, 0, 1); PG8_STAGE(PG8_SA(0, 0), a2, voffA);
            PG8_BAR; PG8_WAIT_L(0); PG8_MMA(1, 0, At, B0); PG8_BAR; PG8_SCHED;
            PG8_STAGE(PG8_SB(0, 1), b2 + hstep, voffB);
            PG8_WAIT_V(6); PG8_BAR; PG8_MMA(1, 1, At, B1); PG8_BAR;
            PG8_LDB(B0, 1, 0); PG8_SCHED; PG8_LDA(At, 1, 0); PG8_STAGE(PG8_SA(0, 1), a2 + hstep, voffA);
            PG8_WAIT_L(8); PG8_BAR; PG8_WAIT_L(0); PG8_MMA(0, 0, At, B0); PG8_BAR; PG8_SCHED;
            PG8_LDB(B1, 1, 1); PG8_STAGE(PG8_SB(1, 0), b3, voffB);
            PG8_BAR; PG8_WAIT_L(0); PG8_MMA(0, 1, At, B1); PG8_BAR;
            PG8_LDA(At, 1, 1); PG8_STAGE(PG8_SA(1, 0), a3, voffA);
            PG8_BAR; PG8_WAIT_L(0); PG8_MMA(1, 0, At, B0); PG8_BAR; PG8_SCHED;
            PG8_STAGE(PG8_SB(1, 1), b3 + hstep, voffB);
            PG8_WAIT_V(6); PG8_BAR; PG8_MMA(1, 1, At, B1); PG8_BAR;
            }
        }
        if constexpr (ALIGN_EPI) { if (wr == 0) PG8_BAR; }
        if constexpr (!Epi::AFTER_DRAIN) { E(acc, cur, wr, wc, fr, fq); S.done(cur); }
        if (!has_next) break;
#pragma unroll
        for (int a = 0; a < 2; ++a)
#pragma unroll
            for (int b = 0; b < 2; ++b)
#pragma unroll
                for (int m = 0; m < 4; ++m)
#pragma unroll
                    for (int n = 0; n < 2; ++n) acc[a][b][m][n] = (f32x4){0.f, 0.f, 0.f, 0.f};
        cur = nxt; cA = nA; cB = nB; ++ui;
        if constexpr (ALIGN_EPI) { if (wr == 1) PG8_BAR; }
    }
    PG8_WAIT_V(0);
    if constexpr (!ALIGN_EPI) { if (wr == 0) PG8_BAR; }
    PG8_BAR;
    if constexpr (Epi::AFTER_DRAIN) { E.fused(acc, cur, wr, wc, fr, fq, lds, wid, lane); S.done(cur); }
#undef PG8_SA
#undef PG8_SB
#undef PG8_STAGE
#undef PG8_LDA
#undef PG8_LDB
#undef PG8_MMA
#undef PG8_WAIT_V
#undef PG8_WAIT_L
#undef PG8_BAR
#undef PG8_SCHED
}
}

#define GAS __attribute__((address_space(1)))
#define LAS __attribute__((address_space(3)))
typedef unsigned short bf16;
typedef unsigned v4u __attribute__((ext_vector_type(4)));
typedef unsigned v2u __attribute__((ext_vector_type(2)));
typedef float f32x4 __attribute__((ext_vector_type(4)));
typedef float f32x16 __attribute__((ext_vector_type(16)));
typedef short bf16x8 __attribute__((ext_vector_type(8)));
typedef GAS unsigned gu32;
#define RLX_AGENT __ATOMIC_RELAXED, __HIP_MEMORY_SCOPE_AGENT
#define LDS_WAIT() asm volatile("s_waitcnt lgkmcnt(0)" ::: "memory")
#define VM_WAIT() asm volatile("s_waitcnt vmcnt(0)" ::: "memory")

constexpr int NWAVES = 8, NTHR = 512;
constexpr int BATCH = 2, SEQ = 4096, T = BATCH * SEQ, D = 2048, C = 1024, NH = 16, HD = 64;
constexpr int AH = 8, AD = 128, MB = 256, NBLK = SEQ / MB;
constexpr int NSHIFT = 3328, NIN = 6400, NZ = 6656, FF = 8192;
constexpr int ZQ = 3328, ZK = 4352, ZV = 5376, ZVD = 6400;
constexpr int DEPTH = 2;
constexpr float NORM_EPS = 1e-6f, LNX_EPS = 64e-5f;

constexpr size_t MiB = 1u << 20;
constexpr size_t WS_CTL = 0, CTL_ZERO_BYTES = 1 * MiB;
constexpr size_t WS_WIN = 1 * MiB, WS_WOUT = 27 * MiB, WS_WUP = 35 * MiB, WS_WDN = 67 * MiB;
constexpr size_t WS_VF = 99 * MiB;
constexpr size_t WS_HN = 131 * MiB;
constexpr size_t WS_YC = 163 * MiB;
constexpr size_t WS_Z = 195 * MiB;
constexpr size_t WS_XL = 299 * MiB;
constexpr size_t WS_LW = 304 * MiB;
constexpr size_t WS_ROPE = 323 * MiB;
constexpr size_t WS_SV = 325 * MiB;
constexpr size_t WS_SG = 341 * MiB;
constexpr size_t WS_AQ = 357 * MiB, WS_AK = 373 * MiB, WS_AVT = 389 * MiB;
constexpr size_t WS_KM = 405 * MiB;
constexpr size_t WS_CHUNK = 406 * MiB;
constexpr size_t WS_U = 195 * MiB;
constexpr size_t WS_Y2 = 195 * MiB;
constexpr size_t WS_M = 131 * MiB;
constexpr size_t WS_END = 502 * MiB;
constexpr int CW_BAR = 4096;

constexpr int RING_BYTES = 147456;
constexpr int LDSCTL_OFF = RING_BYTES, MISC_OFF = LDSCTL_OFF + 320;
constexpr int LDS_BYTES = RING_BYTES + 1024;
constexpr int PTAB_OFF = MISC_OFF + 128;

__device__ __forceinline__ unsigned f2bf(float f) { unsigned u = __builtin_bit_cast(unsigned, f); return (u + 0x7fffu + ((u >> 16) & 1u)) >> 16; }
__device__ __forceinline__ unsigned pk2(float lo, float hi) { return f2bf(lo) | (f2bf(hi) << 16); }
__device__ __forceinline__ float bf2f(unsigned short b) { return __builtin_bit_cast(float, (unsigned)b << 16); }
__device__ __forceinline__ float bflo(unsigned w) { return __builtin_bit_cast(float, w << 16); }
__device__ __forceinline__ float bfhi(unsigned w) { return __builtin_bit_cast(float, w & 0xffff0000u); }

#define XB_TMO      128
#define XB_XCNT(j)  (256  + 64 * (j))
#define XB_XSUB(j)  (1280 + 64 * (j))
#define XB_XGEN(j)  (2304 + 64 * (j))
#define XB_TOP      3328
#define XB_TOPGEN   3392
#define XCD_BAR_WORDS 3456
#define XB_SPIN_CAP (1u << 20)
__device__ __forceinline__ unsigned xb_ld(unsigned* p)              { return __hip_atomic_load(p, __ATOMIC_RELAXED, __HIP_MEMORY_SCOPE_AGENT); }
__device__ __forceinline__ unsigned xb_add(unsigned* p, unsigned v) { return __hip_atomic_fetch_add(p, v, __ATOMIC_RELAXED, __HIP_MEMORY_SCOPE_AGENT); }
__device__ __forceinline__ unsigned xb_xcc_id() { return (unsigned)__builtin_amdgcn_s_getreg((3 << 11) | 20) & 0xFu; }
#define XB_SPIN(cond, bar) do { unsigned _sp = 0; while (cond) { __builtin_amdgcn_s_sleep(1); \
    if ((++_sp & 255u) == 0u) { if (xb_ld(&(bar)[XB_TMO])) break; if (_sp > XB_SPIN_CAP) { atomicAdd(&(bar)[XB_TMO], 1u); break; } } } } while (0)
struct XcdBarrier { unsigned* bar; unsigned x; volatile LAS unsigned* st; };
__device__ __forceinline__ XcdBarrier xcd_barrier_post(unsigned* bar, volatile LAS unsigned* st) {
    XcdBarrier b; b.bar = bar; b.x = xb_xcc_id(); b.st = st;
    if (threadIdx.x == 0) (void)xb_add(&bar[XB_XCNT(b.x)], 1u);
    return b;
}
__device__ __forceinline__ void xcd_barrier_complete(unsigned* bar, unsigned x, unsigned& nloc, unsigned& nx) {
    const unsigned G = gridDim.x * gridDim.y * gridDim.z;
    unsigned sum, cnt, mine, sp = 0u;
    for (;;) {
        sum = 0u; cnt = 0u; mine = 0u;
#pragma unroll
        for (unsigned j = 0; j < 16; ++j) { const unsigned c = xb_ld(&bar[XB_XCNT(j)]); sum += c; cnt += (c > 0u) ? 1u : 0u; mine = (j == x) ? c : mine; }
        if (sum == G) break;
        __builtin_amdgcn_s_sleep(1);
        if ((++sp & 255u) == 0u) { if (xb_ld(&bar[XB_TMO])) break; if (sp > XB_SPIN_CAP) { atomicAdd(&bar[XB_TMO], 1u); break; } }
    }
    nloc = mine > 0u ? mine : 1u; nx = cnt > 0u ? cnt : 1u;
}
__device__ __forceinline__ void xcd_barrier(const XcdBarrier& b) {
    asm volatile("s_waitcnt vmcnt(0)" ::: "memory");
    __syncthreads();
    if (threadIdx.x == 0) {
        unsigned* bar = b.bar;
        __builtin_amdgcn_s_waitcnt(0);
        unsigned nloc = b.st[0], nx = b.st[1];
        if (nloc == 0u) { xcd_barrier_complete(bar, b.x, nloc, nx); b.st[0] = nloc; b.st[1] = nx; }
        const unsigned old = xb_add(&bar[XB_XSUB(b.x)], 1u);
        const unsigned gen = old / nloc;
        if (old + 1u == (gen + 1u) * nloc) {
            __builtin_amdgcn_fence(__ATOMIC_RELEASE, "agent");
            asm volatile("s_waitcnt vmcnt(0)" ::: "memory");
            const unsigned og = xb_add(&bar[XB_TOP], 1u);
            const unsigned tg = og / nx;
            if (og + 1u == (tg + 1u) * nx) xb_add(&bar[XB_TOPGEN], 1u);
            else XB_SPIN(xb_ld(&bar[XB_TOPGEN]) == tg, bar);
            __builtin_amdgcn_fence(__ATOMIC_ACQUIRE, "agent");
            xb_add(&bar[XB_XGEN(b.x)], 1u);
            asm volatile("s_waitcnt vmcnt(0)" ::: "memory");
        } else {
            XB_SPIN(xb_ld(&bar[XB_XGEN(b.x)]) == gen, bar);
            __builtin_amdgcn_fence(__ATOMIC_ACQUIRE, "agent");
            asm volatile("s_waitcnt vmcnt(0)" ::: "memory");
        }
    }
    __syncthreads();
}

struct Frame {
    LAS unsigned char* lds;
    volatile LAS unsigned* MISC;
    gu32* ctl;
    int tid, lane, wave, vcu, G, bx;
    float* out;
    unsigned char* ws;
};
enum { I_X = 0, I_NMIXPRE, I_NMIXPOST, I_NMLPPRE, I_NMLPPOST, I_WIN, I_WINV, I_MU, I_MUV, I_W0, I_W2, I_A0, I_A2, I_V0, I_V2, I_G2, I_KK, I_KA, I_RK, I_LNG, I_LNB, I_WOUT, I_WUP, I_WDN };

__device__ __forceinline__ const float* inp_(const Frame& F, int i) {
    const unsigned long long v = *(const LAS unsigned long long*)(F.lds + PTAB_OFF + 8 * i);
    const unsigned lo = __builtin_amdgcn_readfirstlane((unsigned)v), hi = __builtin_amdgcn_readfirstlane((unsigned)(v >> 32));
    return (const float*)(((unsigned long long)hi << 32) | lo);
}
#define INP(i) inp_(F, (i))
#define DPP_ADD(v, ctrl) ((v) + __builtin_bit_cast(float, __builtin_amdgcn_update_dpp(0, __builtin_bit_cast(int, (v)), (ctrl), 0xF, 0xF, true)))
__device__ __forceinline__ float wave_sum(float v) {
    v = DPP_ADD(v, 0xB1);
    v = DPP_ADD(v, 0x4E);
    v = DPP_ADD(v, 0x141);
    v = DPP_ADD(v, 0x140);
    v += __shfl_xor(v, 16); v += __shfl_xor(v, 32);
    return v;
}
__device__ __forceinline__ void transpose_item(const float* W, int K, int N, bf16* WT, int row_off, LAS float* scr, int item, int lane) {
    const int nblk = N / 32, kb = item / nblk, nb = item % nblk, k0 = 64 * kb, n0 = 32 * nb;
#pragma unroll 8
    for (int i = 0; i < 32; ++i) { const int kk = 2 * i + (lane >> 5); scr[kk * 33 + (lane & 31)] = W[(size_t)(k0 + kk) * N + n0 + (lane & 31)]; }
    LDS_WAIT(); asm volatile("" ::: "memory");
    const int c = lane & 7;
#pragma unroll
    for (int j = 0; j < 4; ++j) { const int n = (lane >> 3) + 8 * j; const LAS float* s = scr + (8 * c) * 33 + n;
        v4u o; o.x = pk2(s[0 * 33], s[1 * 33]); o.y = pk2(s[2 * 33], s[3 * 33]); o.z = pk2(s[4 * 33], s[5 * 33]); o.w = pk2(s[6 * 33], s[7 * 33]);
        *(GAS v4u*)(WT + (size_t)(row_off + n0 + n) * K + k0 + 8 * c) = o; }
    LDS_WAIT(); asm volatile("" ::: "memory");
}
__device__ __forceinline__ void rmsnorm_row_to_bf16(const float* xrow, const float* gain, bf16* orow, int lane) {
    const GAS f32x4* xr = (const GAS f32x4*)xrow + lane; const GAS f32x4* gr = (const GAS f32x4*)gain + lane;
    f32x4 v[8]; float s = 0.f;
#pragma unroll
    for (int j = 0; j < 8; ++j) { v[j] = xr[64 * j]; s += (v[j].x * v[j].x + v[j].y * v[j].y) + (v[j].z * v[j].z + v[j].w * v[j].w); }
    const float rs = 1.0f / sqrtf(wave_sum(s) * (1.f / D) + NORM_EPS);
    GAS v2u* o8 = (GAS v2u*)orow + lane;
#pragma unroll
    for (int j = 0; j < 8; ++j) { const f32x4 g = gr[64 * j]; v2u w; w.x = pk2(v[j].x * rs * g.x, v[j].y * rs * g.y); w.y = pk2(v[j].z * rs * g.z, v[j].w * rs * g.w); o8[64 * j] = w; }
}
__device__ __forceinline__ void ph_convert(Frame& F, int L) {
    LAS float* scr = (LAS float*)(F.lds + F.wave * 16384);
    const int gw = F.vcu * NWAVES + F.wave, NGW = F.G * NWAVES;
    bf16* WinT = (bf16*)(F.ws + WS_WIN); bf16* WoutT = (bf16*)(F.ws + WS_WOUT); bf16* WupT = (bf16*)(F.ws + WS_WUP); bf16* WdnT = (bf16*)(F.ws + WS_WDN);
    constexpr int I_IN = (D / 64) * (NIN / 32), I_VR = (D / 64), I_OUT = (D / 64) * (D / 32), I_UP = (D / 64) * (FF / 32), I_DN = (FF / 64) * (D / 32);
    const int nvr = (L > 0) ? I_VR : 0;
    const int NITEMS = I_IN + nvr + I_OUT + I_UP + I_DN;
    for (int it = gw; it < NITEMS; it += NGW) {
        int r = it;
        if (r < I_IN) { transpose_item(INP(I_WIN) + (size_t)L * D * NIN, D, NIN, WinT, 0, scr, r, F.lane); continue; } r -= I_IN;
        if (r < nvr) { transpose_item(INP(I_WINV) + (size_t)(L - 1) * D * 32, D, 32, WinT, NIN, scr, r, F.lane); continue; } r -= nvr;
        if (r < I_OUT) { transpose_item(INP(I_WOUT) + (size_t)L * D * D, D, D, WoutT, 0, scr, r, F.lane); continue; } r -= I_OUT;
        if (r < I_UP) { transpose_item(INP(I_WUP) + (size_t)L * D * FF, D, FF, WupT, 0, scr, r, F.lane); continue; } r -= I_UP;
        transpose_item(INP(I_WDN) + (size_t)L * FF * D, FF, D, WdnT, 0, scr, r, F.lane);
    }
    if (L > 0) {
        const int gt = F.vcu * NTHR + F.tid, NGT = F.G * NTHR;
        for (int i = gt; i < (NZ - NIN - 32) * (D / 8); i += NGT) *(GAS v4u*)(WinT + (size_t)(NIN + 32) * D + (size_t)i * 8) = (v4u){0u, 0u, 0u, 0u};
    }
    {
        bf16* W2T = (bf16*)(F.ws + WS_LW); bf16* A2T = W2T + C * 64; bf16* G2T = A2T + C * 64; bf16* V2T = G2T + C * 128;
        for (int it = gw; it < 32 + 32 + 64; it += NGW) {
            if (it < 32) transpose_item(INP(I_W2) + (size_t)L * 64 * C, 64, C, W2T, 0, scr, it, F.lane);
            else if (it < 64) transpose_item(INP(I_A2) + (size_t)L * 64 * C, 64, C, A2T, 0, scr, it - 32, F.lane);
            else transpose_item(INP(I_G2) + (size_t)L * 128 * C, 128, C, G2T, 0, scr, it - 64, F.lane);
        }
        const int gt = F.vcu * NTHR + F.tid, NGT = F.G * NTHR;
        if (L > 0) { const float* v2 = INP(I_V2) + (size_t)(L - 1) * 32 * C; for (int i = gt; i < 32 * C; i += NGT) { const int cch = i >> 5, k = i & 31; V2T[i] = (bf16)f2bf(v2[(size_t)k * C + cch]); } }
        if (L == 0) { float* RC = (float*)(F.ws + WS_ROPE); float* RS = RC + SEQ * 64;
            for (int i = gt; i < SEQ * 64; i += NGT) { const int pos = i >> 6, d = i & 63; const float inv_freq = exp2f(-(float)d * (13.287712379549449f / 64.0f)); float sn, cs; sincosf((float)pos * inv_freq, &sn, &cs); RC[i] = cs; RS[i] = sn; } }
    }
    if (L == 0) {
        bf16* HN = (bf16*)(F.ws + WS_HN);
        for (int m = gw; m < T; m += NGW) rmsnorm_row_to_bf16(INP(I_X) + (size_t)m * D, INP(I_NMIXPRE), HN + (size_t)m * D, F.lane);
    }
}
__device__ __forceinline__ void ph_resnorm(Frame& F, const float* y, const float* xin, const float* gA, const float* gB, float* xout, bf16* hn) {
    const int gw = F.vcu * NWAVES + F.wave, NGW = F.G * NWAVES;
    for (int m = gw; m < T; m += NGW) {
        const GAS f32x4* yr = (const GAS f32x4*)(y + (size_t)m * D) + F.lane; const GAS f32x4* xr = (const GAS f32x4*)(xin + (size_t)m * D) + F.lane;
        const GAS f32x4* ga = (const GAS f32x4*)gA + F.lane;
        f32x4 v[8]; float s = 0.f;
#pragma unroll
        for (int j = 0; j < 8; ++j) { v[j] = yr[64 * j]; s += (v[j].x * v[j].x + v[j].y * v[j].y) + (v[j].z * v[j].z + v[j].w * v[j].w); }
        const float rs = 1.0f / sqrtf(wave_sum(s) * (1.f / D) + NORM_EPS);
        float s2 = 0.f;
        GAS f32x4* xo = (GAS f32x4*)(xout + (size_t)m * D) + F.lane;
#pragma unroll
        for (int j = 0; j < 8; ++j) { const f32x4 g = ga[64 * j]; const f32x4 x = xr[64 * j];
            v[j].x = x.x + v[j].x * rs * g.x; v[j].y = x.y + v[j].y * rs * g.y; v[j].z = x.z + v[j].z * rs * g.z; v[j].w = x.w + v[j].w * rs * g.w;
            xo[64 * j] = v[j]; s2 += (v[j].x * v[j].x + v[j].y * v[j].y) + (v[j].z * v[j].z + v[j].w * v[j].w); }
        if (gB) {
            const float rs2 = 1.0f / sqrtf(wave_sum(s2) * (1.f / D) + NORM_EPS);
            const GAS f32x4* gb = (const GAS f32x4*)gB + F.lane; GAS v2u* o8 = (GAS v2u*)(hn + (size_t)m * D) + F.lane;
#pragma unroll
            for (int j = 0; j < 8; ++j) { const f32x4 g = gb[64 * j]; v2u w; w.x = pk2(v[j].x * rs2 * g.x, v[j].y * rs2 * g.y); w.y = pk2(v[j].z * rs2 * g.z, v[j].w * rs2 * g.w); o8[64 * j] = w; }
        }
    }
}
__device__ __forceinline__ float sigmoidf_(float x) { return 1.0f / (1.0f + __expf(-x)); }
__device__ __forceinline__ float softplusf_(float x) { return fmaxf(x, 0.f) + log1pf(__expf(-fabsf(x))); }

__device__ __forceinline__ void prep_xl_items(Frame& F, int L) {
    const bf16* Z = (const bf16*)(F.ws + WS_Z); bf16* XL = (bf16*)(F.ws + WS_XL);
    const float* mu = INP(I_MU) + (size_t)L * NSHIFT; const float* muv = INP(I_MUV) + (size_t)(L > 0 ? L - 1 : 0) * 32;
    const int gt = F.vcu * NTHR + F.tid, NGT = F.G * NTHR;
    for (int it = gt; it < T * 36; it += NGT) {
        const int t = it / 36, j8 = it - t * 36, s = t & (SEQ - 1);
        v4u o = (v4u){0u, 0u, 0u, 0u};
        if (j8 < 32 || L > 0) {
            const int col = (j8 < 32) ? (3072 + 8 * j8) : (ZVD + 8 * (j8 - 32));
            const float* mup = (j8 < 32) ? (mu + col) : (muv + 8 * (j8 - 32));
            const v4u zc = *(const GAS v4u*)(Z + (size_t)t * NZ + col);
            v4u zp = (v4u){0u, 0u, 0u, 0u}; if (s) zp = *(const GAS v4u*)(Z + (size_t)(t - 1) * NZ + col);
            const f32x4 m0 = *(const GAS f32x4*)mup, m1 = *(const GAS f32x4*)(mup + 4);
            float f[8];
#pragma unroll
            for (int q = 0; q < 4; ++q) { const float c0 = bflo(zc[q]), c1 = bfhi(zc[q]), p0 = bflo(zp[q]), p1 = bfhi(zp[q]);
                const float ma = (q < 2) ? m0[2 * q] : m1[2 * q - 4], mb = (q < 2) ? m0[2 * q + 1] : m1[2 * q - 3];
                f[2 * q] = c0 + (p0 - c0) * ma; f[2 * q + 1] = c1 + (p1 - c1) * mb; }
            if (j8 < 8) {
#pragma unroll
                for (int q = 0; q < 8; ++q) f[q] = tanhf(f[q]);
            } else if (j8 >= 16 && j8 < 32) {
#pragma unroll
                for (int q = 0; q < 8; ++q) f[q] = sigmoidf_(f[q]);
            }
            o = (v4u){pk2(f[0], f[1]), pk2(f[2], f[3]), pk2(f[4], f[5]), pk2(f[6], f[7])};
        }
        *(GAS v4u*)(XL + (size_t)t * 288 + 8 * j8) = o;
    }
}
constexpr float QSC = 0.08838834764831845f * 1.4426950408889634f;
__device__ __forceinline__ void prep_attn_unit(Frame& F, int u) {
    const bf16* Z = (const bf16*)(F.ws + WS_Z);
    bf16* AQ = (bf16*)(F.ws + WS_AQ); bf16* AKp = (bf16*)(F.ws + WS_AK); float* KM = (float*)(F.ws + WS_KM);
    const float* RC = (const float*)(F.ws + WS_ROPE); const float* RS = RC + SEQ * 64;
    const int b = u / (NBLK * AH), rem = u % (NBLK * AH), blk = rem / AH, h = rem % AH;
    const int tid = F.tid, d = 8 * (tid & 7), tg = tid >> 3;
    const int tb = b * SEQ + blk * MB;
    LAS float* red = (LAS float*)F.lds;
    __syncthreads();
    float ks[16];
#pragma unroll
    for (int q = 0; q < 16; ++q) ks[q] = 0.f;
#pragma unroll
    for (int i = 0; i < 4; ++i) {
        const int tok = tg + 64 * i; const int pos = blk * MB + tok; const size_t t = (size_t)(tb + tok);
        const f32x4 c0 = *(const GAS f32x4*)(RC + pos * 64 + d), c1 = *(const GAS f32x4*)(RC + pos * 64 + d + 4);
        const f32x4 s0 = *(const GAS f32x4*)(RS + pos * 64 + d), s1 = *(const GAS f32x4*)(RS + pos * 64 + d + 4);
        const v4u ql = *(const GAS v4u*)(Z + t * NZ + ZQ + h * AD + d), qh = *(const GAS v4u*)(Z + t * NZ + ZQ + h * AD + 64 + d);
        const v4u kl = *(const GAS v4u*)(Z + t * NZ + ZK + h * AD + d), kh = *(const GAS v4u*)(Z + t * NZ + ZK + h * AD + 64 + d);
        float qlo[8], qhi[8], klo[8], khi[8];
#pragma unroll
        for (int q = 0; q < 4; ++q) { qlo[2 * q] = bflo(ql[q]); qlo[2 * q + 1] = bfhi(ql[q]); qhi[2 * q] = bflo(qh[q]); qhi[2 * q + 1] = bfhi(qh[q]);
            klo[2 * q] = bflo(kl[q]); klo[2 * q + 1] = bfhi(kl[q]); khi[2 * q] = bflo(kh[q]); khi[2 * q + 1] = bfhi(kh[q]); }
        float oq1[8], oq2[8], ok1[8], ok2[8];
#pragma unroll
        for (int q = 0; q < 8; ++q) { const float cs = (q < 4) ? c0[q] : c1[q - 4], sn = (q < 4) ? s0[q] : s1[q - 4];
            oq1[q] = (qlo[q] * cs - qhi[q] * sn) * QSC; oq2[q] = (qhi[q] * cs + qlo[q] * sn) * QSC; ok1[q] = klo[q] * cs - khi[q] * sn; ok2[q] = khi[q] * cs + klo[q] * sn;
            ks[q] += ok1[q]; ks[8 + q] += ok2[q]; }
        *(GAS v4u*)(AQ + t * C + h * AD + d) = (v4u){pk2(oq1[0], oq1[1]), pk2(oq1[2], oq1[3]), pk2(oq1[4], oq1[5]), pk2(oq1[6], oq1[7])};
        *(GAS v4u*)(AQ + t * C + h * AD + 64 + d) = (v4u){pk2(oq2[0], oq2[1]), pk2(oq2[2], oq2[3]), pk2(oq2[4], oq2[5]), pk2(oq2[6], oq2[7])};
        *(GAS v4u*)(AKp + t * C + h * AD + d) = (v4u){pk2(ok1[0], ok1[1]), pk2(ok1[2], ok1[3]), pk2(ok1[4], ok1[5]), pk2(ok1[6], ok1[7])};
        *(GAS v4u*)(AKp + t * C + h * AD + 64 + d) = (v4u){pk2(ok2[0], ok2[1]), pk2(ok2[2], ok2[3]), pk2(ok2[4], ok2[5]), pk2(ok2[6], ok2[7])};
    }
    *(LAS f32x4*)(red + tg * 128 + d) = (f32x4){ks[0], ks[1], ks[2], ks[3]}; *(LAS f32x4*)(red + tg * 128 + d + 4) = (f32x4){ks[4], ks[5], ks[6], ks[7]};
    *(LAS f32x4*)(red + tg * 128 + 64 + d) = (f32x4){ks[8], ks[9], ks[10], ks[11]}; *(LAS f32x4*)(red + tg * 128 + 64 + d + 4) = (f32x4){ks[12], ks[13], ks[14], ks[15]};
    __syncthreads();
    if (tid < 128) { float s = 0.f;
#pragma unroll 8
        for (int w = 0; w < 64; ++w) s += red[w * 128 + tid];
        KM[((size_t)(b * AH + h) * NBLK + blk) * AD + tid] = s * (1.0f / MB); }
}
__device__ __forceinline__ void ph_prep(Frame& F, int L) {
    prep_xl_items(F, L);
    for (int u = F.vcu; u < BATCH * NBLK * AH; u += F.G) prep_attn_unit(F, u);
}

typedef short bf16x4 __attribute__((ext_vector_type(4)));
constexpr int NCHK = SEQ / 64;
constexpr int NUNIT = BATCH * NH * NCHK;
constexpr int CP = 144, MATB = 64 * CP;
constexpr int L_ARA = 0, L_ARR = MATB, L_BKB = 2 * MATB, L_BKK = 3 * MATB, L_AT = 4 * MATB, L_BT = 5 * MATB, L_KT = 6 * MATB, L_VT = 7 * MATB;
constexpr int L_AAB = 8 * MATB, L_AAK = 9 * MATB, L_ARB = 10 * MATB, L_ARK = 11 * MATB, L_ND = 12 * MATB, L_TB = L_ND + 4096;
constexpr int XLP = 592;
constexpr int L_XL = 8 * MATB, L_LW = L_XL + 64 * XLP, L_LA = L_LW + 16384, L_LV = L_LA + 8192, L_SEG = L_LV + 8192, L_GL = L_SEG + 2048;
static_assert(L_TB + 2048 <= L_SEG && L_GL + 256 <= RING_BYTES, "wkv LDS map");
constexpr int L_W2T = L_ARA, L_PT = L_BKB, L_QT = L_BKK;
constexpr size_t WS_CM = WS_CHUNK, WS_CG = WS_CM + (size_t)NUNIT * 8192, WS_CRY = WS_CG + (size_t)NUNIT * 16384, WS_CYC = WS_CRY + (size_t)NUNIT * 8192;
static_assert(WS_CYC + (size_t)NUNIT * 16384 <= WS_END, "chunk outputs");
constexpr size_t WS_CS = WS_HN;
constexpr size_t WS_BON = WS_HN + (size_t)NUNIT * 8192;
static_assert(WS_BON + (size_t)T * NH * 4 <= WS_YC, "HN region");

__device__ __forceinline__ f32x4 mfma32(bf16x8 a, bf16x8 b, f32x4 c) { return __builtin_amdgcn_mfma_f32_16x16x32_bf16(a, b, c, 0, 0, 0); }
__device__ __forceinline__ f32x4 mfma16(bf16x4 a, bf16x4 b, f32x4 c) { return __builtin_amdgcn_mfma_f32_16x16x16bf16_1k(a, b, c, 0, 0, 0); }
__device__ __forceinline__ v2u pk4(f32x4 v) { v2u w; w.x = pk2(v[0], v[1]); w.y = pk2(v[2], v[3]); return w; }

__device__ __forceinline__ void wkv_r1_unit(Frame& F, int L, int unit) {
    const int c = unit % NCHK, bh = unit / NCHK, h = bh % NH, b = bh / NH;
    const int tid = F.tid, lane = F.lane, w = F.wave, fr = lane & 15, g = lane >> 4;
    LAS unsigned char* lds = F.lds;
    const bf16* Z = (const bf16*)(F.ws + WS_Z);
    const size_t tok0 = (size_t)b * SEQ + (size_t)c * 64;
    __syncthreads();
    { const bf16* XLg = (const bf16*)(F.ws + WS_XL) + tok0 * 288;
      for (int idx = tid; idx < 64 * 36; idx += NTHR) { const int row = idx / 36, ch = idx - row * 36;
          *(LAS v4u*)(lds + L_XL + row * XLP + ch * 16) = *(const GAS v4u*)(XLg + row * 288 + ch * 8); } }
    __syncthreads();
    {
        const int nt = w & 3, mt0 = 2 * (w >> 2), cl = 16 * nt + fr, ch = h * HD + cl;
        const bf16* W2T = (const bf16*)(F.ws + WS_LW); const bf16* A2T = W2T + C * 64; const bf16* G2T = A2T + C * 64; const bf16* V2T = G2T + C * 128;
        bf16* SG = (bf16*)(F.ws + WS_SG);
        const float w0c = INP(I_W0)[(size_t)L * C + ch], a0c = INP(I_A0)[(size_t)L * C + ch];
        const LAS unsigned char* xa0 = lds + L_XL + (16 * mt0 + fr) * XLP + g * 16; const LAS unsigned char* xa1 = xa0 + 16 * XLP;
        {
            const bf16x8 b0 = *(const GAS bf16x8*)(W2T + (size_t)ch * 64 + 8 * g), b1 = *(const GAS bf16x8*)(W2T + (size_t)ch * 64 + 32 + 8 * g);
            f32x4 c0 = (f32x4){0.f, 0.f, 0.f, 0.f}, c1 = c0;
            c0 = mfma32(*(const LAS bf16x8*)(xa0), b0, c0); c0 = mfma32(*(const LAS bf16x8*)(xa0 + 64), b1, c0);
            c1 = mfma32(*(const LAS bf16x8*)(xa1), b0, c1); c1 = mfma32(*(const LAS bf16x8*)(xa1 + 64), b1, c1);
#pragma unroll
            for (int i = 0; i < 4; ++i) { const float wl0 = -softplusf_(-(c0[i] + w0c)) - 0.5f, wl1 = -softplusf_(-(c1[i] + w0c)) - 0.5f;
                ((LAS float*)(lds + L_LW))[(16 * mt0 + 4 * g + i) * 64 + cl] = -__expf(wl0); ((LAS float*)(lds + L_LW))[(16 * mt0 + 16 + 4 * g + i) * 64 + cl] = -__expf(wl1); }
        }
        {
            const bf16x8 b0 = *(const GAS bf16x8*)(A2T + (size_t)ch * 64 + 8 * g), b1 = *(const GAS bf16x8*)(A2T + (size_t)ch * 64 + 32 + 8 * g);
            f32x4 c0 = (f32x4){0.f, 0.f, 0.f, 0.f}, c1 = c0;
            c0 = mfma32(*(const LAS bf16x8*)(xa0 + 128), b0, c0); c0 = mfma32(*(const LAS bf16x8*)(xa0 + 192), b1, c0);
            c1 = mfma32(*(const LAS bf16x8*)(xa1 + 128), b0, c1); c1 = mfma32(*(const LAS bf16x8*)(xa1 + 192), b1, c1);
#pragma unroll
            for (int i = 0; i < 4; ++i) { ((LAS unsigned short*)(lds + L_LA))[(16 * mt0 + 4 * g + i) * 64 + cl] = (unsigned short)f2bf(sigmoidf_(c0[i] + a0c));
                ((LAS unsigned short*)(lds + L_LA))[(16 * mt0 + 16 + 4 * g + i) * 64 + cl] = (unsigned short)f2bf(sigmoidf_(c1[i] + a0c)); }
        }
        {
            f32x4 c0 = (f32x4){0.f, 0.f, 0.f, 0.f}, c1 = c0;
#pragma unroll
            for (int ks = 0; ks < 4; ++ks) { const bf16x8 bb = *(const GAS bf16x8*)(G2T + (size_t)ch * 128 + 32 * ks + 8 * g);
                c0 = mfma32(*(const LAS bf16x8*)(xa0 + 256 + 64 * ks), bb, c0); c1 = mfma32(*(const LAS bf16x8*)(xa1 + 256 + 64 * ks), bb, c1); }
#pragma unroll
            for (int i = 0; i < 4; ++i) { SG[(tok0 + 16 * mt0 + 4 * g + i) * C + ch] = (bf16)f2bf(c0[i]); SG[(tok0 + 16 * mt0 + 16 + 4 * g + i) * C + ch] = (bf16)f2bf(c1[i]); }
        }
        if (L > 0) {
            const float v0c = INP(I_V0)[(size_t)(L - 1) * C + ch];
            const bf16x8 b0 = *(const GAS bf16x8*)(V2T + (size_t)ch * 32 + 8 * g);
            f32x4 c0 = (f32x4){0.f, 0.f, 0.f, 0.f}, c1 = c0;
            c0 = mfma32(*(const LAS bf16x8*)(xa0 + 512), b0, c0); c1 = mfma32(*(const LAS bf16x8*)(xa1 + 512), b0, c1);
#pragma unroll
            for (int i = 0; i < 4; ++i) { ((LAS unsigned short*)(lds + L_LV))[(16 * mt0 + 4 * g + i) * 64 + cl] = (unsigned short)f2bf(sigmoidf_(c0[i] + v0c));
                ((LAS unsigned short*)(lds + L_LV))[(16 * mt0 + 16 + 4 * g + i) * 64 + cl] = (unsigned short)f2bf(sigmoidf_(c1[i] + v0c)); }
        }
    }
    __syncthreads();
    {
        const int sg = w, j = lane, ch = h * HD + j;
        const float* mu = INP(I_MU) + (size_t)L * NSHIFT;
        const float mur = mu[ch], muk = mu[C + ch], muv = mu[2 * C + ch];
        const float kkc = INP(I_KK)[(size_t)L * C + ch], kac = INP(I_KA)[(size_t)L * C + ch], rkj = INP(I_RK)[(size_t)L * C + ch];
        float* VF = (float*)(F.ws + WS_VF); bf16* SVg = (bf16*)(F.ws + WS_SV);
        const size_t tokA = tok0 + 8 * sg;
        float zpr = 0.f, zpk = 0.f, zpv = 0.f;
        if (c != 0 || sg != 0) { const bf16* zp = Z + (tokA - 1) * NZ; zpr = bf2f(zp[ch]); zpk = bf2f(zp[C + ch]); zpv = bf2f(zp[2 * C + ch]); }
        float lw[8], cum[8], rf[8], kf[8], kkf[8], af[8]; unsigned vb[8];
#pragma unroll
        for (int e = 0; e < 8; ++e) {
            const bf16* zc = Z + (tokA + e) * NZ; const int t = 8 * sg + e;
            const float zr = bf2f(zc[ch]), zk = bf2f(zc[C + ch]), zv = bf2f(zc[2 * C + ch]);
            const float r = zr + (zpr - zr) * mur, k = zk + (zpk - zk) * muk; float v = zv + (zpv - zv) * muv;
            zpr = zr; zpk = zk; zpv = zv;
            lw[e] = ((const LAS float*)(lds + L_LW))[t * 64 + j];
            const float a = bf2f(((const LAS unsigned short*)(lds + L_LA))[t * 64 + j]);
            const size_t o = (tokA + e) * C + ch;
            if (L == 0) VF[o] = v; else { const float sv = bf2f(((const LAS unsigned short*)(lds + L_LV))[t * 64 + j]); v = v + (VF[o] - v) * sv; }
            vb[e] = f2bf(v); SVg[o] = (bf16)vb[e];
            float kk = k * kkc; const float ss = wave_sum(kk * kk); kk = kk / fmaxf(sqrtf(ss), 1e-12f);
            rf[e] = r; kf[e] = k * (1.f + (a - 1.f) * kac); kkf[e] = kk; af[e] = a;
        }
        float run = 0.f;
#pragma unroll
        for (int e = 0; e < 8; ++e) { run += lw[e]; cum[e] = run; }
        LAS float* seg = (LAS float*)(lds + L_SEG);
        seg[sg * 64 + j] = run;
        __syncthreads();
        float off = 0.f, tot = 0.f;
#pragma unroll
        for (int s2 = 0; s2 < 8; ++s2) { const float v = seg[s2 * 64 + j]; tot += v; off += (s2 < sg) ? v : 0.f; }
        if (sg == 0) ((LAS float*)(lds + L_GL))[j] = __expf(tot);
        unsigned at8[4], bt8[4], kt8[4], vt8[4];
        float* BON = (float*)(F.ws + WS_BON);
#pragma unroll
        for (int e = 0; e < 8; ++e) {
            const float cu = cum[e] + off, ce = cu - lw[e];
            const float eC = __expf(cu), eE = __expf(ce), eN = __expf(-cu);
            const unsigned At = f2bf(-kkf[e] * eE), Rt = f2bf(rf[e] * eC), Bt = f2bf(kkf[e] * af[e] * eN), Kt = f2bf(kf[e] * eN);
            const int t = 8 * sg + e;
            *(LAS unsigned short*)(lds + L_ARA + t * CP + j * 2) = (unsigned short)At;
            *(LAS unsigned short*)(lds + L_ARR + t * CP + j * 2) = (unsigned short)Rt;
            *(LAS unsigned short*)(lds + L_BKB + t * CP + j * 2) = (unsigned short)Bt;
            *(LAS unsigned short*)(lds + L_BKK + t * CP + j * 2) = (unsigned short)Kt;
            if (e & 1) { at8[e >> 1] |= At << 16; bt8[e >> 1] |= Bt << 16; kt8[e >> 1] |= Kt << 16; vt8[e >> 1] |= vb[e] << 16; }
            else { at8[e >> 1] = At; bt8[e >> 1] = Bt; kt8[e >> 1] = Kt; vt8[e >> 1] = vb[e]; }
            const float bs = wave_sum(rf[e] * kf[e] * rkj);
            if (j == 0) BON[(tok0 + t) * NH + h] = bs;
        }
        *(LAS v4u*)(lds + L_AT + j * CP + sg * 16) = (v4u){at8[0], at8[1], at8[2], at8[3]};
        *(LAS v4u*)(lds + L_BT + j * CP + sg * 16) = (v4u){bt8[0], bt8[1], bt8[2], bt8[3]};
        *(LAS v4u*)(lds + L_KT + j * CP + sg * 16) = (v4u){kt8[0], kt8[1], kt8[2], kt8[3]};
        *(LAS v4u*)(lds + L_VT + j * CP + sg * 16) = (v4u){vt8[0], vt8[1], vt8[2], vt8[3]};
    }
    __syncthreads();
    {
        const int tq = w & 3; const bool isA = w < 4;
        const LAS unsigned char* Bsrc = lds + (isA ? L_ARA : L_ARR) + (16 * tq + fr) * CP + g * 16;
        const bf16x8 b0 = *(const LAS bf16x8*)Bsrc, b1 = *(const LAS bf16x8*)(Bsrc + 64);
        const int t = 16 * tq + fr;
#pragma unroll
        for (int mt = 0; mt < 8; ++mt) {
            const int sq = mt & 3; const bool isB = mt < 4;
            f32x4 acc = (f32x4){0.f, 0.f, 0.f, 0.f};
            if (sq <= tq) {
                const LAS unsigned char* Asrc = lds + (isB ? L_BKB : L_BKK) + (16 * sq + fr) * CP + g * 16;
                acc = mfma32(*(const LAS bf16x8*)Asrc, b0, acc);
                acc = mfma32(*(const LAS bf16x8*)(Asrc + 64), b1, acc);
            }
            const int s0 = 16 * sq + 4 * g;
#pragma unroll
            for (int i = 0; i < 4; ++i) { const bool keep = isA ? (s0 + i < t) : (s0 + i <= t); acc[i] = keep ? acc[i] : 0.f; }
            const int dst = isB ? (isA ? L_AAB : L_ARB) : (isA ? L_AAK : L_ARK);
            *(LAS v2u*)(lds + dst + t * CP + s0 * 2) = pk4(acc);
            if (isA && isB && sq == tq) *(LAS f32x4*)(lds + L_ND + tq * 1024 + fr * 64 + g * 16) = acc;
        }
    }
    __syncthreads();
    if (w == 0) {
        const int bi = lane >> 4, cc = lane & 15;
        const LAS float* Nb = (const LAS float*)(lds + L_ND + bi * 1024);
        float x[16];
#pragma unroll
        for (int r = 0; r < 16; ++r) {
            float acc = (r == cc) ? 1.f : 0.f;
#pragma unroll
            for (int kq = 0; kq < (r + 3) / 4; ++kq) { const f32x4 n4 = *(const LAS f32x4*)(Nb + r * 16 + 4 * kq);
#pragma unroll
                for (int z = 0; z < 4; ++z) if (4 * kq + z < r) acc += n4[z] * x[4 * kq + z]; }
            x[r] = acc;
            *(LAS unsigned short*)(lds + L_TB + bi * 512 + r * 32 + cc * 2) = (unsigned short)f2bf(acc);
        }
    } else {
        for (int ti = w - 1; ti < 16; ti += 7) {
            const int mt = ti >> 2, nt = ti & 3;
            const LAS unsigned char* Asrc = lds + L_AAK + (16 * mt + fr) * CP + g * 16;
            const LAS unsigned char* Bsrc = lds + L_VT + (16 * nt + fr) * CP + g * 16;
            f32x4 acc = (f32x4){0.f, 0.f, 0.f, 0.f};
            acc = mfma32(*(const LAS bf16x8*)Asrc, *(const LAS bf16x8*)Bsrc, acc);
            acc = mfma32(*(const LAS bf16x8*)(Asrc + 64), *(const LAS bf16x8*)(Bsrc + 64), acc);
            *(LAS v2u*)(lds + L_W2T + (16 * nt + fr) * CP + (16 * mt + 4 * g) * 2) = pk4(acc);
        }
    }
    __syncthreads();
    {
        const LAS unsigned char* rhs = lds + (w < 4 ? L_AT : L_W2T) + (16 * (w & 3) + fr) * CP;
        LAS unsigned char* xout = lds + (w < 4 ? L_PT : L_QT) + (16 * (w & 3) + fr) * CP;
        bf16x4 X[4];
#pragma unroll
        for (int bq = 0; bq < 4; ++bq) {
            const v2u rv = *(const LAS v2u*)(rhs + (16 * bq + 4 * g) * 2);
            f32x4 y = (f32x4){bflo(rv.x), bfhi(rv.x), bflo(rv.y), bfhi(rv.y)};
#pragma unroll
            for (int kb = 0; kb < bq; ++kb) {
                const bf16x4 nf = *(const LAS bf16x4*)(lds + L_AAB + (16 * bq + fr) * CP + (16 * kb + 4 * g) * 2);
                y = mfma16(nf, X[kb], y);
            }
            const v2u yb = pk4(y);
            const bf16x4 tf = *(const LAS bf16x4*)(lds + L_TB + bq * 512 + fr * 32 + g * 8);
            const f32x4 xr = mfma16(tf, __builtin_bit_cast(bf16x4, yb), (f32x4){0.f, 0.f, 0.f, 0.f});
            const v2u xb = pk4(xr);
            X[bq] = __builtin_bit_cast(bf16x4, xb);
            *(LAS v2u*)(xout + (16 * bq + 4 * g) * 2) = xb;
        }
    }
    __syncthreads();
    {
        const int nt = w & 3;
        const LAS float* GL = (const LAS float*)(lds + L_GL);
        if (w < 4) {
            const LAS unsigned char* Bb = lds + L_BT + (16 * nt + fr) * CP + g * 16;
            const bf16x8 bb0 = *(const LAS bf16x8*)Bb, bb1 = *(const LAS bf16x8*)(Bb + 64);
            const LAS unsigned char* Bq = lds + L_QT + (16 * nt + fr) * CP + g * 16;
            const bf16x8 bq0 = *(const LAS bf16x8*)Bq, bq1 = *(const LAS bf16x8*)(Bq + 64);
            const LAS unsigned char* Bv = lds + L_VT + (16 * nt + fr) * CP + g * 16;
            const bf16x8 bv0 = *(const LAS bf16x8*)Bv, bv1 = *(const LAS bf16x8*)(Bv + 64);
            const int jn = 16 * nt + fr; const float glj = GL[jn];
            bf16* Mg = (bf16*)(F.ws + WS_CM) + (size_t)unit * 4096;
            float* Gg = (float*)(F.ws + WS_CG) + (size_t)unit * 4096;
#pragma unroll
            for (int mt = 0; mt < 4; ++mt) {
                const LAS unsigned char* Ap = lds + L_PT + (16 * mt + fr) * CP + g * 16;
                f32x4 acc = (f32x4){0.f, 0.f, 0.f, 0.f};
                acc = mfma32(*(const LAS bf16x8*)Ap, bb0, acc); acc = mfma32(*(const LAS bf16x8*)(Ap + 64), bb1, acc);
#pragma unroll
                for (int i = 0; i < 4; ++i) acc[i] = glj * (acc[i] + ((16 * mt + 4 * g + i == jn) ? 1.f : 0.f));
                *(GAS v2u*)(Mg + jn * 64 + 16 * mt + 4 * g) = pk4(acc);
                const LAS unsigned char* Ab = lds + L_BT + (16 * mt + fr) * CP + g * 16;
                const LAS unsigned char* Ak = lds + L_KT + (16 * mt + fr) * CP + g * 16;
                f32x4 ga = (f32x4){0.f, 0.f, 0.f, 0.f};
                ga = mfma32(*(const LAS bf16x8*)Ab, bq0, ga); ga = mfma32(*(const LAS bf16x8*)(Ab + 64), bq1, ga);
                ga = mfma32(*(const LAS bf16x8*)Ak, bv0, ga); ga = mfma32(*(const LAS bf16x8*)(Ak + 64), bv1, ga);
                const f32x4 gl4 = *(const LAS f32x4*)(GL + 16 * mt + 4 * g);
                ga = ga * gl4;
                *(GAS f32x4*)(Gg + ((nt * 4 + mt) * 64 + lane) * 4) = ga;
            }
        } else {
            const LAS unsigned char* Bb = lds + L_ARB + (16 * nt + fr) * CP + g * 16;
            const bf16x8 bb0 = *(const LAS bf16x8*)Bb, bb1 = *(const LAS bf16x8*)(Bb + 64);
            const LAS unsigned char* Bk = lds + L_ARK + (16 * nt + fr) * CP + g * 16;
            const bf16x8 bk0 = *(const LAS bf16x8*)Bk, bk1 = *(const LAS bf16x8*)(Bk + 64);
            const int tn = 16 * nt + fr;
            bf16* Ryg = (bf16*)(F.ws + WS_CRY) + (size_t)unit * 4096;
            float* Ycg = (float*)(F.ws + WS_CYC) + (size_t)unit * 4096;
#pragma unroll
            for (int mt = 0; mt < 4; ++mt) {
                const LAS unsigned char* Ap = lds + L_PT + (16 * mt + fr) * CP + g * 16;
                const v2u rv = *(const LAS v2u*)(lds + L_ARR + tn * CP + (16 * mt + 4 * g) * 2);
                f32x4 acc = (f32x4){bflo(rv.x), bfhi(rv.x), bflo(rv.y), bfhi(rv.y)};
                acc = mfma32(*(const LAS bf16x8*)Ap, bb0, acc); acc = mfma32(*(const LAS bf16x8*)(Ap + 64), bb1, acc);
                *(GAS v2u*)(Ryg + tn * 64 + 16 * mt + 4 * g) = pk4(acc);
                const LAS unsigned char* Aq = lds + L_QT + (16 * mt + fr) * CP + g * 16;
                const LAS unsigned char* Av = lds + L_VT + (16 * mt + fr) * CP + g * 16;
                f32x4 ya = (f32x4){0.f, 0.f, 0.f, 0.f};
                ya = mfma32(*(const LAS bf16x8*)Aq, bb0, ya); ya = mfma32(*(const LAS bf16x8*)(Aq + 64), bb1, ya);
                ya = mfma32(*(const LAS bf16x8*)Av, bk0, ya); ya = mfma32(*(const LAS bf16x8*)(Av + 64), bk1, ya);
                *(GAS f32x4*)(Ycg + ((mt * 4 + nt) * 64 + lane) * 4) = ya;
            }
        }
    }
}
__device__ __forceinline__ void wkv_r2_wave(Frame& F, int bh, int nt) {
    const int lane = F.lane, fr = lane & 15, g = lane >> 4;
    const bf16* Mg = (const bf16*)(F.ws + WS_CM) + (size_t)bh * NCHK * 4096;
    const float* Gg = (const float*)(F.ws + WS_CG) + (size_t)bh * NCHK * 4096;
    bf16* Sg = (bf16*)(F.ws + WS_CS) + (size_t)bh * NCHK * 4096;
    f32x4 S[4];
#pragma unroll
    for (int mt = 0; mt < 4; ++mt) S[mt] = (f32x4){0.f, 0.f, 0.f, 0.f};
    v2u mA[4][2][2]; f32x4 gC[4];
#define R2_LOAD(cidx) do { const bf16* Mc_ = Mg + (size_t)(cidx) * 4096; const float* Gc_ = Gg + (size_t)(cidx) * 4096; \
        _Pragma("unroll") for (int mt = 0; mt < 4; ++mt) { gC[mt] = *(const GAS f32x4*)(Gc_ + ((nt * 4 + mt) * 64 + lane) * 4); \
            _Pragma("unroll") for (int ks = 0; ks < 2; ++ks) { const bf16* mp = Mc_ + (16 * mt + fr) * 64 + 32 * ks + 4 * g; mA[mt][ks][0] = *(const GAS v2u*)mp; mA[mt][ks][1] = *(const GAS v2u*)(mp + 16); } } } while (0)
    R2_LOAD(0);
    for (int c = 0; c < NCHK; ++c) {
        v2u sb[4];
#pragma unroll
        for (int mt = 0; mt < 4; ++mt) { sb[mt] = pk4(S[mt]); *(GAS v2u*)(Sg + (size_t)c * 4096 + (16 * nt + fr) * 64 + 16 * mt + 4 * g) = sb[mt]; }
        const bf16x8 bf0 = __builtin_bit_cast(bf16x8, (v4u){sb[0].x, sb[0].y, sb[1].x, sb[1].y});
        const bf16x8 bf1 = __builtin_bit_cast(bf16x8, (v4u){sb[2].x, sb[2].y, sb[3].x, sb[3].y});
        f32x4 Sn[4];
#pragma unroll
        for (int mt = 0; mt < 4; ++mt) {
            const bf16x8 a0 = __builtin_bit_cast(bf16x8, (v4u){mA[mt][0][0].x, mA[mt][0][0].y, mA[mt][0][1].x, mA[mt][0][1].y});
            const bf16x8 a1 = __builtin_bit_cast(bf16x8, (v4u){mA[mt][1][0].x, mA[mt][1][0].y, mA[mt][1][1].x, mA[mt][1][1].y});
            Sn[mt] = mfma32(a0, bf0, gC[mt]); Sn[mt] = mfma32(a1, bf1, Sn[mt]);
        }
        if (c + 1 < NCHK) R2_LOAD(c + 1);
#pragma unroll
        for (int mt = 0; mt < 4; ++mt) S[mt] = Sn[mt];
    }
#undef R2_LOAD
}
__device__ __forceinline__ void wkv_r3_wave(Frame& F, int L, int unit) {
    const int c = unit % NCHK, bh = unit / NCHK, h = bh % NH, b = bh / NH;
    const int lane = F.lane, fr = lane & 15, g = lane >> 4;
    const bf16* Sg = (const bf16*)(F.ws + WS_CS) + (size_t)unit * 4096;
    const bf16* Ryg = (const bf16*)(F.ws + WS_CRY) + (size_t)unit * 4096;
    const float* Ycg = (const float*)(F.ws + WS_CYC) + (size_t)unit * 4096;
    const bf16* SV = (const bf16*)(F.ws + WS_SV); const bf16* SG = (const bf16*)(F.ws + WS_SG); const float* BON = (const float*)(F.ws + WS_BON);
    bf16* YC = (bf16*)(F.ws + WS_YC);
    const float* lg = INP(I_LNG) + (size_t)L * C + h * HD; const float* lb = INP(I_LNB) + (size_t)L * C + h * HD;
    const size_t tok0 = (size_t)b * SEQ + (size_t)c * 64;
    bf16x8 sa[4][2];
#pragma unroll
    for (int mt = 0; mt < 4; ++mt)
#pragma unroll
        for (int ks = 0; ks < 2; ++ks) sa[mt][ks] = *(const GAS bf16x8*)(Sg + (16 * mt + fr) * 64 + 32 * ks + 8 * g);
    f32x4 lgv[4], lbv[4];
#pragma unroll
    for (int mt = 0; mt < 4; ++mt) { lgv[mt] = *(const GAS f32x4*)(lg + 16 * mt + 4 * g); lbv[mt] = *(const GAS f32x4*)(lb + 16 * mt + 4 * g); }
#pragma unroll
    for (int nt = 0; nt < 4; ++nt) {
        const int t = 16 * nt + fr;
        const bf16x8 rb0 = *(const GAS bf16x8*)(Ryg + t * 64 + 8 * g), rb1 = *(const GAS bf16x8*)(Ryg + t * 64 + 32 + 8 * g);
        f32x4 y[4]; float s = 0.f;
#pragma unroll
        for (int mt = 0; mt < 4; ++mt) {
            f32x4 acc = *(const GAS f32x4*)(Ycg + ((mt * 4 + nt) * 64 + lane) * 4);
            acc = mfma32(sa[mt][0], rb0, acc); acc = mfma32(sa[mt][1], rb1, acc);
            y[mt] = acc; s += (acc[0] + acc[1]) + (acc[2] + acc[3]);
        }
        s += __shfl_xor(s, 16); s += __shfl_xor(s, 32);
        const float mean = s * (1.f / HD); float q = 0.f;
#pragma unroll
        for (int mt = 0; mt < 4; ++mt) { y[mt] = y[mt] - mean; q += (y[mt][0] * y[mt][0] + y[mt][1] * y[mt][1]) + (y[mt][2] * y[mt][2] + y[mt][3] * y[mt][3]); }
        q += __shfl_xor(q, 16); q += __shfl_xor(q, 32);
        const float rstd = 1.0f / sqrtf(q * (1.f / HD) + LNX_EPS);
        const float bon = BON[(tok0 + t) * NH + h];
#pragma unroll
        for (int mt = 0; mt < 4; ++mt) {
            const size_t o = (tok0 + t) * C + h * HD + 16 * mt + 4 * g;
            const v2u vv = *(const GAS v2u*)(SV + o), gg = *(const GAS v2u*)(SG + o);
            f32x4 r;
            r[0] = (y[mt][0] * rstd * lgv[mt][0] + lbv[mt][0] + bon * bflo(vv.x)) * bflo(gg.x);
            r[1] = (y[mt][1] * rstd * lgv[mt][1] + lbv[mt][1] + bon * bfhi(vv.x)) * bfhi(gg.x);
            r[2] = (y[mt][2] * rstd * lgv[mt][2] + lbv[mt][2] + bon * bflo(vv.y)) * bflo(gg.y);
            r[3] = (y[mt][3] * rstd * lgv[mt][3] + lbv[mt][3] + bon * bfhi(vv.y)) * bfhi(gg.y);
            *(GAS v2u*)(YC + (tok0 + t) * D + h * HD + 16 * mt + 4 * g) = pk4(r);
        }
    }
}

__device__ __forceinline__ int crow(int r, int hi) { return (r & 3) + 8 * (r >> 2) + 4 * hi; }
typedef short s16x4 __attribute__((ext_vector_type(4)));
typedef float f32x2_t __attribute__((ext_vector_type(2))); typedef __bf16 bf16x2_t __attribute__((ext_vector_type(2)));
__device__ __forceinline__ unsigned cvtpk(float lo, float hi) { f32x2_t v = {lo, hi}; bf16x2_t b = __builtin_convertvector(v, bf16x2_t); return __builtin_bit_cast(unsigned, b); }
__device__ __forceinline__ s16x4 vtr(const LAS unsigned char* p) { return __builtin_bit_cast(s16x4, __builtin_amdgcn_ds_read_tr16_b64_v4i16((LAS s16x4*)p)); }
constexpr float ATT_THR = 6.0f;
constexpr int A_KB = 0, A_VB = 65536, A_KM = 131072;
__device__ __forceinline__ void attn2_unit(Frame& F, int b, int h, int qb, int half) {
    const bf16* AQ = (const bf16*)(F.ws + WS_AQ); const bf16* AKp = (const bf16*)(F.ws + WS_AK); const bf16* Z = (const bf16*)(F.ws + WS_Z); const float* KM = (const float*)(F.ws + WS_KM);
    bf16* YC = (bf16*)(F.ws + WS_YC);
    const int tid = F.tid, lane = F.lane, w = F.wave, qg = w & 3, kvh = w >> 2, r32 = lane & 31, hi = lane >> 5;
    LAS unsigned char* lds = F.lds;
    const size_t tb = (size_t)b * SEQ; const int q0w = qb * MB + 128 * half + 32 * qg;
    __syncthreads();
    for (int i = tid; i < NBLK * AD; i += NTHR) { const float v = KM[(size_t)(b * AH + h) * NBLK * AD + i]; const unsigned hb = f2bf(v); const float rem = v - __builtin_bit_cast(float, hb << 16);
        ((LAS unsigned short*)(lds + A_KM))[i] = (unsigned short)hb; ((LAS unsigned short*)(lds + A_KM + 4096))[i] = (unsigned short)f2bf(rem); }
    bf16x8 qr[8];
    { const bf16* Qp = AQ + (tb + q0w + r32) * C + h * AD + hi * 8;
#pragma unroll
      for (int d0 = 0; d0 < 8; ++d0) qr[d0] = *(const GAS bf16x8*)(Qp + d0 * 16); }
    const int n_own = half ? 2 : 1, NS = n_own + 2 * qb;
    const bf16* Kg = AKp + tb * C + h * AD; const bf16* Vg = Z + tb * NZ + ZV + h * AD;
#define STEP_KB(si) (((si) < n_own) ? (qb * MB + 128 * (si)) : ((((si) - n_own) >> 1) * MB + 128 * (((si) - n_own) & 1)))
    const int dl_r = lane >> 4, dl_cs = lane & 15;
#define ATT_LOAD(si, bi) do { const int kb_ = STEP_KB(si); _Pragma("unroll") for (int i_ = 0; i_ < 4; ++i_) { const int pi_ = w + 8 * i_; const int row_ = 4 * pi_ + dl_r; \
        __builtin_amdgcn_global_load_lds((const GAS unsigned*)(Kg + (size_t)(kb_ + row_) * C + ((dl_cs ^ (row_ & 15)) << 3)), (LAS unsigned*)(lds + A_KB + (bi) * 32768 + pi_ * 1024), 16, 0, 0); \
        __builtin_amdgcn_global_load_lds((const GAS unsigned*)(Vg + (size_t)(kb_ + row_) * NZ + ((dl_cs ^ ((row_ & 3) << 2)) << 3)), (LAS unsigned*)(lds + A_VB + (bi) * 32768 + pi_ * 1024), 16, 0, 0); } } while (0)
    ATT_LOAD(0, 0);
    __syncthreads();
    unsigned selmask;
    {
        f32x16 ga = (f32x16){0.f};
        const bool rowok = r32 < 16;
#pragma unroll
        for (int d0 = 0; d0 < 8; ++d0) {
            const LAS unsigned char* kp = lds + A_KM + (r32 & 15) * 256 + d0 * 32 + hi * 16;
            bf16x8 ah = *(const LAS bf16x8*)kp, al = *(const LAS bf16x8*)(kp + 4096);
            if (!rowok) { ah = (bf16x8){0, 0, 0, 0, 0, 0, 0, 0}; al = ah; }
            ga = __builtin_amdgcn_mfma_f32_32x32x16_bf16(ah, qr[d0], ga, 0, 0, 0);
            ga = __builtin_amdgcn_mfma_f32_32x32x16_bf16(al, qr[d0], ga, 0, 0, 0);
        }
        float gt[16];
#pragma unroll
        for (int r = 0; r < 4; ++r) { const float o0 = __shfl_xor(ga[r], 32), o1 = __shfl_xor(ga[4 + r], 32);
            gt[r] = hi ? o0 : ga[r]; gt[4 + r] = hi ? ga[r] : o0; gt[8 + r] = hi ? o1 : ga[4 + r]; gt[12 + r] = hi ? ga[4 + r] : o1; }
        float g1 = -INFINITY, g2 = -INFINITY, g3 = -INFINITY; int i1 = 0, i2 = 0, i3 = 0;
#pragma unroll
        for (int n = 0; n < 16; ++n) { if (n < qb) { const float g = gt[n];
            if (g > g1) { g3 = g2; i3 = i2; g2 = g1; i2 = i1; g1 = g; i1 = n; }
            else if (g > g2) { g3 = g2; i3 = i2; g2 = g; i2 = n; }
            else if (g > g3) { g3 = g; i3 = n; } } }
        selmask = (qb <= 3) ? ((1u << qb) - 1u) : ((1u << i1) | (1u << i2) | (1u << i3));
    }
    f32x16 O[4];
#pragma unroll
    for (int dt = 0; dt < 4; ++dt) O[dt] = (f32x16){0.f};
    float m_run = -1e30f, l_run = 0.f;
    VM_WAIT();
    __syncthreads();
    const int qpos = q0w + r32;
    const int trq = (lane & 15) >> 2, trp = lane & 3, trg = (lane >> 4) & 1;
    for (int si = 0; si < NS; ++si) {
        if (si + 1 < NS) ATT_LOAD(si + 1, (si + 1) & 1);
        const bool own = si < n_own;
        const int kt = STEP_KB(si) + 64 * kvh;
        const bool skip = own && (kt > q0w + 31);
        if (!skip) {
            const LAS unsigned char* kb_ = lds + A_KB + (si & 1) * 32768 + (64 * kvh) * 256;
            const LAS unsigned char* vb_ = lds + A_VB + (si & 1) * 32768 + (64 * kvh) * 256;
            f32x16 p[2];
#pragma unroll
            for (int kb2 = 0; kb2 < 2; ++kb2) {
                f32x16 acc = (f32x16){0.f};
                const int row = 32 * kb2 + r32;
#pragma unroll
                for (int d0 = 0; d0 < 8; ++d0) {
                    const bf16x8 kf = *(const LAS bf16x8*)(kb_ + row * 256 + (((2 * d0 + hi) ^ (row & 15)) << 4));
                    acc = __builtin_amdgcn_mfma_f32_32x32x16_bf16(kf, qr[d0], acc, 0, 0, 0);
                }
                p[kb2] = acc;
            }
            if (own && (kt + 63 > q0w)) {
#pragma unroll
                for (int kb2 = 0; kb2 < 2; ++kb2)
#pragma unroll
                    for (int r = 0; r < 16; ++r) { const int kpos = kt + 32 * kb2 + crow(r, hi); p[kb2][r] = (kpos <= qpos) ? p[kb2][r] : -1e30f; }
            }
            const bool ok = own || ((selmask >> ((si - n_own) >> 1)) & 1u);
            float mx = fmaxf(p[0][0], p[1][0]);
#pragma unroll
            for (int r = 1; r < 16; ++r) mx = fmaxf(mx, fmaxf(p[0][r], p[1][r]));
            mx = fmaxf(mx, __shfl_xor(mx, 32));
            mx = ok ? mx : -1e30f;
            if (__any(mx > m_run + ATT_THR)) {
                const float m_new = fmaxf(m_run, mx); const float alpha = __builtin_amdgcn_exp2f(m_run - m_new);
                m_run = m_new; l_run *= alpha;
#pragma unroll
                for (int dt = 0; dt < 4; ++dt)
#pragma unroll
                    for (int r = 0; r < 16; ++r) O[dt][r] *= alpha;
            }
            float ls = 0.f;
#pragma unroll
            for (int kb2 = 0; kb2 < 2; ++kb2)
#pragma unroll
                for (int r = 0; r < 16; ++r) { const float e = __builtin_amdgcn_exp2f(p[kb2][r] - m_run); p[kb2][r] = e; ls += e; }
            l_run += ok ? ls : 0.f;
            const unsigned okm = ok ? 0xffffffffu : 0u;
#pragma unroll
            for (int kb2 = 0; kb2 < 2; ++kb2)
#pragma unroll
                for (int s = 0; s < 2; ++s) {
                    v4u pw; pw.x = cvtpk(p[kb2][8 * s + 0], p[kb2][8 * s + 1]) & okm; pw.y = cvtpk(p[kb2][8 * s + 2], p[kb2][8 * s + 3]) & okm;
                    pw.z = cvtpk(p[kb2][8 * s + 4], p[kb2][8 * s + 5]) & okm; pw.w = cvtpk(p[kb2][8 * s + 6], p[kb2][8 * s + 7]) & okm;
                    const bf16x8 pf = __builtin_bit_cast(bf16x8, pw);
                    const int key0 = 32 * kb2 + 16 * s + 4 * hi + trq;
#pragma unroll
                    for (int dt = 0; dt < 4; ++dt) {
                        const int dby = (32 * dt + 16 * trg + 4 * trp) * 2;
                        const s16x4 lo = vtr(vb_ + key0 * 256 + (dby ^ ((key0 & 3) << 6)));
                        const s16x4 hi4 = vtr(vb_ + (key0 + 8) * 256 + (dby ^ (((key0 + 8) & 3) << 6)));
                        const bf16x8 vf = (bf16x8){lo[0], lo[1], lo[2], lo[3], hi4[0], hi4[1], hi4[2], hi4[3]};
                        O[dt] = __builtin_amdgcn_mfma_f32_32x32x16_bf16(vf, pf, O[dt], 0, 0, 0);
                    }
                }
        }
        VM_WAIT();
        __syncthreads();
    }
    LAS float* cb = (LAS float*)lds + (size_t)qg * 64 * 67;
    if (kvh == 1) {
        LAS float* cp = cb + lane * 67;
        cp[64] = m_run; cp[65] = l_run;
#pragma unroll
        for (int dt = 0; dt < 4; ++dt)
#pragma unroll
            for (int r = 0; r < 16; ++r) cp[dt * 16 + r] = O[dt][r];
    }
    __syncthreads();
    if (kvh == 0) {
        const LAS float* cp = cb + lane * 67;
        const float m1 = cp[64], l1 = cp[65];
        const float m = fmaxf(m_run, m1); const float a0 = __builtin_amdgcn_exp2f(m_run - m), a1 = __builtin_amdgcn_exp2f(m1 - m);
        float l = l_run * a0 + l1 * a1; l += __shfl_xor(l, 32);
        const float inv = 1.0f / l;
#pragma unroll
        for (int dt = 0; dt < 4; ++dt)
#pragma unroll
            for (int r = 0; r < 16; ++r) O[dt][r] = (O[dt][r] * a0 + cp[dt * 16 + r] * a1) * inv;
    }
    __syncthreads();
    if (kvh == 0) {
        LAS unsigned char* st = lds + 69632 + qg * (32 * 272);
#pragma unroll
        for (int dt = 0; dt < 4; ++dt)
#pragma unroll
            for (int rq = 0; rq < 4; ++rq) { v2u wv; wv.x = cvtpk(O[dt][4 * rq], O[dt][4 * rq + 1]); wv.y = cvtpk(O[dt][4 * rq + 2], O[dt][4 * rq + 3]);
                *(LAS v2u*)(st + r32 * 272 + (32 * dt + 8 * rq + 4 * hi) * 2) = wv; }
        LDS_WAIT(); asm volatile("" ::: "memory");
#pragma unroll
        for (int i = 0; i < 8; ++i) { const int row = i * 4 + (lane >> 4), ch = lane & 15;
            const v4u v = *(const LAS v4u*)(st + row * 272 + ch * 16);
            *(GAS v4u*)(YC + (tb + q0w + row) * D + C + h * AD + ch * 8) = v; }
    }
#undef STEP_KB
#undef ATT_LOAD
}
__device__ __forceinline__ void ph_wkv_r1(Frame& F, int L) { for (int u = F.vcu; u < NUNIT; u += F.G) wkv_r1_unit(F, L, u); }
__device__ __forceinline__ void ph_wkv_r2(Frame& F) { if (F.wave == 0) for (int id = F.vcu; id < BATCH * NH * 4; id += F.G) wkv_r2_wave(F, id >> 2, id & 3); }
__device__ __forceinline__ void ph_mixer(Frame& F, int L) {
    for (int u = F.vcu * NWAVES + F.wave; u < NUNIT; u += F.G * NWAVES) wkv_r3_wave(F, L, u);
    for (int it = F.vcu; it < BATCH * AH * NBLK; it += F.G) { const int bh = it >> 4, rem = it & 15, qlo = rem >> 1, hf = rem & 1;
        for (int k = 0; k < 2; ++k) attn2_unit(F, bh / AH, bh % AH, k ? qlo : NBLK - 1 - qlo, k ? hf : 1 - hf); }
}

constexpr int PH_PER_LAYER = 11, NPHASE = DEPTH * PH_PER_LAYER;
#ifndef MK_N_LAUNCHES
#define MK_N_LAUNCHES 1
#endif
struct Args { const float* in[24]; float* out; unsigned char* ws; int ph_lo, ph_hi, li, pad; };
__global__ void __launch_bounds__(NTHR, 2) mega_fwd(Args args) {
    extern __shared__ __attribute__((aligned(16))) unsigned char lds[];
    Frame F;
    F.lds = (LAS unsigned char*)lds;
    F.MISC = (volatile LAS unsigned*)(F.lds + MISC_OFF);
    F.tid = threadIdx.x; F.lane = F.tid & 63; F.wave = __builtin_amdgcn_readfirstlane(F.tid >> 6);
    F.G = gridDim.x; { const int bx = blockIdx.x; F.vcu = (F.G % 8 == 0) ? (bx % 8) * (F.G / 8) + bx / 8 : bx; }
    F.ws = args.ws; F.out = args.out; F.ctl = (gu32*)(args.ws + WS_CTL);
    for (int u = F.tid; u < (LDS_BYTES - LDSCTL_OFF) / 4; u += NTHR) ((LAS unsigned*)(F.lds + LDSCTL_OFF))[u] = 0u;
    __syncthreads();
    if (F.tid < 24) *(LAS unsigned long long*)(F.lds + PTAB_OFF + 8 * F.tid) = (unsigned long long)args.in[F.tid];
    __syncthreads();
    XcdBarrier bar; bar.bar = (unsigned*)(F.ctl + CW_BAR) + args.li * XCD_BAR_WORDS; bar.x = 0; bar.st = nullptr;
    const bool one_launch = (args.ph_hi - args.ph_lo) > 1;
    if (one_launch) bar = xcd_barrier_post((unsigned*)(F.ctl + CW_BAR) + args.li * XCD_BAR_WORDS, F.MISC + 8);
    bf16* HN = (bf16*)(F.ws + WS_HN); bf16* YC = (bf16*)(F.ws + WS_YC); bf16* Zb = (bf16*)(F.ws + WS_Z); bf16* U = (bf16*)(F.ws + WS_U);
    float* Y2 = (float*)(F.ws + WS_Y2); float* Mo = (float*)(F.ws + WS_M);
#ifdef PROBE_DUP_MASK
    bool dup_done = false;
#endif
    for (int ph = args.ph_lo; ph < args.ph_hi; ++ph) {
        const int L = ph / PH_PER_LAYER, p = ph % PH_PER_LAYER;
        { int t_ = threadIdx.x; asm volatile("" : "+v"(t_)); F.tid = t_; F.lane = t_ & 63; F.wave = __builtin_amdgcn_readfirstlane(t_ >> 6); }
        { unsigned long long w_ = (unsigned long long)args.ws, o_ = (unsigned long long)args.out; asm volatile("" : "+s"(w_), "+s"(o_)); F.ws = (unsigned char*)w_; F.out = (float*)o_; F.ctl = (gu32*)w_; }
        { int g_ = gridDim.x, b_ = blockIdx.x; asm volatile("" : "+s"(g_), "+s"(b_)); F.G = g_; F.bx = b_; F.vcu = (g_ % 8 == 0) ? (b_ % 8) * (g_ / 8) + b_ / 8 : b_; }
        { unsigned l_ = (unsigned)(unsigned long long)(LAS unsigned char*)lds; asm volatile("" : "+s"(l_)); F.lds = (LAS unsigned char*)(unsigned long long)l_; }
        switch (p) {
        case 0: ph_convert(F, L); break;
        case 1: { pg8::Gemm g{HN, (const bf16*)(F.ws + WS_WIN), T, (L == 0) ? NIN : NZ, D}; pg8::StaticOrder S; S.init(T, (L == 0) ? NIN : NZ, F.G, F.bx);
                  pg8::EpiBf16<0> E{Zb, NZ}; pg8::gemm_phase<pg8::EpiBf16<0>, pg8::StaticOrder, true, true>(F.lds, g, S, E, F.tid); } break;
        case 2: ph_prep(F, L); break;
        case 3: ph_wkv_r1(F, L); break;
        case 4: ph_wkv_r2(F); break;
        case 5: ph_mixer(F, L); break;
        case 6: { pg8::Gemm g{YC, (const bf16*)(F.ws + WS_WOUT), T, D, D}; pg8::StaticOrder S; S.init(T, D, F.G, F.bx);
                  pg8::EpiF32 E{Y2, D}; pg8::gemm_phase<pg8::EpiF32, pg8::StaticOrder, true, true>(F.lds, g, S, E, F.tid); } break;
        case 7: ph_resnorm(F, Y2, (L == 0) ? INP(I_X) : F.out, INP(I_NMIXPOST) + (size_t)L * D, INP(I_NMLPPRE) + (size_t)L * D, F.out, HN); break;
        case 8: { pg8::Gemm g{HN, (const bf16*)(F.ws + WS_WUP), T, FF, D}; pg8::StaticOrder S; S.init(T, FF, F.G, F.bx);
                  pg8::EpiBf16<2> E{U, FF}; pg8::gemm_phase<pg8::EpiBf16<2>, pg8::StaticOrder, true, true>(F.lds, g, S, E, F.tid); } break;
        case 9: { pg8::Gemm g{U, (const bf16*)(F.ws + WS_WDN), T, D, FF}; pg8::StaticOrder S; S.init(T, D, F.G, F.bx);
                  pg8::EpiF32 E{Mo, D}; pg8::gemm_phase<pg8::EpiF32, pg8::StaticOrder, true, true>(F.lds, g, S, E, F.tid); } break;
        case 10: ph_resnorm(F, Mo, F.out, INP(I_NMLPPOST) + (size_t)L * D, (L + 1 < DEPTH) ? INP(I_NMIXPRE) + (size_t)(L + 1) * D : nullptr, F.out, HN); break;
        }
        if (ph + 1 < args.ph_hi) xcd_barrier(bar);
#ifdef PROBE_DUP_MASK
        if (((PROBE_DUP_MASK >> p) & 1) && !dup_done) { dup_done = true; --ph; } else dup_done = false;
#endif
    }
}

extern "C" void kernel_launch(void* const* d_in, const int* in_sizes, int n_in, void* d_out, int out_size, void* d_ws, size_t ws_size, hipStream_t stream) {
    static int grid = 0;
    if (grid == 0) {
        if (n_in != 24 || in_sizes[0] != T * D || out_size != T * D || ws_size < WS_END) { fprintf(stderr, "kernel_launch: unexpected shapes (n_in %d, in0 %d, out %d, ws %zu)\n", n_in, n_in > 0 ? in_sizes[0] : -1, out_size, ws_size); grid = -1; return; }
        int dev = 0, cus = 0, per_cu = 0;
        if (hipGetDevice(&dev) != hipSuccess || hipDeviceGetAttribute(&cus, hipDeviceAttributeMultiprocessorCount, dev) != hipSuccess) { grid = -1; return; }
        if (hipFuncSetAttribute((const void*)mega_fwd, hipFuncAttributeMaxDynamicSharedMemorySize, LDS_BYTES) != hipSuccess) { fprintf(stderr, "kernel_launch: hipFuncSetAttribute failed\n"); grid = -1; return; }
        if (hipOccupancyMaxActiveBlocksPerMultiprocessor(&per_cu, (const void*)mega_fwd, NTHR, LDS_BYTES) != hipSuccess || per_cu < 1) { fprintf(stderr, "kernel_launch: occupancy query says %d\n", per_cu); per_cu = 1; }
        (void)hipGetLastError();
        grid = cus * (per_cu > 1 ? 1 : per_cu);
    }
    if (grid < 0) return;
    (void)hipMemsetAsync((char*)d_ws + WS_CTL, 0, CTL_ZERO_BYTES, stream);
    Args a{};
    for (int i = 0; i < 24; ++i) a.in[i] = (const float*)d_in[i];
    a.out = (float*)d_out; a.ws = (unsigned char*)d_ws;
    const int nl = MK_N_LAUNCHES;
    for (int li = 0; li < nl; ++li) {
        a.li = li; a.ph_lo = (int)((long)NPHASE * li / nl); a.ph_hi = (int)((long)NPHASE * (li + 1) / nl);
        if (a.ph_hi - a.ph_lo > 1) {
            void* kargs[] = {&a};
            hipError_t e = hipLaunchCooperativeKernel((const void*)mega_fwd, dim3(grid), dim3(NTHR), kargs, LDS_BYTES, stream);
            if (e != hipSuccess) fprintf(stderr, "kernel_launch: cooperative launch failed: %s (grid %d)\n", hipGetErrorString(e), grid);
        } else {
            hipLaunchKernelGGL(mega_fwd, dim3(grid), dim3(NTHR), LDS_BYTES, stream, a);
        }
    }
}
```

```cpp
#include <hip/hip_runtime.h>
#include <cstdio>
#include <cstdint>
namespace pg8 {
#define PG8_LAS __attribute__((address_space(3)))
typedef unsigned short bf16_t;
typedef short bf16x8 __attribute__((ext_vector_type(8)));
typedef float f32x4 __attribute__((ext_vector_type(4)));
typedef unsigned u32x4 __attribute__((ext_vector_type(4)));
constexpr int BM = 256, BK = 64, HALF = 128, HTB = HALF * BK * 2  , STAGE_BYTES = 8 * HTB, NXCD = 8, WGM = 8;

__host__ __device__ __forceinline__ int lds_byte(int r, int c) { const int st = (r >> 4) * 2 + (c >> 5), rr = r & 15, cc = c & 31, ob = rr * 64 + cc * 2; return st * 1024 + (ob ^ (((ob >> 9) & 1) << 5)); }
__host__ __device__ __forceinline__ void stage_rc(int b, int& R, int& C) { const int st = b / 1024, sb = b % 1024, swz = sb ^ (((sb >> 9) & 1) << 5); R = (st >> 1) * 16 + swz / 64; C = (st & 1) * 32 + (swz % 64) / 2; }
__host__ __device__ __forceinline__ int perm32(int rho) { const int n = rho >> 4, i = rho & 15; return 8 * (i >> 2) + 4 * n + (i & 3); }

struct Unit { int pm, pn; };
struct Gemm { const bf16_t* A; const bf16_t* Bt; int M, N, K; };

struct StaticOrder {
    int nM, nN, nwg, G, c;
    __host__ __device__ void init(int M, int N, int G_, int c_) { nM = M / BM; nN = N / BM; nwg = nM * nN; G = G_; c = c_; }
    __host__ __device__ bool next(int i, Unit& u) const {
        const long L = (long)i * G + c; if (L >= nwg) return false;
        int wgid = (int)L; { const int q = nwg / NXCD, r = nwg % NXCD, xcd = wgid % NXCD, off = wgid / NXCD; wgid = (xcd < r ? xcd * (q + 1) : r * (q + 1) + (xcd - r) * q) + off; }
        const int nig = WGM * nN, gid = wgid / nig, fm = gid * WGM, gsz = (nM - fm) < WGM ? (nM - fm) : WGM;
        u.pm = fm + ((wgid % nig) % gsz); u.pn = (wgid % nig) / gsz; return true;
    }
    __device__ __forceinline__ void a_ready(const Unit&) const {}
    __device__ __forceinline__ void done(const Unit&) const {}
};

__device__ __forceinline__ unsigned cvt_pk_bf16(float lo, float hi) { unsigned r; asm volatile("v_cvt_pk_bf16_f32 %0, %1, %2" : "=v"(r) : "v"(lo), "v"(hi)); return r; }
struct EpiF32 {
    static constexpr bool PERM = false, AFTER_DRAIN = false;
    float* C; int ldc;
    __device__ __forceinline__ void operator()(const f32x4 (&acc)[2][2][4][2], const Unit& u, int wr, int wc, int fr, int fq) const {
        const int row0 = u.pm * BM + wr * 64 + fr, col0 = u.pn * BM + wc * 32 + 4 * fq;
#pragma unroll
        for (int ai = 0; ai < 2; ++ai)
#pragma unroll
            for (int m = 0; m < 4; ++m) { float* rowp = C + (size_t)(row0 + ai * HALF + m * 16) * ldc + col0;
#pragma unroll
                for (int bj = 0; bj < 2; ++bj)
#pragma unroll
                    for (int n = 0; n < 2; ++n) *(f32x4*)(rowp + bj * HALF + n * 16) = acc[ai][bj][m][n]; }
    }
};
template <int ACT  > struct EpiBf16 {
    static constexpr bool PERM = true, AFTER_DRAIN = false;
    bf16_t* O; int ldc;
    __device__ __forceinline__ void operator()(const f32x4 (&acc)[2][2][4][2], const Unit& u, int wr, int wc, int fr, int fq) const {
        const int row0 = u.pm * BM + wr * 64 + fr; const int col0 = u.pn * BM + wc * 32 + 8 * fq;
#pragma unroll
        for (int ai = 0; ai < 2; ++ai)
#pragma unroll
            for (int m = 0; m < 4; ++m) { bf16_t* rowp = O + (size_t)(row0 + ai * HALF + m * 16) * ldc + col0;
#pragma unroll
                for (int bj = 0; bj < 2; ++bj) { f32x4 v0 = acc[ai][bj][m][0], v1 = acc[ai][bj][m][1];
                    if (ACT == 2) {
#pragma unroll
                        for (int e = 0; e < 4; ++e) { float a = v0[e] > 0.f ? v0[e] : 0.f; v0[e] = a * a; float b = v1[e] > 0.f ? v1[e] : 0.f; v1[e] = b * b; } }
                    u32x4 w; w.x = cvt_pk_bf16(v0[0], v0[1]); w.y = cvt_pk_bf16(v0[2], v0[3]); w.z = cvt_pk_bf16(v1[0], v1[1]); w.w = cvt_pk_bf16(v1[2], v1[3]);
                    *(u32x4*)(rowp + bj * HALF) = w; } }
    }
};

template <class Epi, class Sched, bool ALIGN_EPI = false, bool SP2 = false>
__device__ __forceinline__ void gemm_phase(PG8_LAS unsigned char* lds, const Gemm g, const Sched& S, const Epi& E, const int tid) {
    const int wid = __builtin_amdgcn_readfirstlane(tid >> 6), lane = tid & 63, wr = wid >> 2, wc = wid & 3, fr = lane & 15, fq = lane >> 4;
    const int K = g.K, nt = K / BK;
    unsigned voffA[2], voffB[2];
#pragma unroll
    for (int i = 0; i < 2; ++i) { int R, C; stage_rc(tid * 16 + i * 8192, R, C); const int Rb = Epi::PERM ? ((R & ~31) + perm32(R & 31)) : R;
        voffA[i] = (unsigned)(R * K + C) * 2u; voffB[i] = (unsigned)(Rb * K + C) * 2u; }
    const size_t kstep = (size_t)(BK * 2);
    const size_t hstep = (size_t)HALF * K * 2;
    const size_t tstep = 2 * hstep;
    const unsigned ldsw = (unsigned)wid * 1024u;
    const int aoff = lds_byte(wr * 64 + fr, fq * 8), boff = lds_byte(wc * 32 + fr, fq * 8);
#define PG8_SA(b, h) (((b) * 2 + (h)) * HTB)
#define PG8_SB(b, h) ((4 + (b) * 2 + (h)) * HTB)
#define PG8_STAGE(bufoff, gbase, voff) do { _Pragma("unroll") for (int _i = 0; _i < 2; ++_i) \
        __builtin_amdgcn_global_load_lds((const unsigned*)((const char*)(gbase) + (voff)[_i]), (PG8_LAS unsigned*)(lds + (bufoff) + ldsw + _i * 8192), 16, 0, 0); } while (0)
#define PG8_LDA(dst, b, h) do { _Pragma("unroll") for (int m = 0; m < 4; ++m) _Pragma("unroll") for (int k = 0; k < 2; ++k) dst[m][k] = *(const PG8_LAS bf16x8*)(lds + PG8_SA(b, h) + aoff + m * 2048 + k * 1024); } while (0)
#define PG8_LDB(dst, b, h) do { _Pragma("unroll") for (int n = 0; n < 2; ++n) _Pragma("unroll") for (int k = 0; k < 2; ++k) dst[n][k] = *(const PG8_LAS bf16x8*)(lds + PG8_SB(b, h) + boff + n * 2048 + k * 1024); } while (0)
#define PG8_MMA(ai, bj, At, Bt) do { __builtin_amdgcn_s_setprio(1); _Pragma("unroll") for (int m = 0; m < 4; ++m) _Pragma("unroll") for (int n = 0; n < 2; ++n) _Pragma("unroll") for (int k = 0; k < 2; ++k) \
        acc[ai][bj][m][n] = __builtin_amdgcn_mfma_f32_16x16x32_bf16(Bt[n][k], At[m][k], acc[ai][bj][m][n], 0, 0, 0); __builtin_amdgcn_s_setprio(0); } while (0)
#define PG8_WAIT_V(n) asm volatile("s_waitcnt vmcnt(" #n ")" ::: "memory")
#define PG8_WAIT_L(n) asm volatile("s_waitcnt lgkmcnt(" #n ")" ::: "memory")
#define PG8_BAR __builtin_amdgcn_s_barrier()
#define PG8_SCHED __builtin_amdgcn_sched_barrier(0)
    Unit cur, nxt; int ui = 0;
    if (!S.next(0, cur)) return;
    f32x4 acc[2][2][4][2];
#pragma unroll
    for (int a = 0; a < 2; ++a)
#pragma unroll
        for (int b = 0; b < 2; ++b)
#pragma unroll
            for (int m = 0; m < 4; ++m)
#pragma unroll
                for (int n = 0; n < 2; ++n) acc[a][b][m][n] = (f32x4){0.f, 0.f, 0.f, 0.f};
    bf16x8 At[4][2], B0[2][2], B1[2][2];
    const char* cA = (const char*)g.A + (size_t)cur.pm * tstep; const char* cB = (const char*)g.Bt + (size_t)cur.pn * tstep;
    S.a_ready(cur);
    if constexpr (SP2) {
        PG8_STAGE(PG8_SB(0, 0), cB, voffB); PG8_STAGE(PG8_SB(0, 1), cB + hstep, voffB); PG8_STAGE(PG8_SA(0, 0), cA, voffA); PG8_STAGE(PG8_SA(0, 1), cA + hstep, voffA);
        if (wr == 1) PG8_BAR;
        PG8_WAIT_V(2); PG8_BAR;
        PG8_STAGE(PG8_SB(1, 0), cB + kstep, voffB); PG8_STAGE(PG8_SA(1, 0), cA + kstep, voffA); PG8_STAGE(PG8_SB(1, 1), cB + hstep + kstep, voffB);
        PG8_WAIT_V(6); PG8_BAR;
    } else {
        PG8_STAGE(PG8_SB(0, 0), cB, voffB); PG8_STAGE(PG8_SA(0, 0), cA, voffA); PG8_STAGE(PG8_SB(0, 1), cB + hstep, voffB); PG8_STAGE(PG8_SA(0, 1), cA + hstep, voffA);
        if (wr == 1) PG8_BAR;
        PG8_WAIT_V(4); PG8_BAR;
        PG8_STAGE(PG8_SB(1, 0), cB + kstep, voffB); PG8_STAGE(PG8_SA(1, 0), cA + kstep, voffA); PG8_STAGE(PG8_SB(1, 1), cB + hstep + kstep, voffB);
        PG8_WAIT_V(6); PG8_BAR;
    }
    for (;;) {
        const bool has_next = S.next(ui + 1, nxt);
        const char* nA = has_next ? (const char*)g.A + (size_t)nxt.pm * tstep : cA; const char* nB = has_next ? (const char*)g.Bt + (size_t)nxt.pn * tstep : cB;
        for (int t = 0; t < nt; t += 2) {
            const bool last = (t == nt - 2);
            const char* a1 = cA + (size_t)(t + 1) * kstep;
            const char* a2 = last ? nA : cA + (size_t)(t + 2) * kstep; const char* b2 = last ? nB : cB + (size_t)(t + 2) * kstep;
            const char* a3 = a2 + kstep; const char* b3 = b2 + kstep;
            if (last && has_next) S.a_ready(nxt);
            if constexpr (SP2) {
            PG8_LDB(B0, 0, 0); PG8_LDB(B1, 0, 1); PG8_SCHED; PG8_LDA(At, 0, 0); PG8_STAGE(PG8_SA(1, 1), a1 + hstep, voffA);
            PG8_WAIT_V(8); PG8_WAIT_L(0); PG8_BAR; PG8_MMA(0, 0, At, B0); PG8_MMA(0, 1, At, B1); PG8_BAR; PG8_SCHED;
            PG8_LDA(At, 0, 1); PG8_STAGE(PG8_SB(0, 0), b2, voffB); PG8_STAGE(PG8_SB(0, 1), b2 + hstep, voffB); PG8_STAGE(PG8_SA(0, 0), a2, voffA);
            PG8_WAIT_V(8); PG8_WAIT_L(0); PG8_BAR; PG8_MMA(1, 0, At, B0); PG8_MMA(1, 1, At, B1); PG8_BAR; PG8_SCHED;
            PG8_LDB(B0, 1, 0); PG8_LDB(B1, 1, 1); PG8_SCHED; PG8_LDA(At, 1, 0); PG8_STAGE(PG8_SA(0, 1), a2 + hstep, voffA);
            PG8_WAIT_V(8); PG8_WAIT_L(0); PG8_BAR; PG8_MMA(0, 0, At, B0); PG8_MMA(0, 1, At, B1); PG8_BAR; PG8_SCHED;
            PG8_LDA(At, 1, 1); PG8_STAGE(PG8_SB(1, 0), b3, voffB); PG8_STAGE(PG8_SB(1, 1), b3 + hstep, voffB); PG8_STAGE(PG8_SA(1, 0), a3, voffA);
            PG8_WAIT_V(8); PG8_WAIT_L(0); PG8_BAR; PG8_MMA(1, 0, At, B0); PG8_MMA(1, 1, At, B1); PG8_BAR; PG8_SCHED;
            } else {
            PG8_LDB(B0, 0, 0); PG8_SCHED; PG8_LDA(At, 0, 0); PG8_STAGE(PG8_SA(1, 1), a1 + hstep, voffA);
            PG8_WAIT_L(8); PG8_BAR; PG8_WAIT_L(0); PG8_MMA(0, 0, At, B0); PG8_BAR; PG8_SCHED;
            PG8_LDB(B1, 0, 1); PG8_STAGE(PG8_SB(0, 0), b2, voffB);
            PG8_BAR; PG8_WAIT_L(0); PG8_MMA(0, 1, At, B1); PG8_BAR;
            PG8_LDA(At, 0, 1); PG8_STAGE(PG8_SA(0, 0), a2, voffA);
            PG8_BAR; PG8_WAIT_L(0); PG8_MMA(1, 0, At, B0); PG8_BAR; PG8_SCHED;
            PG8_STAGE(PG8_SB(0, 1), b2 + hstep, voffB);
            PG8_WAIT_V(6); PG8_BAR; PG8_MMA(1, 1, At, B1); PG8_BAR;
            PG8_LDB(B0, 1, 0); PG8_SCHED; PG8_LDA(At, 1, 0); PG8_STAGE(PG8_SA(0, 1), a2 + hstep, voffA);
            PG8_WAIT_L(8); PG8_BAR; PG8_WAIT_L(0); PG8_MMA(0, 0, At, B0); PG8_BAR; PG8_SCHED;
            PG8_LDB(B1, 1, 1); PG8_STAGE(PG8_SB(1, 0), b3, voffB);
            PG8_BAR; PG8_WAIT_L(0); PG8_MMA(0, 1, At, B1); PG8_BAR;
            PG8_LDA(At, 1, 1); PG8_STAGE(PG8_SA(1, 0), a3, voffA);
            PG8_BAR; PG8_WAIT_L(0); PG8_MMA(1, 0, At, B0); PG8_BAR; PG8_SCHED;
            PG8_STAGE(PG8_SB(1, 1), b3 + hstep, voffB);
            PG8_WAIT_V(6); PG8_BAR; PG8_MMA(1, 1, At, B1); PG8_BAR;
            }
        }
        if constexpr (ALIGN_EPI) { if (wr == 0) PG8_BAR; }
        if constexpr (!Epi::AFTER_DRAIN) { E(acc, cur, wr, wc, fr, fq); S.done(cur); }
        if (!has_next) break;
#pragma unroll
        for (int a = 0; a < 2; ++a)
#pragma unroll
            for (int b = 0; b < 2; ++b)
#pragma unroll
                for (int m = 0; m < 4; ++m)
#pragma unroll
                    for (int n = 0; n < 2; ++n) acc[a][b][m][n] = (f32x4){0.f, 0.f, 0.f, 0.f};
        cur = nxt; cA = nA; cB = nB; ++ui;
        if constexpr (ALIGN_EPI) { if (wr == 1) PG8_BAR; }
    }
    PG8_WAIT_V(0);
    if constexpr (!ALIGN_EPI) { if (wr == 0) PG8_BAR; }
    PG8_BAR;
    if constexpr (Epi::AFTER_DRAIN) { E.fused(acc, cur, wr, wc, fr, fq, lds, wid, lane); S.done(cur); }
#undef PG8_SA
#undef PG8_SB
#undef PG8_STAGE
#undef PG8_LDA
#undef PG8_LDB
#undef PG8_MMA
#undef PG8_WAIT_V
#undef PG8_WAIT_L
#undef PG8_BAR
#undef PG8_SCHED
}
}

#define GAS __attribute__((address_space(1)))
#define LAS __attribute__((address_space(3)))
typedef unsigned short bf16;
typedef unsigned v4u __attribute__((ext_vector_type(4)));
typedef unsigned v2u __attribute__((ext_vector_type(2)));
typedef float f32x4 __attribute__((ext_vector_type(4)));
typedef float f32x16 __attribute__((ext_vector_type(16)));
typedef short bf16x8 __attribute__((ext_vector_type(8)));
typedef GAS unsigned gu32;
#define RLX_AGENT __ATOMIC_RELAXED, __HIP_MEMORY_SCOPE_AGENT
#define LDS_WAIT() asm volatile("s_waitcnt lgkmcnt(0)" ::: "memory")
#define VM_WAIT() asm volatile("s_waitcnt vmcnt(0)" ::: "memory")

constexpr int NWAVES = 8, NTHR = 512;
constexpr int BATCH = 2, SEQ = 4096, T = BATCH * SEQ, D = 2048, C = 1024, NH = 16, HD = 64;
constexpr int AH = 8, AD = 128, MB = 256, NBLK = SEQ / MB;
constexpr int NSHIFT = 3328, NIN = 6400, NZ = 6656, FF = 8192;
constexpr int ZQ = 3328, ZK = 4352, ZV = 5376, ZVD = 6400;
constexpr int DEPTH = 2;
constexpr float NORM_EPS = 1e-6f, LNX_EPS = 64e-5f;

constexpr size_t MiB = 1u << 20;
constexpr size_t WS_CTL = 0, CTL_ZERO_BYTES = 1 * MiB;
constexpr size_t WS_WIN = 1 * MiB, WS_WOUT = 27 * MiB, WS_WUP = 35 * MiB, WS_WDN = 67 * MiB;
constexpr size_t WS_VF = 99 * MiB;
constexpr size_t WS_HN = 131 * MiB;
constexpr size_t WS_YC = 163 * MiB;
constexpr size_t WS_Z = 195 * MiB;
constexpr size_t WS_XL = 299 * MiB;
constexpr size_t WS_LW = 304 * MiB;
constexpr size_t WS_ROPE = 323 * MiB;
constexpr size_t WS_SV = 325 * MiB;
constexpr size_t WS_SG = 341 * MiB;
constexpr size_t WS_AQ = 357 * MiB, WS_AK = 373 * MiB, WS_AVT = 389 * MiB;
constexpr size_t WS_KM = 405 * MiB;
constexpr size_t WS_CHUNK = 406 * MiB;
constexpr size_t WS_U = 195 * MiB;
constexpr size_t WS_Y2 = 195 * MiB;
constexpr size_t WS_M = 131 * MiB;
constexpr size_t WS_END = 502 * MiB;
constexpr int CW_BAR = 4096;

constexpr int RING_BYTES = 147456;
constexpr int LDSCTL_OFF = RING_BYTES, MISC_OFF = LDSCTL_OFF + 320;
constexpr int LDS_BYTES = RING_BYTES + 1024;
constexpr int PTAB_OFF = MISC_OFF + 128;

__device__ __forceinline__ unsigned f2bf(float f) { unsigned u = __builtin_bit_cast(unsigned, f); return (u + 0x7fffu + ((u >> 16) & 1u)) >> 16; }
__device__ __forceinline__ unsigned pk2(float lo, float hi) { return f2bf(lo) | (f2bf(hi) << 16); }
__device__ __forceinline__ float bf2f(unsigned short b) { return __builtin_bit_cast(float, (unsigned)b << 16); }
__device__ __forceinline__ float bflo(unsigned w) { return __builtin_bit_cast(float, w << 16); }
__device__ __forceinline__ float bfhi(unsigned w) { return __builtin_bit_cast(float, w & 0xffff0000u); }

#define XB_TMO      128
#define XB_XCNT(j)  (256  + 64 * (j))
#define XB_XSUB(j)  (1280 + 64 * (j))
#define XB_XGEN(j)  (2304 + 64 * (j))
#define XB_TOP      3328
#define XB_TOPGEN   3392
#define XCD_BAR_WORDS 3456
#define XB_SPIN_CAP (1u << 20)
__device__ __forceinline__ unsigned xb_ld(unsigned* p)              { return __hip_atomic_load(p, __ATOMIC_RELAXED, __HIP_MEMORY_SCOPE_AGENT); }
__device__ __forceinline__ unsigned xb_add(unsigned* p, unsigned v) { return __hip_atomic_fetch_add(p, v, __ATOMIC_RELAXED, __HIP_MEMORY_SCOPE_AGENT); }
__device__ __forceinline__ unsigned xb_xcc_id() { return (unsigned)__builtin_amdgcn_s_getreg((3 << 11) | 20) & 0xFu; }
#define XB_SPIN(cond, bar) do { unsigned _sp = 0; while (cond) { __builtin_amdgcn_s_sleep(1); \
    if ((++_sp & 255u) == 0u) { if (xb_ld(&(bar)[XB_TMO])) break; if (_sp > XB_SPIN_CAP) { atomicAdd(&(bar)[XB_TMO], 1u); break; } } } } while (0)
struct XcdBarrier { unsigned* bar; unsigned x; volatile LAS unsigned* st; };
__device__ __forceinline__ XcdBarrier xcd_barrier_post(unsigned* bar, volatile LAS unsigned* st) {
    XcdBarrier b; b.bar = bar; b.x = xb_xcc_id(); b.st = st;
    if (threadIdx.x == 0) (void)xb_add(&bar[XB_XCNT(b.x)], 1u);
    return b;
}
__device__ __forceinline__ void xcd_barrier_complete(unsigned* bar, unsigned x, unsigned& nloc, unsigned& nx) {
    const unsigned G = gridDim.x * gridDim.y * gridDim.z;
    unsigned sum, cnt, mine, sp = 0u;
    for (;;) {
        sum = 0u; cnt = 0u; mine = 0u;
#pragma unroll
        for (unsigned j = 0; j < 16; ++j) { const unsigned c = xb_ld(&bar[XB_XCNT(j)]); sum += c; cnt += (c > 0u) ? 1u : 0u; mine = (j == x) ? c : mine; }
        if (sum == G) break;
        __builtin_amdgcn_s_sleep(1);
        if ((++sp & 255u) == 0u) { if (xb_ld(&bar[XB_TMO])) break; if (sp > XB_SPIN_CAP) { atomicAdd(&bar[XB_TMO], 1u); break; } }
    }
    nloc = mine > 0u ? mine : 1u; nx = cnt > 0u ? cnt : 1u;
}
__device__ __forceinline__ void xcd_barrier(const XcdBarrier& b) {
    asm volatile("s_waitcnt vmcnt(0)" ::: "memory");
    __syncthreads();
    if (threadIdx.x == 0) {
        unsigned* bar = b.bar;
        __builtin_amdgcn_s_waitcnt(0);
        unsigned nloc = b.st[0], nx = b.st[1];
        if (nloc == 0u) { xcd_barrier_complete(bar, b.x, nloc, nx); b.st[0] = nloc; b.st[1] = nx; }
        const unsigned old = xb_add(&bar[XB_XSUB(b.x)], 1u);
        const unsigned gen = old / nloc;
        if (old + 1u == (gen + 1u) * nloc) {
            __builtin_amdgcn_fence(__ATOMIC_RELEASE, "agent");
            asm volatile("s_waitcnt vmcnt(0)" ::: "memory");
            const unsigned og = xb_add(&bar[XB_TOP], 1u);
            const unsigned tg = og / nx;
            if (og + 1u == (tg + 1u) * nx) xb_add(&bar[XB_TOPGEN], 1u);
            else XB_SPIN(xb_ld(&bar[XB_TOPGEN]) == tg, bar);
            __builtin_amdgcn_fence(__ATOMIC_ACQUIRE, "agent");
            xb_add(&bar[XB_XGEN(b.x)], 1u);
            asm volatile("s_waitcnt vmcnt(0)" ::: "memory");
        } else {
            XB_SPIN(xb_ld(&bar[XB_XGEN(b.x)]) == gen, bar);
            __builtin_amdgcn_fence(__ATOMIC_ACQUIRE, "agent");
            asm volatile("s_waitcnt vmcnt(0)" ::: "memory");
        }
    }
    __syncthreads();
}

struct Frame {
    LAS unsigned char* lds;
    volatile LAS unsigned* MISC;
    gu32* ctl;
    int tid, lane, wave, vcu, G, bx;
    float* out;
    unsigned char* ws;
};
enum { I_X = 0, I_NMIXPRE, I_NMIXPOST, I_NMLPPRE, I_NMLPPOST, I_WIN, I_WINV, I_MU, I_MUV, I_W0, I_W2, I_A0, I_A2, I_V0, I_V2, I_G2, I_KK, I_KA, I_RK, I_LNG, I_LNB, I_WOUT, I_WUP, I_WDN };

__device__ __forceinline__ const float* inp_(const Frame& F, int i) {
    const unsigned long long v = *(const LAS unsigned long long*)(F.lds + PTAB_OFF + 8 * i);
    const unsigned lo = __builtin_amdgcn_readfirstlane((unsigned)v), hi = __builtin_amdgcn_readfirstlane((unsigned)(v >> 32));
    return (const float*)(((unsigned long long)hi << 32) | lo);
}
#define INP(i) inp_(F, (i))
#define DPP_ADD(v, ctrl) ((v) + __builtin_bit_cast(float, __builtin_amdgcn_update_dpp(0, __builtin_bit_cast(int, (v)), (ctrl), 0xF, 0xF, true)))
__device__ __forceinline__ float wave_sum(float v) {
    v = DPP_ADD(v, 0xB1);
    v = DPP_ADD(v, 0x4E);
    v = DPP_ADD(v, 0x141);
    v = DPP_ADD(v, 0x140);
    const float r0 = __builtin_bit_cast(float, __builtin_amdgcn_readlane(__builtin_bit_cast(int, v), 0)), r1 = __builtin_bit_cast(float, __builtin_amdgcn_readlane(__builtin_bit_cast(int, v), 16));
    const float r2 = __builtin_bit_cast(float, __builtin_amdgcn_readlane(__builtin_bit_cast(int, v), 32)), r3 = __builtin_bit_cast(float, __builtin_amdgcn_readlane(__builtin_bit_cast(int, v), 48));
    return (r0 + r1) + (r2 + r3);
}
__device__ __forceinline__ void transpose_item(const float* W, int K, int N, bf16* WT, int row_off, LAS float* scr, int item, int lane) {
    const int nblk = N / 32, kb = item / nblk, nb = item % nblk, k0 = 64 * kb, n0 = 32 * nb;
#pragma unroll 8
    for (int i = 0; i < 32; ++i) { const int kk = 2 * i + (lane >> 5); scr[kk * 33 + (lane & 31)] = W[(size_t)(k0 + kk) * N + n0 + (lane & 31)]; }
    LDS_WAIT(); asm volatile("" ::: "memory");
    const int c = lane & 7;
#pragma unroll
    for (int j = 0; j < 4; ++j) { const int n = (lane >> 3) + 8 * j; const LAS float* s = scr + (8 * c) * 33 + n;
        v4u o; o.x = pk2(s[0 * 33], s[1 * 33]); o.y = pk2(s[2 * 33], s[3 * 33]); o.z = pk2(s[4 * 33], s[5 * 33]); o.w = pk2(s[6 * 33], s[7 * 33]);
        *(GAS v4u*)(WT + (size_t)(row_off + n0 + n) * K + k0 + 8 * c) = o; }
    LDS_WAIT(); asm volatile("" ::: "memory");
}
__device__ __forceinline__ void rmsnorm_row_to_bf16(const float* xrow, const float* gain, bf16* orow, int lane) {
    const GAS f32x4* xr = (const GAS f32x4*)xrow + lane; const GAS f32x4* gr = (const GAS f32x4*)gain + lane;
    f32x4 v[8]; float s = 0.f;
#pragma unroll
    for (int j = 0; j < 8; ++j) { v[j] = xr[64 * j]; s += (v[j].x * v[j].x + v[j].y * v[j].y) + (v[j].z * v[j].z + v[j].w * v[j].w); }
    const float rs = 1.0f / sqrtf(wave_sum(s) * (1.f / D) + NORM_EPS);
    GAS v2u* o8 = (GAS v2u*)orow + lane;
#pragma unroll
    for (int j = 0; j < 8; ++j) { const f32x4 g = gr[64 * j]; v2u w; w.x = pk2(v[j].x * rs * g.x, v[j].y * rs * g.y); w.y = pk2(v[j].z * rs * g.z, v[j].w * rs * g.w); o8[64 * j] = w; }
}
__device__ __forceinline__ void ph_convert(Frame& F, int L) {
    LAS float* scr = (LAS float*)(F.lds + F.wave * 16384);
    const int gw = F.vcu * NWAVES + F.wave, NGW = F.G * NWAVES;
    bf16* WinT = (bf16*)(F.ws + WS_WIN); bf16* WoutT = (bf16*)(F.ws + WS_WOUT); bf16* WupT = (bf16*)(F.ws + WS_WUP); bf16* WdnT = (bf16*)(F.ws + WS_WDN);
    constexpr int I_IN = (D / 64) * (NIN / 32), I_VR = (D / 64), I_OUT = (D / 64) * (D / 32), I_UP = (D / 64) * (FF / 32), I_DN = (FF / 64) * (D / 32);
    const int nvr = (L > 0) ? I_VR : 0;
    const int NITEMS = I_IN + nvr + I_OUT + I_UP + I_DN;
    for (int it = gw; it < NITEMS; it += NGW) {
        int r = it;
        if (r < I_IN) { transpose_item(INP(I_WIN) + (size_t)L * D * NIN, D, NIN, WinT, 0, scr, r, F.lane); continue; } r -= I_IN;
        if (r < nvr) { transpose_item(INP(I_WINV) + (size_t)(L - 1) * D * 32, D, 32, WinT, NIN, scr, r, F.lane); continue; } r -= nvr;
        if (r < I_OUT) { transpose_item(INP(I_WOUT) + (size_t)L * D * D, D, D, WoutT, 0, scr, r, F.lane); continue; } r -= I_OUT;
        if (r < I_UP) { transpose_item(INP(I_WUP) + (size_t)L * D * FF, D, FF, WupT, 0, scr, r, F.lane); continue; } r -= I_UP;
        transpose_item(INP(I_WDN) + (size_t)L * FF * D, FF, D, WdnT, 0, scr, r, F.lane);
    }
    if (L > 0) {
        const int gt = F.vcu * NTHR + F.tid, NGT = F.G * NTHR;
        for (int i = gt; i < (NZ - NIN - 32) * (D / 8); i += NGT) *(GAS v4u*)(WinT + (size_t)(NIN + 32) * D + (size_t)i * 8) = (v4u){0u, 0u, 0u, 0u};
    }
    {
        bf16* W2T = (bf16*)(F.ws + WS_LW); bf16* A2T = W2T + C * 64; bf16* G2T = A2T + C * 64; bf16* V2T = G2T + C * 128;
        for (int it = gw; it < 32 + 32 + 64; it += NGW) {
            if (it < 32) transpose_item(INP(I_W2) + (size_t)L * 64 * C, 64, C, W2T, 0, scr, it, F.lane);
            else if (it < 64) transpose_item(INP(I_A2) + (size_t)L * 64 * C, 64, C, A2T, 0, scr, it - 32, F.lane);
            else transpose_item(INP(I_G2) + (size_t)L * 128 * C, 128, C, G2T, 0, scr, it - 64, F.lane);
        }
        const int gt = F.vcu * NTHR + F.tid, NGT = F.G * NTHR;
        if (L > 0) { const float* v2 = INP(I_V2) + (size_t)(L - 1) * 32 * C; for (int i = gt; i < 32 * C; i += NGT) { const int cch = i >> 5, k = i & 31; V2T[i] = (bf16)f2bf(v2[(size_t)k * C + cch]); } }
        if (L == 0) { float* RC = (float*)(F.ws + WS_ROPE); float* RS = RC + SEQ * 64;
            for (int i = gt; i < SEQ * 64; i += NGT) { const int pos = i >> 6, d = i & 63; const float inv_freq = exp2f(-(float)d * (13.287712379549449f / 64.0f)); float sn, cs; sincosf((float)pos * inv_freq, &sn, &cs); RC[i] = cs; RS[i] = sn; } }
    }
    if (L == 0) {
        bf16* HN = (bf16*)(F.ws + WS_HN);
        for (int m = gw; m < T; m += NGW) rmsnorm_row_to_bf16(INP(I_X) + (size_t)m * D, INP(I_NMIXPRE), HN + (size_t)m * D, F.lane);
    }
}
__device__ __forceinline__ void ph_resnorm(Frame& F, const float* y, const float* xin, const float* gA, const float* gB, float* xout, bf16* hn) {
    const int gw = F.vcu * NWAVES + F.wave, NGW = F.G * NWAVES;
    for (int m = gw; m < T; m += NGW) {
        const GAS f32x4* yr = (const GAS f32x4*)(y + (size_t)m * D) + F.lane; const GAS f32x4* xr = (const GAS f32x4*)(xin + (size_t)m * D) + F.lane;
        const GAS f32x4* ga = (const GAS f32x4*)gA + F.lane;
        f32x4 v[8]; float s = 0.f;
#pragma unroll
        for (int j = 0; j < 8; ++j) { v[j] = yr[64 * j]; s += (v[j].x * v[j].x + v[j].y * v[j].y) + (v[j].z * v[j].z + v[j].w * v[j].w); }
        const float rs = 1.0f / sqrtf(wave_sum(s) * (1.f / D) + NORM_EPS);
        float s2 = 0.f;
        GAS f32x4* xo = (GAS f32x4*)(xout + (size_t)m * D) + F.lane;
#pragma unroll
        for (int j = 0; j < 8; ++j) { const f32x4 g = ga[64 * j]; const f32x4 x = xr[64 * j];
            v[j].x = x.x + v[j].x * rs * g.x; v[j].y = x.y + v[j].y * rs * g.y; v[j].z = x.z + v[j].z * rs * g.z; v[j].w = x.w + v[j].w * rs * g.w;
            xo[64 * j] = v[j]; s2 += (v[j].x * v[j].x + v[j].y * v[j].y) + (v[j].z * v[j].z + v[j].w * v[j].w); }
        if (gB) {
            const float rs2 = 1.0f / sqrtf(wave_sum(s2) * (1.f / D) + NORM_EPS);
            const GAS f32x4* gb = (const GAS f32x4*)gB + F.lane; GAS v2u* o8 = (GAS v2u*)(hn + (size_t)m * D) + F.lane;
#pragma unroll
            for (int j = 0; j < 8; ++j) { const f32x4 g = gb[64 * j]; v2u w; w.x = pk2(v[j].x * rs2 * g.x, v[j].y * rs2 * g.y); w.y = pk2(v[j].z * rs2 * g.z, v[j].w * rs2 * g.w); o8[64 * j] = w; }
        }
    }
}
__device__ __forceinline__ float sigmoidf_(float x) { return 1.0f / (1.0f + __expf(-x)); }
__device__ __forceinline__ float softplusf_(float x) { return fmaxf(x, 0.f) + log1pf(__expf(-fabsf(x))); }

__device__ __forceinline__ void prep_xl_items(Frame& F, int L) {
    const bf16* Z = (const bf16*)(F.ws + WS_Z); bf16* XL = (bf16*)(F.ws + WS_XL);
    const float* mu = INP(I_MU) + (size_t)L * NSHIFT; const float* muv = INP(I_MUV) + (size_t)(L > 0 ? L - 1 : 0) * 32;
    const int gt = F.vcu * NTHR + F.tid, NGT = F.G * NTHR;
    for (int it = gt; it < T * 36; it += NGT) {
        const int t = it / 36, j8 = it - t * 36, s = t & (SEQ - 1);
        v4u o = (v4u){0u, 0u, 0u, 0u};
        if (j8 < 32 || L > 0) {
            const int col = (j8 < 32) ? (3072 + 8 * j8) : (ZVD + 8 * (j8 - 32));
            const float* mup = (j8 < 32) ? (mu + col) : (muv + 8 * (j8 - 32));
            const v4u zc = *(const GAS v4u*)(Z + (size_t)t * NZ + col);
            v4u zp = (v4u){0u, 0u, 0u, 0u}; if (s) zp = *(const GAS v4u*)(Z + (size_t)(t - 1) * NZ + col);
            const f32x4 m0 = *(const GAS f32x4*)mup, m1 = *(const GAS f32x4*)(mup + 4);
            float f[8];
#pragma unroll
            for (int q = 0; q < 4; ++q) { const float c0 = bflo(zc[q]), c1 = bfhi(zc[q]), p0 = bflo(zp[q]), p1 = bfhi(zp[q]);
                const float ma = (q < 2) ? m0[2 * q] : m1[2 * q - 4], mb = (q < 2) ? m0[2 * q + 1] : m1[2 * q - 3];
                f[2 * q] = c0 + (p0 - c0) * ma; f[2 * q + 1] = c1 + (p1 - c1) * mb; }
            if (j8 < 8) {
#pragma unroll
                for (int q = 0; q < 8; ++q) f[q] = tanhf(f[q]);
            } else if (j8 >= 16 && j8 < 32) {
#pragma unroll
                for (int q = 0; q < 8; ++q) f[q] = sigmoidf_(f[q]);
            }
            o = (v4u){pk2(f[0], f[1]), pk2(f[2], f[3]), pk2(f[4], f[5]), pk2(f[6], f[7])};
        }
        *(GAS v4u*)(XL + (size_t)t * 288 + 8 * j8) = o;
    }
}
constexpr float QSC = 0.08838834764831845f * 1.4426950408889634f;
__device__ __forceinline__ void prep_attn_unit(Frame& F, int u) {
    const bf16* Z = (const bf16*)(F.ws + WS_Z);
    bf16* AQ = (bf16*)(F.ws + WS_AQ); bf16* AKp = (bf16*)(F.ws + WS_AK); float* KM = (float*)(F.ws + WS_KM);
    const float* RC = (const float*)(F.ws + WS_ROPE); const float* RS = RC + SEQ * 64;
    const int b = u / (NBLK * AH), rem = u % (NBLK * AH), blk = rem / AH, h = rem % AH;
    const int tid = F.tid, d = 8 * (tid & 7), tg = tid >> 3;
    const int tb = b * SEQ + blk * MB;
    LAS float* red = (LAS float*)F.lds;
    __syncthreads();
    float ks[16];
#pragma unroll
    for (int q = 0; q < 16; ++q) ks[q] = 0.f;
#pragma unroll
    for (int i = 0; i < 4; ++i) {
        const int tok = tg + 64 * i; const int pos = blk * MB + tok; const size_t t = (size_t)(tb + tok);
        const f32x4 c0 = *(const GAS f32x4*)(RC + pos * 64 + d), c1 = *(const GAS f32x4*)(RC + pos * 64 + d + 4);
        const f32x4 s0 = *(const GAS f32x4*)(RS + pos * 64 + d), s1 = *(const GAS f32x4*)(RS + pos * 64 + d + 4);
        const v4u ql = *(const GAS v4u*)(Z + t * NZ + ZQ + h * AD + d), qh = *(const GAS v4u*)(Z + t * NZ + ZQ + h * AD + 64 + d);
        const v4u kl = *(const GAS v4u*)(Z + t * NZ + ZK + h * AD + d), kh = *(const GAS v4u*)(Z + t * NZ + ZK + h * AD + 64 + d);
        float qlo[8], qhi[8], klo[8], khi[8];
#pragma unroll
        for (int q = 0; q < 4; ++q) { qlo[2 * q] = bflo(ql[q]); qlo[2 * q + 1] = bfhi(ql[q]); qhi[2 * q] = bflo(qh[q]); qhi[2 * q + 1] = bfhi(qh[q]);
            klo[2 * q] = bflo(kl[q]); klo[2 * q + 1] = bfhi(kl[q]); khi[2 * q] = bflo(kh[q]); khi[2 * q + 1] = bfhi(kh[q]); }
        float oq1[8], oq2[8], ok1[8], ok2[8];
#pragma unroll
        for (int q = 0; q < 8; ++q) { const float cs = (q < 4) ? c0[q] : c1[q - 4], sn = (q < 4) ? s0[q] : s1[q - 4];
            oq1[q] = (qlo[q] * cs - qhi[q] * sn) * QSC; oq2[q] = (qhi[q] * cs + qlo[q] * sn) * QSC; ok1[q] = klo[q] * cs - khi[q] * sn; ok2[q] = khi[q] * cs + klo[q] * sn;
            ks[q] += ok1[q]; ks[8 + q] += ok2[q]; }
        *(GAS v4u*)(AQ + t * C + h * AD + d) = (v4u){pk2(oq1[0], oq1[1]), pk2(oq1[2], oq1[3]), pk2(oq1[4], oq1[5]), pk2(oq1[6], oq1[7])};
        *(GAS v4u*)(AQ + t * C + h * AD + 64 + d) = (v4u){pk2(oq2[0], oq2[1]), pk2(oq2[2], oq2[3]), pk2(oq2[4], oq2[5]), pk2(oq2[6], oq2[7])};
        *(GAS v4u*)(AKp + t * C + h * AD + d) = (v4u){pk2(ok1[0], ok1[1]), pk2(ok1[2], ok1[3]), pk2(ok1[4], ok1[5]), pk2(ok1[6], ok1[7])};
        *(GAS v4u*)(AKp + t * C + h * AD + 64 + d) = (v4u){pk2(ok2[0], ok2[1]), pk2(ok2[2], ok2[3]), pk2(ok2[4], ok2[5]), pk2(ok2[6], ok2[7])};
    }
    *(LAS f32x4*)(red + tg * 128 + d) = (f32x4){ks[0], ks[1], ks[2], ks[3]}; *(LAS f32x4*)(red + tg * 128 + d + 4) = (f32x4){ks[4], ks[5], ks[6], ks[7]};
    *(LAS f32x4*)(red + tg * 128 + 64 + d) = (f32x4){ks[8], ks[9], ks[10], ks[11]}; *(LAS f32x4*)(red + tg * 128 + 64 + d + 4) = (f32x4){ks[12], ks[13], ks[14], ks[15]};
    __syncthreads();
    if (tid < 128) { float s = 0.f;
#pragma unroll 8
        for (int w = 0; w < 64; ++w) s += red[w * 128 + tid];
        KM[((size_t)(b * AH + h) * NBLK + blk) * AD + tid] = s * (1.0f / MB); }
}
__device__ __forceinline__ void ph_prep(Frame& F, int L) {
    prep_xl_items(F, L);
    for (int u = F.vcu; u < BATCH * NBLK * AH; u += F.G) prep_attn_unit(F, u);
}

typedef short bf16x4 __attribute__((ext_vector_type(4)));
constexpr int NCHK = SEQ / 64;
constexpr int NUNIT = BATCH * NH * NCHK;
constexpr int CP = 144, MATB = 64 * CP;
constexpr int L_ARA = 0, L_ARR = MATB, L_BKB = 2 * MATB, L_BKK = 3 * MATB, L_AT = 4 * MATB, L_BT = 5 * MATB, L_KT = 6 * MATB, L_VT = 7 * MATB;
constexpr int L_AAB = 8 * MATB, L_AAK = 9 * MATB, L_ARB = 10 * MATB, L_ARK = 11 * MATB, L_ND = 12 * MATB, L_TB = L_ND + 4096;
constexpr int XLP = 592;
constexpr int L_XL = 8 * MATB, L_LW = L_XL + 64 * XLP, L_LA = L_LW + 16384, L_LV = L_LA + 8192, L_SEG = L_LV + 8192, L_GL = L_SEG + 2048;
static_assert(L_TB + 2048 <= L_SEG && L_GL + 256 <= RING_BYTES, "wkv LDS map");
constexpr int L_W2T = L_ARA, L_PT = L_BKB, L_QT = L_BKK;
constexpr size_t WS_CM = WS_CHUNK, WS_CG = WS_CM + (size_t)NUNIT * 8192, WS_CRY = WS_CG + (size_t)NUNIT * 16384, WS_CYC = WS_CRY + (size_t)NUNIT * 8192;
static_assert(WS_CYC + (size_t)NUNIT * 16384 <= WS_END, "chunk outputs");
constexpr size_t WS_CS = WS_HN;
constexpr size_t WS_BON = WS_HN + (size_t)NUNIT * 8192;
static_assert(WS_BON + (size_t)T * NH * 4 <= WS_YC, "HN region");

__device__ __forceinline__ f32x4 mfma32(bf16x8 a, bf16x8 b, f32x4 c) { return __builtin_amdgcn_mfma_f32_16x16x32_bf16(a, b, c, 0, 0, 0); }
__device__ __forceinline__ f32x4 mfma16(bf16x4 a, bf16x4 b, f32x4 c) { return __builtin_amdgcn_mfma_f32_16x16x16bf16_1k(a, b, c, 0, 0, 0); }
__device__ __forceinline__ v2u pk4(f32x4 v) { v2u w; w.x = pk2(v[0], v[1]); w.y = pk2(v[2], v[3]); return w; }

__device__ __forceinline__ void wkv_r1_unit(Frame& F, int L, int unit) {
    const int c = unit % NCHK, bh = unit / NCHK, h = bh % NH, b = bh / NH;
    const int tid = F.tid, lane = F.lane, w = F.wave, fr = lane & 15, g = lane >> 4;
    LAS unsigned char* lds = F.lds;
    const bf16* Z = (const bf16*)(F.ws + WS_Z);
    const size_t tok0 = (size_t)b * SEQ + (size_t)c * 64;
    __syncthreads();
    { const bf16* XLg = (const bf16*)(F.ws + WS_XL) + tok0 * 288;
      for (int idx = tid; idx < 64 * 36; idx += NTHR) { const int row = idx / 36, ch = idx - row * 36;
          *(LAS v4u*)(lds + L_XL + row * XLP + ch * 16) = *(const GAS v4u*)(XLg + row * 288 + ch * 8); } }
    __syncthreads();
    {
        const int nt = w & 3, mt0 = 2 * (w >> 2), cl = 16 * nt + fr, ch = h * HD + cl;
        const bf16* W2T = (const bf16*)(F.ws + WS_LW); const bf16* A2T = W2T + C * 64; const bf16* G2T = A2T + C * 64; const bf16* V2T = G2T + C * 128;
        bf16* SG = (bf16*)(F.ws + WS_SG);
        const float w0c = INP(I_W0)[(size_t)L * C + ch], a0c = INP(I_A0)[(size_t)L * C + ch];
        const LAS unsigned char* xa0 = lds + L_XL + (16 * mt0 + fr) * XLP + g * 16; const LAS unsigned char* xa1 = xa0 + 16 * XLP;
        {
            const bf16x8 b0 = *(const GAS bf16x8*)(W2T + (size_t)ch * 64 + 8 * g), b1 = *(const GAS bf16x8*)(W2T + (size_t)ch * 64 + 32 + 8 * g);
            f32x4 c0 = (f32x4){0.f, 0.f, 0.f, 0.f}, c1 = c0;
            c0 = mfma32(*(const LAS bf16x8*)(xa0), b0, c0); c0 = mfma32(*(const LAS bf16x8*)(xa0 + 64), b1, c0);
            c1 = mfma32(*(const LAS bf16x8*)(xa1), b0, c1); c1 = mfma32(*(const LAS bf16x8*)(xa1 + 64), b1, c1);
#pragma unroll
            for (int i = 0; i < 4; ++i) { const float wl0 = -softplusf_(-(c0[i] + w0c)) - 0.5f, wl1 = -softplusf_(-(c1[i] + w0c)) - 0.5f;
                ((LAS float*)(lds + L_LW))[(16 * mt0 + 4 * g + i) * 64 + cl] = -__expf(wl0); ((LAS float*)(lds + L_LW))[(16 * mt0 + 16 + 4 * g + i) * 64 + cl] = -__expf(wl1); }
        }
        {
            const bf16x8 b0 = *(const GAS bf16x8*)(A2T + (size_t)ch * 64 + 8 * g), b1 = *(const GAS bf16x8*)(A2T + (size_t)ch * 64 + 32 + 8 * g);
            f32x4 c0 = (f32x4){0.f, 0.f, 0.f, 0.f}, c1 = c0;
            c0 = mfma32(*(const LAS bf16x8*)(xa0 + 128), b0, c0); c0 = mfma32(*(const LAS bf16x8*)(xa0 + 192), b1, c0);
            c1 = mfma32(*(const LAS bf16x8*)(xa1 + 128), b0, c1); c1 = mfma32(*(const LAS bf16x8*)(xa1 + 192), b1, c1);
#pragma unroll
            for (int i = 0; i < 4; ++i) { ((LAS unsigned short*)(lds + L_LA))[(16 * mt0 + 4 * g + i) * 64 + cl] = (unsigned short)f2bf(sigmoidf_(c0[i] + a0c));
                ((LAS unsigned short*)(lds + L_LA))[(16 * mt0 + 16 + 4 * g + i) * 64 + cl] = (unsigned short)f2bf(sigmoidf_(c1[i] + a0c)); }
        }
        {
            f32x4 c0 = (f32x4){0.f, 0.f, 0.f, 0.f}, c1 = c0;
#pragma unroll
            for (int ks = 0; ks < 4; ++ks) { const bf16x8 bb = *(const GAS bf16x8*)(G2T + (size_t)ch * 128 + 32 * ks + 8 * g);
                c0 = mfma32(*(const LAS bf16x8*)(xa0 + 256 + 64 * ks), bb, c0); c1 = mfma32(*(const LAS bf16x8*)(xa1 + 256 + 64 * ks), bb, c1); }
#pragma unroll
            for (int i = 0; i < 4; ++i) { SG[(tok0 + 16 * mt0 + 4 * g + i) * C + ch] = (bf16)f2bf(c0[i]); SG[(tok0 + 16 * mt0 + 16 + 4 * g + i) * C + ch] = (bf16)f2bf(c1[i]); }
        }
        if (L > 0) {
            const float v0c = INP(I_V0)[(size_t)(L - 1) * C + ch];
            const bf16x8 b0 = *(const GAS bf16x8*)(V2T + (size_t)ch * 32 + 8 * g);
            f32x4 c0 = (f32x4){0.f, 0.f, 0.f, 0.f}, c1 = c0;
            c0 = mfma32(*(const LAS bf16x8*)(xa0 + 512), b0, c0); c1 = mfma32(*(const LAS bf16x8*)(xa1 + 512), b0, c1);
#pragma unroll
            for (int i = 0; i < 4; ++i) { ((LAS unsigned short*)(lds + L_LV))[(16 * mt0 + 4 * g + i) * 64 + cl] = (unsigned short)f2bf(sigmoidf_(c0[i] + v0c));
                ((LAS unsigned short*)(lds + L_LV))[(16 * mt0 + 16 + 4 * g + i) * 64 + cl] = (unsigned short)f2bf(sigmoidf_(c1[i] + v0c)); }
        }
    }
    __syncthreads();
    {
        const int sg = w, j = lane, ch = h * HD + j;
        const float* mu = INP(I_MU) + (size_t)L * NSHIFT;
        const float mur = mu[ch], muk = mu[C + ch], muv = mu[2 * C + ch];
        const float kkc = INP(I_KK)[(size_t)L * C + ch], kac = INP(I_KA)[(size_t)L * C + ch], rkj = INP(I_RK)[(size_t)L * C + ch];
        float* VF = (float*)(F.ws + WS_VF); bf16* SVg = (bf16*)(F.ws + WS_SV);
        const size_t tokA = tok0 + 8 * sg;
        float zpr = 0.f, zpk = 0.f, zpv = 0.f;
        if (c != 0 || sg != 0) { const bf16* zp = Z + (tokA - 1) * NZ; zpr = bf2f(zp[ch]); zpk = bf2f(zp[C + ch]); zpv = bf2f(zp[2 * C + ch]); }
        float lw[8], cum[8], rf[8], kf[8], kkf[8], af[8]; unsigned vb[8];
#pragma unroll
        for (int e = 0; e < 8; ++e) {
            const bf16* zc = Z + (tokA + e) * NZ; const int t = 8 * sg + e;
            const float zr = bf2f(zc[ch]), zk = bf2f(zc[C + ch]), zv = bf2f(zc[2 * C + ch]);
            const float r = zr + (zpr - zr) * mur, k = zk + (zpk - zk) * muk; float v = zv + (zpv - zv) * muv;
            zpr = zr; zpk = zk; zpv = zv;
            lw[e] = ((const LAS float*)(lds + L_LW))[t * 64 + j];
            const float a = bf2f(((const LAS unsigned short*)(lds + L_LA))[t * 64 + j]);
            const size_t o = (tokA + e) * C + ch;
            if (L == 0) VF[o] = v; else { const float sv = bf2f(((const LAS unsigned short*)(lds + L_LV))[t * 64 + j]); v = v + (VF[o] - v) * sv; }
            vb[e] = f2bf(v); SVg[o] = (bf16)vb[e];
            float kk = k * kkc; const float ss = wave_sum(kk * kk); kk = kk / fmaxf(sqrtf(ss), 1e-12f);
            rf[e] = r; kf[e] = k * (1.f + (a - 1.f) * kac); kkf[e] = kk; af[e] = a;
        }
        float run = 0.f;
#pragma unroll
        for (int e = 0; e < 8; ++e) { run += lw[e]; cum[e] = run; }
        LAS float* seg = (LAS float*)(lds + L_SEG);
        seg[sg * 64 + j] = run;
        __syncthreads();
        float off = 0.f, tot = 0.f;
#pragma unroll
        for (int s2 = 0; s2 < 8; ++s2) { const float v = seg[s2 * 64 + j]; tot += v; off += (s2 < sg) ? v : 0.f; }
        if (sg == 0) ((LAS float*)(lds + L_GL))[j] = __expf(tot);
        unsigned at8[4], bt8[4], kt8[4], vt8[4];
        float* BON = (float*)(F.ws + WS_BON);
#pragma unroll
        for (int e = 0; e < 8; ++e) {
            const float cu = cum[e] + off, ce = cu - lw[e];
            const float eC = __expf(cu), eE = __expf(ce), eN = __expf(-cu);
            const unsigned At = f2bf(-kkf[e] * eE), Rt = f2bf(rf[e] * eC), Bt = f2bf(kkf[e] * af[e] * eN), Kt = f2bf(kf[e] * eN);
            const int t = 8 * sg + e;
            *(LAS unsigned short*)(lds + L_ARA + t * CP + j * 2) = (unsigned short)At;
            *(LAS unsigned short*)(lds + L_ARR + t * CP + j * 2) = (unsigned short)Rt;
            *(LAS unsigned short*)(lds + L_BKB + t * CP + j * 2) = (unsigned short)Bt;
            *(LAS unsigned short*)(lds + L_BKK + t * CP + j * 2) = (unsigned short)Kt;
            if (e & 1) { at8[e >> 1] |= At << 16; bt8[e >> 1] |= Bt << 16; kt8[e >> 1] |= Kt << 16; vt8[e >> 1] |= vb[e] << 16; }
            else { at8[e >> 1] = At; bt8[e >> 1] = Bt; kt8[e >> 1] = Kt; vt8[e >> 1] = vb[e]; }
            const float bs = wave_sum(rf[e] * kf[e] * rkj);
            if (j == 0) BON[(tok0 + t) * NH + h] = bs;
        }
        *(LAS v4u*)(lds + L_AT + j * CP + sg * 16) = (v4u){at8[0], at8[1], at8[2], at8[3]};
        *(LAS v4u*)(lds + L_BT + j * CP + sg * 16) = (v4u){bt8[0], bt8[1], bt8[2], bt8[3]};
        *(LAS v4u*)(lds + L_KT + j * CP + sg * 16) = (v4u){kt8[0], kt8[1], kt8[2], kt8[3]};
        *(LAS v4u*)(lds + L_VT + j * CP + sg * 16) = (v4u){vt8[0], vt8[1], vt8[2], vt8[3]};
    }
    __syncthreads();
    {
        const int tq = w & 3; const bool isA = w < 4;
        const LAS unsigned char* Bsrc = lds + (isA ? L_ARA : L_ARR) + (16 * tq + fr) * CP + g * 16;
        const bf16x8 b0 = *(const LAS bf16x8*)Bsrc, b1 = *(const LAS bf16x8*)(Bsrc + 64);
        const int t = 16 * tq + fr;
#pragma unroll
        for (int mt = 0; mt < 8; ++mt) {
            const int sq = mt & 3; const bool isB = mt < 4;
            f32x4 acc = (f32x4){0.f, 0.f, 0.f, 0.f};
            if (sq <= tq) {
                const LAS unsigned char* Asrc = lds + (isB ? L_BKB : L_BKK) + (16 * sq + fr) * CP + g * 16;
                acc = mfma32(*(const LAS bf16x8*)Asrc, b0, acc);
                acc = mfma32(*(const LAS bf16x8*)(Asrc + 64), b1, acc);
            }
            const int s0 = 16 * sq + 4 * g;
#pragma unroll
            for (int i = 0; i < 4; ++i) { const bool keep = isA ? (s0 + i < t) : (s0 + i <= t); acc[i] = keep ? acc[i] : 0.f; }
            const int dst = isB ? (isA ? L_AAB : L_ARB) : (isA ? L_AAK : L_ARK);
            *(LAS v2u*)(lds + dst + t * CP + s0 * 2) = pk4(acc);
            if (isA && isB && sq == tq) *(LAS f32x4*)(lds + L_ND + tq * 1024 + fr * 64 + g * 16) = acc;
        }
    }
    __syncthreads();
    if (w == 0) {
        const int bi = lane >> 4, cc = lane & 15;
        const LAS float* Nb = (const LAS float*)(lds + L_ND + bi * 1024);
        float x[16];
#pragma unroll
        for (int r = 0; r < 16; ++r) {
            float acc = (r == cc) ? 1.f : 0.f;
#pragma unroll
            for (int kq = 0; kq < (r + 3) / 4; ++kq) { const f32x4 n4 = *(const LAS f32x4*)(Nb + r * 16 + 4 * kq);
#pragma unroll
                for (int z = 0; z < 4; ++z) if (4 * kq + z < r) acc += n4[z] * x[4 * kq + z]; }
            x[r] = acc;
            *(LAS unsigned short*)(lds + L_TB + bi * 512 + r * 32 + cc * 2) = (unsigned short)f2bf(acc);
        }
    } else {
        for (int ti = w - 1; ti < 16; ti += 7) {
            const int mt = ti >> 2, nt = ti & 3;
            const LAS unsigned char* Asrc = lds + L_AAK + (16 * mt + fr) * CP + g * 16;
            const LAS unsigned char* Bsrc = lds + L_VT + (16 * nt + fr) * CP + g * 16;
            f32x4 acc = (f32x4){0.f, 0.f, 0.f, 0.f};
            acc = mfma32(*(const LAS bf16x8*)Asrc, *(const LAS bf16x8*)Bsrc, acc);
            acc = mfma32(*(const LAS bf16x8*)(Asrc + 64), *(const LAS bf16x8*)(Bsrc + 64), acc);
            *(LAS v2u*)(lds + L_W2T + (16 * nt + fr) * CP + (16 * mt + 4 * g) * 2) = pk4(acc);
        }
    }
    __syncthreads();
    {
        const LAS unsigned char* rhs = lds + (w < 4 ? L_AT : L_W2T) + (16 * (w & 3) + fr) * CP;
        LAS unsigned char* xout = lds + (w < 4 ? L_PT : L_QT) + (16 * (w & 3) + fr) * CP;
        bf16x4 X[4];
#pragma unroll
        for (int bq = 0; bq < 4; ++bq) {
            const v2u rv = *(const LAS v2u*)(rhs + (16 * bq + 4 * g) * 2);
            f32x4 y = (f32x4){bflo(rv.x), bfhi(rv.x), bflo(rv.y), bfhi(rv.y)};
#pragma unroll
            for (int kb = 0; kb < bq; ++kb) {
                const bf16x4 nf = *(const LAS bf16x4*)(lds + L_AAB + (16 * bq + fr) * CP + (16 * kb + 4 * g) * 2);
                y = mfma16(nf, X[kb], y);
            }
            const v2u yb = pk4(y);
            const bf16x4 tf = *(const LAS bf16x4*)(lds + L_TB + bq * 512 + fr * 32 + g * 8);
            const f32x4 xr = mfma16(tf, __builtin_bit_cast(bf16x4, yb), (f32x4){0.f, 0.f, 0.f, 0.f});
            const v2u xb = pk4(xr);
            X[bq] = __builtin_bit_cast(bf16x4, xb);
            *(LAS v2u*)(xout + (16 * bq + 4 * g) * 2) = xb;
        }
    }
    __syncthreads();
    {
        const int nt = w & 3;
        const LAS float* GL = (const LAS float*)(lds + L_GL);
        if (w < 4) {
            const LAS unsigned char* Bb = lds + L_BT + (16 * nt + fr) * CP + g * 16;
            const bf16x8 bb0 = *(const LAS bf16x8*)Bb, bb1 = *(const LAS bf16x8*)(Bb + 64);
            const LAS unsigned char* Bq = lds + L_QT + (16 * nt + fr) * CP + g * 16;
            const bf16x8 bq0 = *(const LAS bf16x8*)Bq, bq1 = *(const LAS bf16x8*)(Bq + 64);
            const LAS unsigned char* Bv = lds + L_VT + (16 * nt + fr) * CP + g * 16;
            const bf16x8 bv0 = *(const LAS bf16x8*)Bv, bv1 = *(const LAS bf16x8*)(Bv + 64);
            const int jn = 16 * nt + fr; const float glj = GL[jn];
            bf16* Mg = (bf16*)(F.ws + WS_CM) + (size_t)unit * 4096;
            float* Gg = (float*)(F.ws + WS_CG) + (size_t)unit * 4096;
#pragma unroll
            for (int mt = 0; mt < 4; ++mt) {
                const LAS unsigned char* Ap = lds + L_PT + (16 * mt + fr) * CP + g * 16;
                f32x4 acc = (f32x4){0.f, 0.f, 0.f, 0.f};
                acc = mfma32(*(const LAS bf16x8*)Ap, bb0, acc); acc = mfma32(*(const LAS bf16x8*)(Ap + 64), bb1, acc);
#pragma unroll
                for (int i = 0; i < 4; ++i) acc[i] = glj * (acc[i] + ((16 * mt + 4 * g + i == jn) ? 1.f : 0.f));
                *(GAS v2u*)(Mg + jn * 64 + 16 * mt + 4 * g) = pk4(acc);
                const LAS unsigned char* Ab = lds + L_BT + (16 * mt + fr) * CP + g * 16;
                const LAS unsigned char* Ak = lds + L_KT + (16 * mt + fr) * CP + g * 16;
                f32x4 ga = (f32x4){0.f, 0.f, 0.f, 0.f};
                ga = mfma32(*(const LAS bf16x8*)Ab, bq0, ga); ga = mfma32(*(const LAS bf16x8*)(Ab + 64), bq1, ga);
                ga = mfma32(*(const LAS bf16x8*)Ak, bv0, ga); ga = mfma32(*(const LAS bf16x8*)(Ak + 64), bv1, ga);
                const f32x4 gl4 = *(const LAS f32x4*)(GL + 16 * mt + 4 * g);
                ga = ga * gl4;
                *(GAS f32x4*)(Gg + ((nt * 4 + mt) * 64 + lane) * 4) = ga;
            }
        } else {
            const LAS unsigned char* Bb = lds + L_ARB + (16 * nt + fr) * CP + g * 16;
            const bf16x8 bb0 = *(const LAS bf16x8*)Bb, bb1 = *(const LAS bf16x8*)(Bb + 64);
            const LAS unsigned char* Bk = lds + L_ARK + (16 * nt + fr) * CP + g * 16;
            const bf16x8 bk0 = *(const LAS bf16x8*)Bk, bk1 = *(const LAS bf16x8*)(Bk + 64);
            const int tn = 16 * nt + fr;
            bf16* Ryg = (bf16*)(F.ws + WS_CRY) + (size_t)unit * 4096;
            float* Ycg = (float*)(F.ws + WS_CYC) + (size_t)unit * 4096;
#pragma unroll
            for (int mt = 0; mt < 4; ++mt) {
                const LAS unsigned char* Ap = lds + L_PT + (16 * mt + fr) * CP + g * 16;
                const v2u rv = *(const LAS v2u*)(lds + L_ARR + tn * CP + (16 * mt + 4 * g) * 2);
                f32x4 acc = (f32x4){bflo(rv.x), bfhi(rv.x), bflo(rv.y), bfhi(rv.y)};
                acc = mfma32(*(const LAS bf16x8*)Ap, bb0, acc); acc = mfma32(*(const LAS bf16x8*)(Ap + 64), bb1, acc);
                *(GAS v2u*)(Ryg + tn * 64 + 16 * mt + 4 * g) = pk4(acc);
                const LAS unsigned char* Aq = lds + L_QT + (16 * mt + fr) * CP + g * 16;
                const LAS unsigned char* Av = lds + L_VT + (16 * mt + fr) * CP + g * 16;
                f32x4 ya = (f32x4){0.f, 0.f, 0.f, 0.f};
                ya = mfma32(*(const LAS bf16x8*)Aq, bb0, ya); ya = mfma32(*(const LAS bf16x8*)(Aq + 64), bb1, ya);
                ya = mfma32(*(const LAS bf16x8*)Av, bk0, ya); ya = mfma32(*(const LAS bf16x8*)(Av + 64), bk1, ya);
                *(GAS f32x4*)(Ycg + ((mt * 4 + nt) * 64 + lane) * 4) = ya;
            }
        }
    }
}
constexpr int R2_SLOT = 9216 + 16384;
__device__ __forceinline__ void wkv_r2_head(Frame& F, int bh) {
    const int tid = F.tid, lane = F.lane, w = F.wave, fr = lane & 15, g = lane >> 4, nt = w;
    LAS unsigned char* lds = F.lds;
    const bf16* Mg = (const bf16*)(F.ws + WS_CM) + (size_t)bh * NCHK * 4096;
    const float* Gg = (const float*)(F.ws + WS_CG) + (size_t)bh * NCHK * 4096;
    bf16* Sg = (bf16*)(F.ws + WS_CS) + (size_t)bh * NCHK * 4096;
    f32x4 S[4];
#pragma unroll
    for (int mt = 0; mt < 4; ++mt) S[mt] = (f32x4){0.f, 0.f, 0.f, 0.f};
    v4u rm[4], rg0[4], rg1[4];
#define R2_GLOAD(k, cidx) do { if ((cidx) < NCHK) { rm[k] = *(const GAS v4u*)(Mg + (size_t)(cidx) * 4096 + tid * 8); \
        rg0[k] = *(const GAS v4u*)(Gg + (size_t)(cidx) * 4096 + tid * 4); rg1[k] = *(const GAS v4u*)(Gg + (size_t)(cidx) * 4096 + (tid + NTHR) * 4); } } while (0)
#define R2_LSTORE(k, slot) do { LAS unsigned char* sp_ = lds + (slot) * R2_SLOT; *(LAS v4u*)(sp_ + (tid >> 3) * CP + (tid & 7) * 16) = rm[k]; \
        *(LAS v4u*)(sp_ + 9216 + tid * 16) = rg0[k]; *(LAS v4u*)(sp_ + 9216 + (tid + NTHR) * 16) = rg1[k]; } while (0)
    __syncthreads();
    R2_GLOAD(0, 0); R2_LSTORE(0, 0);
    R2_GLOAD(0, 1); R2_GLOAD(1, 2); R2_GLOAD(2, 3); R2_GLOAD(3, 4);
    __syncthreads();
#define R2_STEP(k, c) do { \
        R2_LSTORE(k, ((c) + 1) & 1); R2_GLOAD(k, (c) + 5); \
        if (w < 4) { const LAS unsigned char* sp_ = lds + ((c) & 1) * R2_SLOT; \
            v2u sb[4]; \
            _Pragma("unroll") for (int mt = 0; mt < 4; ++mt) { sb[mt] = pk4(S[mt]); *(GAS v2u*)(Sg + (size_t)(c) * 4096 + (16 * nt + fr) * 64 + 16 * mt + 4 * g) = sb[mt]; } \
            const bf16x8 bf0 = __builtin_bit_cast(bf16x8, (v4u){sb[0].x, sb[0].y, sb[1].x, sb[1].y}); \
            const bf16x8 bf1 = __builtin_bit_cast(bf16x8, (v4u){sb[2].x, sb[2].y, sb[3].x, sb[3].y}); \
            _Pragma("unroll") for (int mt = 0; mt < 4; ++mt) { \
                const LAS unsigned char* mp = sp_ + (16 * mt + fr) * CP + g * 8; \
                const v2u a00 = *(const LAS v2u*)mp, a01 = *(const LAS v2u*)(mp + 32), a10 = *(const LAS v2u*)(mp + 64), a11 = *(const LAS v2u*)(mp + 96); \
                f32x4 acc = *(const LAS f32x4*)(sp_ + 9216 + ((nt * 4 + mt) * 64 + lane) * 16); \
                acc = mfma32(__builtin_bit_cast(bf16x8, (v4u){a00.x, a00.y, a01.x, a01.y}), bf0, acc); \
                acc = mfma32(__builtin_bit_cast(bf16x8, (v4u){a10.x, a10.y, a11.x, a11.y}), bf1, acc); \
                S[mt] = acc; } } \
        __syncthreads(); } while (0)
    for (int c = 0; c < NCHK; c += 4) { R2_STEP(0, c); R2_STEP(1, c + 1); R2_STEP(2, c + 2); R2_STEP(3, c + 3); }
#undef R2_GLOAD
#undef R2_LSTORE
#undef R2_STEP
}
__device__ __forceinline__ void wkv_r3_wave(Frame& F, int L, int unit) {
    const int c = unit % NCHK, bh = unit / NCHK, h = bh % NH, b = bh / NH;
    const int lane = F.lane, fr = lane & 15, g = lane >> 4;
    const bf16* Sg = (const bf16*)(F.ws + WS_CS) + (size_t)unit * 4096;
    const bf16* Ryg = (const bf16*)(F.ws + WS_CRY) + (size_t)unit * 4096;
    const float* Ycg = (const float*)(F.ws + WS_CYC) + (size_t)unit * 4096;
    const bf16* SV = (const bf16*)(F.ws + WS_SV); const bf16* SG = (const bf16*)(F.ws + WS_SG); const float* BON = (const float*)(F.ws + WS_BON);
    bf16* YC = (bf16*)(F.ws + WS_YC);
    const float* lg = INP(I_LNG) + (size_t)L * C + h * HD; const float* lb = INP(I_LNB) + (size_t)L * C + h * HD;
    const size_t tok0 = (size_t)b * SEQ + (size_t)c * 64;
    bf16x8 sa[4][2];
#pragma unroll
    for (int mt = 0; mt < 4; ++mt)
#pragma unroll
        for (int ks = 0; ks < 2; ++ks) sa[mt][ks] = *(const GAS bf16x8*)(Sg + (16 * mt + fr) * 64 + 32 * ks + 8 * g);
    f32x4 lgv[4], lbv[4];
#pragma unroll
    for (int mt = 0; mt < 4; ++mt) { lgv[mt] = *(const GAS f32x4*)(lg + 16 * mt + 4 * g); lbv[mt] = *(const GAS f32x4*)(lb + 16 * mt + 4 * g); }
#pragma unroll
    for (int nt = 0; nt < 4; ++nt) {
        const int t = 16 * nt + fr;
        const bf16x8 rb0 = *(const GAS bf16x8*)(Ryg + t * 64 + 8 * g), rb1 = *(const GAS bf16x8*)(Ryg + t * 64 + 32 + 8 * g);
        f32x4 y[4]; float s = 0.f;
#pragma unroll
        for (int mt = 0; mt < 4; ++mt) {
            f32x4 acc = *(const GAS f32x4*)(Ycg + ((mt * 4 + nt) * 64 + lane) * 4);
            acc = mfma32(sa[mt][0], rb0, acc); acc = mfma32(sa[mt][1], rb1, acc);
            y[mt] = acc; s += (acc[0] + acc[1]) + (acc[2] + acc[3]);
        }
        s += __shfl_xor(s, 16); s += __shfl_xor(s, 32);
        const float mean = s * (1.f / HD); float q = 0.f;
#pragma unroll
        for (int mt = 0; mt < 4; ++mt) { y[mt] = y[mt] - mean; q += (y[mt][0] * y[mt][0] + y[mt][1] * y[mt][1]) + (y[mt][2] * y[mt][2] + y[mt][3] * y[mt][3]); }
        q += __shfl_xor(q, 16); q += __shfl_xor(q, 32);
        const float rstd = 1.0f / sqrtf(q * (1.f / HD) + LNX_EPS);
        const float bon = BON[(tok0 + t) * NH + h];
#pragma unroll
        for (int mt = 0; mt < 4; ++mt) {
            const size_t o = (tok0 + t) * C + h * HD + 16 * mt + 4 * g;
            const v2u vv = *(const GAS v2u*)(SV + o), gg = *(const GAS v2u*)(SG + o);
            f32x4 r;
            r[0] = (y[mt][0] * rstd * lgv[mt][0] + lbv[mt][0] + bon * bflo(vv.x)) * bflo(gg.x);
            r[1] = (y[mt][1] * rstd * lgv[mt][1] + lbv[mt][1] + bon * bfhi(vv.x)) * bfhi(gg.x);
            r[2] = (y[mt][2] * rstd * lgv[mt][2] + lbv[mt][2] + bon * bflo(vv.y)) * bflo(gg.y);
            r[3] = (y[mt][3] * rstd * lgv[mt][3] + lbv[mt][3] + bon * bfhi(vv.y)) * bfhi(gg.y);
            *(GAS v2u*)(YC + (tok0 + t) * D + h * HD + 16 * mt + 4 * g) = pk4(r);
        }
    }
}

__device__ __forceinline__ int crow(int r, int hi) { return (r & 3) + 8 * (r >> 2) + 4 * hi; }
typedef short s16x4 __attribute__((ext_vector_type(4)));
typedef float f32x2_t __attribute__((ext_vector_type(2))); typedef __bf16 bf16x2_t __attribute__((ext_vector_type(2)));
__device__ __forceinline__ unsigned cvtpk(float lo, float hi) { f32x2_t v = {lo, hi}; bf16x2_t b = __builtin_convertvector(v, bf16x2_t); return __builtin_bit_cast(unsigned, b); }
__device__ __forceinline__ s16x4 vtr(const LAS unsigned char* p) { return __builtin_bit_cast(s16x4, __builtin_amdgcn_ds_read_tr16_b64_v4i16((LAS s16x4*)p)); }
constexpr float ATT_THR = 6.0f;
constexpr int A_KB = 0, A_VB = 65536, A_KM = 131072;
__device__ __forceinline__ void attn2_unit(Frame& F, int b, int h, int qb, int half) {
    const bf16* AQ = (const bf16*)(F.ws + WS_AQ); const bf16* AKp = (const bf16*)(F.ws + WS_AK); const bf16* Z = (const bf16*)(F.ws + WS_Z); const float* KM = (const float*)(F.ws + WS_KM);
    bf16* YC = (bf16*)(F.ws + WS_YC);
    const int tid = F.tid, lane = F.lane, w = F.wave, qg = w & 3, kvh = w >> 2, r32 = lane & 31, hi = lane >> 5;
    LAS unsigned char* lds = F.lds;
    const size_t tb = (size_t)b * SEQ; const int q0w = qb * MB + 128 * half + 32 * qg;
    __syncthreads();
    for (int i = tid; i < NBLK * AD; i += NTHR) { const float v = KM[(size_t)(b * AH + h) * NBLK * AD + i]; const unsigned hb = f2bf(v); const float rem = v - __builtin_bit_cast(float, hb << 16);
        ((LAS unsigned short*)(lds + A_KM))[i] = (unsigned short)hb; ((LAS unsigned short*)(lds + A_KM + 4096))[i] = (unsigned short)f2bf(rem); }
    bf16x8 qr[8];
    { const bf16* Qp = AQ + (tb + q0w + r32) * C + h * AD + hi * 8;
#pragma unroll
      for (int d0 = 0; d0 < 8; ++d0) qr[d0] = *(const GAS bf16x8*)(Qp + d0 * 16); }
    const int n_own = half ? 2 : 1, NS = n_own + 2 * qb;
    const bf16* Kg = AKp + tb * C + h * AD; const bf16* Vg = Z + tb * NZ + ZV + h * AD;
#define STEP_KB(si) (((si) < n_own) ? (qb * MB + 128 * (si)) : ((((si) - n_own) >> 1) * MB + 128 * (((si) - n_own) & 1)))
    const int dl_r = lane >> 4, dl_cs = lane & 15;
#define ATT_LOAD(si, bi) do { const int kb_ = STEP_KB(si); _Pragma("unroll") for (int i_ = 0; i_ < 4; ++i_) { const int pi_ = w + 8 * i_; const int row_ = 4 * pi_ + dl_r; \
        __builtin_amdgcn_global_load_lds((const GAS unsigned*)(Kg + (size_t)(kb_ + row_) * C + ((dl_cs ^ (row_ & 15)) << 3)), (LAS unsigned*)(lds + A_KB + (bi) * 32768 + pi_ * 1024), 16, 0, 0); \
        __builtin_amdgcn_global_load_lds((const GAS unsigned*)(Vg + (size_t)(kb_ + row_) * NZ + ((dl_cs ^ ((row_ & 3) << 2)) << 3)), (LAS unsigned*)(lds + A_VB + (bi) * 32768 + pi_ * 1024), 16, 0, 0); } } while (0)
    ATT_LOAD(0, 0);
    __syncthreads();
    unsigned selmask;
    {
        f32x16 ga = (f32x16){0.f};
        const bool rowok = r32 < 16;
#pragma unroll
        for (int d0 = 0; d0 < 8; ++d0) {
            const LAS unsigned char* kp = lds + A_KM + (r32 & 15) * 256 + d0 * 32 + hi * 16;
            bf16x8 ah = *(const LAS bf16x8*)kp, al = *(const LAS bf16x8*)(kp + 4096);
            if (!rowok) { ah = (bf16x8){0, 0, 0, 0, 0, 0, 0, 0}; al = ah; }
            ga = __builtin_amdgcn_mfma_f32_32x32x16_bf16(ah, qr[d0], ga, 0, 0, 0);
            ga = __builtin_amdgcn_mfma_f32_32x32x16_bf16(al, qr[d0], ga, 0, 0, 0);
        }
        float gt[16];
#pragma unroll
        for (int r = 0; r < 4; ++r) { const float o0 = __shfl_xor(ga[r], 32), o1 = __shfl_xor(ga[4 + r], 32);
            gt[r] = hi ? o0 : ga[r]; gt[4 + r] = hi ? ga[r] : o0; gt[8 + r] = hi ? o1 : ga[4 + r]; gt[12 + r] = hi ? ga[4 + r] : o1; }
        float g1 = -INFINITY, g2 = -INFINITY, g3 = -INFINITY; int i1 = 0, i2 = 0, i3 = 0;
#pragma unroll
        for (int n = 0; n < 16; ++n) { if (n < qb) { const float g = gt[n];
            if (g > g1) { g3 = g2; i3 = i2; g2 = g1; i2 = i1; g1 = g; i1 = n; }
            else if (g > g2) { g3 = g2; i3 = i2; g2 = g; i2 = n; }
            else if (g > g3) { g3 = g; i3 = n; } } }
        selmask = (qb <= 3) ? ((1u << qb) - 1u) : ((1u << i1) | (1u << i2) | (1u << i3));
    }
    f32x16 O[4];
#pragma unroll
    for (int dt = 0; dt < 4; ++dt) O[dt] = (f32x16){0.f};
    float m_run = -1e30f, l_run = 0.f;
    VM_WAIT();
    __syncthreads();
    const int qpos = q0w + r32;
    const int trq = (lane & 15) >> 2, trp = lane & 3, trg = (lane >> 4) & 1;
    for (int si = 0; si < NS; ++si) {
        if (si + 1 < NS) ATT_LOAD(si + 1, (si + 1) & 1);
        const bool own = si < n_own;
        const int kt = STEP_KB(si) + 64 * kvh;
        const bool skip = own && (kt > q0w + 31);
        if (!skip) {
            const LAS unsigned char* kb_ = lds + A_KB + (si & 1) * 32768 + (64 * kvh) * 256;
            const LAS unsigned char* vb_ = lds + A_VB + (si & 1) * 32768 + (64 * kvh) * 256;
            f32x16 p[2];
#pragma unroll
            for (int kb2 = 0; kb2 < 2; ++kb2) {
                f32x16 acc = (f32x16){0.f};
                const int row = 32 * kb2 + r32;
#pragma unroll
                for (int d0 = 0; d0 < 8; ++d0) {
                    const bf16x8 kf = *(const LAS bf16x8*)(kb_ + row * 256 + (((2 * d0 + hi) ^ (row & 15)) << 4));
                    acc = __builtin_amdgcn_mfma_f32_32x32x16_bf16(kf, qr[d0], acc, 0, 0, 0);
                }
                p[kb2] = acc;
            }
            if (own && (kt + 63 > q0w)) {
#pragma unroll
                for (int kb2 = 0; kb2 < 2; ++kb2)
#pragma unroll
                    for (int r = 0; r < 16; ++r) { const int kpos = kt + 32 * kb2 + crow(r, hi); p[kb2][r] = (kpos <= qpos) ? p[kb2][r] : -1e30f; }
            }
            const bool ok = own || ((selmask >> ((si - n_own) >> 1)) & 1u);
            float mx = fmaxf(p[0][0], p[1][0]);
#pragma unroll
            for (int r = 1; r < 16; ++r) mx = fmaxf(mx, fmaxf(p[0][r], p[1][r]));
            mx = fmaxf(mx, __shfl_xor(mx, 32));
            mx = ok ? mx : -1e30f;
            if (__any(mx > m_run + ATT_THR)) {
                const float m_new = fmaxf(m_run, mx); const float alpha = __builtin_amdgcn_exp2f(m_run - m_new);
                m_run = m_new; l_run *= alpha;
#pragma unroll
                for (int dt = 0; dt < 4; ++dt)
#pragma unroll
                    for (int r = 0; r < 16; ++r) O[dt][r] *= alpha;
            }
            float ls = 0.f;
#pragma unroll
            for (int kb2 = 0; kb2 < 2; ++kb2)
#pragma unroll
                for (int r = 0; r < 16; ++r) { const float e = __builtin_amdgcn_exp2f(p[kb2][r] - m_run); p[kb2][r] = e; ls += e; }
            l_run += ok ? ls : 0.f;
            const unsigned okm = ok ? 0xffffffffu : 0u;
#pragma unroll
            for (int kb2 = 0; kb2 < 2; ++kb2)
#pragma unroll
                for (int s = 0; s < 2; ++s) {
                    v4u pw; pw.x = cvtpk(p[kb2][8 * s + 0], p[kb2][8 * s + 1]) & okm; pw.y = cvtpk(p[kb2][8 * s + 2], p[kb2][8 * s + 3]) & okm;
                    pw.z = cvtpk(p[kb2][8 * s + 4], p[kb2][8 * s + 5]) & okm; pw.w = cvtpk(p[kb2][8 * s + 6], p[kb2][8 * s + 7]) & okm;
                    const bf16x8 pf = __builtin_bit_cast(bf16x8, pw);
                    const int key0 = 32 * kb2 + 16 * s + 4 * hi + trq;
#pragma unroll
                    for (int dt = 0; dt < 4; ++dt) {
                        const int dby = (32 * dt + 16 * trg + 4 * trp) * 2;
                        const s16x4 lo = vtr(vb_ + key0 * 256 + (dby ^ ((key0 & 3) << 6)));
                        const s16x4 hi4 = vtr(vb_ + (key0 + 8) * 256 + (dby ^ (((key0 + 8) & 3) << 6)));
                        const bf16x8 vf = (bf16x8){lo[0], lo[1], lo[2], lo[3], hi4[0], hi4[1], hi4[2], hi4[3]};
                        O[dt] = __builtin_amdgcn_mfma_f32_32x32x16_bf16(vf, pf, O[dt], 0, 0, 0);
                    }
                }
        }
        VM_WAIT();
        __syncthreads();
    }
    LAS float* cb = (LAS float*)lds + (size_t)qg * 64 * 67;
    if (kvh == 1) {
        LAS float* cp = cb + lane * 67;
        cp[64] = m_run; cp[65] = l_run;
#pragma unroll
        for (int dt = 0; dt < 4; ++dt)
#pragma unroll
            for (int r = 0; r < 16; ++r) cp[dt * 16 + r] = O[dt][r];
    }
    __syncthreads();
    if (kvh == 0) {
        const LAS float* cp = cb + lane * 67;
        const float m1 = cp[64], l1 = cp[65];
        const float m = fmaxf(m_run, m1); const float a0 = __builtin_amdgcn_exp2f(m_run - m), a1 = __builtin_amdgcn_exp2f(m1 - m);
        float l = l_run * a0 + l1 * a1; l += __shfl_xor(l, 32);
        const float inv = 1.0f / l;
#pragma unroll
        for (int dt = 0; dt < 4; ++dt)
#pragma unroll
            for (int r = 0; r < 16; ++r) O[dt][r] = (O[dt][r] * a0 + cp[dt * 16 + r] * a1) * inv;
    }
    __syncthreads();
    if (kvh == 0) {
        LAS unsigned char* st = lds + 69632 + qg * (32 * 272);
#pragma unroll
        for (int dt = 0; dt < 4; ++dt)
#pragma unroll
            for (int rq = 0; rq < 4; ++rq) { v2u wv; wv.x = cvtpk(O[dt][4 * rq], O[dt][4 * rq + 1]); wv.y = cvtpk(O[dt][4 * rq + 2], O[dt][4 * rq + 3]);
                *(LAS v2u*)(st + r32 * 272 + (32 * dt + 8 * rq + 4 * hi) * 2) = wv; }
        LDS_WAIT(); asm volatile("" ::: "memory");
#pragma unroll
        for (int i = 0; i < 8; ++i) { const int row = i * 4 + (lane >> 4), ch = lane & 15;
            const v4u v = *(const LAS v4u*)(st + row * 272 + ch * 16);
            *(GAS v4u*)(YC + (tb + q0w + row) * D + C + h * AD + ch * 8) = v; }
    }
#undef STEP_KB
#undef ATT_LOAD
}
__device__ __forceinline__ void ph_wkv_r1(Frame& F, int L) { const int upc = (NUNIT + F.G - 1) / F.G; for (int k = 0; k < upc; ++k) { const int u = F.vcu * upc + k; if (u < NUNIT) wkv_r1_unit(F, L, u); } }
__device__ __forceinline__ void ph_wkv_r2(Frame& F) { for (int bh = F.vcu; bh < BATCH * NH; bh += F.G) wkv_r2_head(F, bh); }
__device__ __forceinline__ void ph_mixer(Frame& F, int L) {
    for (int u = F.vcu * NWAVES + F.wave; u < NUNIT; u += F.G * NWAVES) wkv_r3_wave(F, L, u);
    for (int it = F.vcu; it < BATCH * AH * NBLK; it += F.G) { const int bh = it >> 4, rem = it & 15, qlo = rem >> 1, hf = rem & 1;
        for (int k = 0; k < 2; ++k) attn2_unit(F, bh / AH, bh % AH, k ? qlo : NBLK - 1 - qlo, k ? hf : 1 - hf); }
}

constexpr int PH_PER_LAYER = 11, NPHASE = DEPTH * PH_PER_LAYER;
#ifndef MK_N_LAUNCHES
#define MK_N_LAUNCHES 1
#endif
struct Args { const float* in[24]; float* out; unsigned char* ws; int ph_lo, ph_hi, li, pad; };
__global__ void __launch_bounds__(NTHR, 2) mega_fwd(Args args) {
    extern __shared__ __attribute__((aligned(16))) unsigned char lds[];
    Frame F;
    F.lds = (LAS unsigned char*)lds;
    F.MISC = (volatile LAS unsigned*)(F.lds + MISC_OFF);
    F.tid = threadIdx.x; F.lane = F.tid & 63; F.wave = __builtin_amdgcn_readfirstlane(F.tid >> 6);
    F.G = gridDim.x; { const int bx = blockIdx.x; F.vcu = (F.G % 8 == 0) ? (bx % 8) * (F.G / 8) + bx / 8 : bx; }
    F.ws = args.ws; F.out = args.out; F.ctl = (gu32*)(args.ws + WS_CTL);
    for (int u = F.tid; u < (LDS_BYTES - LDSCTL_OFF) / 4; u += NTHR) ((LAS unsigned*)(F.lds + LDSCTL_OFF))[u] = 0u;
    __syncthreads();
    if (F.tid < 24) *(LAS unsigned long long*)(F.lds + PTAB_OFF + 8 * F.tid) = (unsigned long long)args.in[F.tid];
    __syncthreads();
    XcdBarrier bar; bar.bar = (unsigned*)(F.ctl + CW_BAR) + args.li * XCD_BAR_WORDS; bar.x = 0; bar.st = nullptr;
    const bool one_launch = (args.ph_hi - args.ph_lo) > 1;
    if (one_launch) bar = xcd_barrier_post((unsigned*)(F.ctl + CW_BAR) + args.li * XCD_BAR_WORDS, F.MISC + 8);
    bf16* HN = (bf16*)(F.ws + WS_HN); bf16* YC = (bf16*)(F.ws + WS_YC); bf16* Zb = (bf16*)(F.ws + WS_Z); bf16* U = (bf16*)(F.ws + WS_U);
    float* Y2 = (float*)(F.ws + WS_Y2); float* Mo = (float*)(F.ws + WS_M);
#ifdef PROBE_DUP_MASK
    bool dup_done = false;
#endif
    for (int ph = args.ph_lo; ph < args.ph_hi; ++ph) {
        const int L = ph / PH_PER_LAYER, p = ph % PH_PER_LAYER;
        { int t_ = threadIdx.x; asm volatile("" : "+v"(t_)); F.tid = t_; F.lane = t_ & 63; F.wave = __builtin_amdgcn_readfirstlane(t_ >> 6); }
        { unsigned long long w_ = (unsigned long long)args.ws, o_ = (unsigned long long)args.out; asm volatile("" : "+s"(w_), "+s"(o_)); F.ws = (unsigned char*)w_; F.out = (float*)o_; F.ctl = (gu32*)w_; }
        { int g_ = gridDim.x, b_ = blockIdx.x; asm volatile("" : "+s"(g_), "+s"(b_)); F.G = g_; F.bx = b_; F.vcu = (g_ % 8 == 0) ? (b_ % 8) * (g_ / 8) + b_ / 8 : b_; }
        { unsigned l_ = (unsigned)(unsigned long long)(LAS unsigned char*)lds; asm volatile("" : "+s"(l_)); F.lds = (LAS unsigned char*)(unsigned long long)l_; }
        switch (p) {
        case 0: ph_convert(F, L); break;
        case 1: { pg8::Gemm g{HN, (const bf16*)(F.ws + WS_WIN), T, (L == 0) ? NIN : NZ, D}; pg8::StaticOrder S; S.init(T, (L == 0) ? NIN : NZ, F.G, F.bx);
                  pg8::EpiBf16<0> E{Zb, NZ}; pg8::gemm_phase<pg8::EpiBf16<0>, pg8::StaticOrder, true, true>(F.lds, g, S, E, F.tid); } break;
        case 2: ph_prep(F, L); break;
        case 3: ph_wkv_r1(F, L); break;
        case 4: ph_wkv_r2(F); break;
        case 5: ph_mixer(F, L); break;
        case 6: { pg8::Gemm g{YC, (const bf16*)(F.ws + WS_WOUT), T, D, D}; pg8::StaticOrder S; S.init(T, D, F.G, F.bx);
                  pg8::EpiF32 E{Y2, D}; pg8::gemm_phase<pg8::EpiF32, pg8::StaticOrder, true, true>(F.lds, g, S, E, F.tid); } break;
        case 7: ph_resnorm(F, Y2, (L == 0) ? INP(I_X) : F.out, INP(I_NMIXPOST) + (size_t)L * D, INP(I_NMLPPRE) + (size_t)L * D, F.out, HN); break;
        case 8: { pg8::Gemm g{HN, (const bf16*)(F.ws + WS_WUP), T, FF, D}; pg8::StaticOrder S; S.init(T, FF, F.G, F.bx);
                  pg8::EpiBf16<2> E{U, FF}; pg8::gemm_phase<pg8::EpiBf16<2>, pg8::StaticOrder, true, true>(F.lds, g, S, E, F.tid); } break;
        case 9: { pg8::Gemm g{U, (const bf16*)(F.ws + WS_WDN), T, D, FF}; pg8::StaticOrder S; S.init(T, D, F.G, F.bx);
                  pg8::EpiF32 E{Mo, D}; pg8::gemm_phase<pg8::EpiF32, pg8::StaticOrder, true, true>(F.lds, g, S, E, F.tid); } break;
        case 10: ph_resnorm(F, Mo, F.out, INP(I_NMLPPOST) + (size_t)L * D, (L + 1 < DEPTH) ? INP(I_NMIXPRE) + (size_t)(L + 1) * D : nullptr, F.out, HN); break;
        }
        if (ph + 1 < args.ph_hi) xcd_barrier(bar);
#ifdef PROBE_DUP_MASK
        if (((PROBE_DUP_MASK >> p) & 1) && !dup_done) { dup_done = true; --ph; } else dup_done = false;
#endif
    }
}

extern "C" void kernel_launch(void* const* d_in, const int* in_sizes, int n_in, void* d_out, int out_size, void* d_ws, size_t ws_size, hipStream_t stream) {
    static int grid = 0;
    if (grid == 0) {
        if (n_in != 24 || in_sizes[0] != T * D || out_size != T * D || ws_size < WS_END) { fprintf(stderr, "kernel_launch: unexpected shapes (n_in %d, in0 %d, out %d, ws %zu)\n", n_in, n_in > 0 ? in_sizes[0] : -1, out_size, ws_size); grid = -1; return; }
        int dev = 0, cus = 0, per_cu = 0;
        if (hipGetDevice(&dev) != hipSuccess || hipDeviceGetAttribute(&cus, hipDeviceAttributeMultiprocessorCount, dev) != hipSuccess) { grid = -1; return; }
        if (hipFuncSetAttribute((const void*)mega_fwd, hipFuncAttributeMaxDynamicSharedMemorySize, LDS_BYTES) != hipSuccess) { fprintf(stderr, "kernel_launch: hipFuncSetAttribute failed\n"); grid = -1; return; }
        if (hipOccupancyMaxActiveBlocksPerMultiprocessor(&per_cu, (const void*)mega_fwd, NTHR, LDS_BYTES) != hipSuccess || per_cu < 1) { fprintf(stderr, "kernel_launch: occupancy query says %d\n", per_cu); per_cu = 1; }
        (void)hipGetLastError();
        grid = cus * (per_cu > 1 ? 1 : per_cu);
    }
    if (grid < 0) return;
    (void)hipMemsetAsync((char*)d_ws + WS_CTL, 0, CTL_ZERO_BYTES, stream);
    Args a{};
    for (int i = 0; i < 24; ++i) a.in[i] = (const float*)d_in[i];
    a.out = (float*)d_out; a.ws = (unsigned char*)d_ws;
    const int nl = MK_N_LAUNCHES;
    for (int li = 0; li < nl; ++li) {
        a.li = li; a.ph_lo = (int)((long)NPHASE * li / nl); a.ph_hi = (int)((long)NPHASE * (li + 1) / nl);
        if (a.ph_hi - a.ph_lo > 1) {
            void* kargs[] = {&a};
            hipError_t e = hipLaunchCooperativeKernel((const void*)mega_fwd, dim3(grid), dim3(NTHR), kargs, LDS_BYTES, stream);
            if (e != hipSuccess) fprintf(stderr, "kernel_launch: cooperative launch failed: %s (grid %d)\n", hipGetErrorString(e), grid);
        } else {
            hipLaunchKernelGGL(mega_fwd, dim3(grid), dim3(NTHR), LDS_BYTES, stream, a);
        }
    }
}
```

```cpp
#include <hip/hip_runtime.h>
#include <cstdio>
#include <cstdint>
namespace pg8 {
#define PG8_LAS __attribute__((address_space(3)))
typedef unsigned short bf16_t;
typedef short bf16x8 __attribute__((ext_vector_type(8)));
typedef float f32x4 __attribute__((ext_vector_type(4)));
typedef unsigned u32x4 __attribute__((ext_vector_type(4)));
constexpr int BM = 256, BK = 64, HALF = 128, HTB = HALF * BK * 2  , STAGE_BYTES = 8 * HTB, NXCD = 8, WGM = 8;

__host__ __device__ __forceinline__ int lds_byte(int r, int c) { const int st = (r >> 4) * 2 + (c >> 5), rr = r & 15, cc = c & 31, ob = rr * 64 + cc * 2; return st * 1024 + (ob ^ (((ob >> 9) & 1) << 5)); }
__host__ __device__ __forceinline__ void stage_rc(int b, int& R, int& C) { const int st = b / 1024, sb = b % 1024, swz = sb ^ (((sb >> 9) & 1) << 5); R = (st >> 1) * 16 + swz / 64; C = (st & 1) * 32 + (swz % 64) / 2; }
__host__ __device__ __forceinline__ int perm32(int rho) { const int n = rho >> 4, i = rho & 15; return 8 * (i >> 2) + 4 * n + (i & 3); }

struct Unit { int pm, pn; };
struct Gemm { const bf16_t* A; const bf16_t* Bt; int M, N, K; };

struct StaticOrder {
    int nM, nN, nwg, G, c;
    __host__ __device__ void init(int M, int N, int G_, int c_) { nM = M / BM; nN = N / BM; nwg = nM * nN; G = G_; c = c_; }
    __host__ __device__ bool next(int i, Unit& u) const {
        const long L = (long)i * G + c; if (L >= nwg) return false;
        int wgid = (int)L; { const int q = nwg / NXCD, r = nwg % NXCD, xcd = wgid % NXCD, off = wgid / NXCD; wgid = (xcd < r ? xcd * (q + 1) : r * (q + 1) + (xcd - r) * q) + off; }
        const int nig = WGM * nN, gid = wgid / nig, fm = gid * WGM, gsz = (nM - fm) < WGM ? (nM - fm) : WGM;
        u.pm = fm + ((wgid % nig) % gsz); u.pn = (wgid % nig) / gsz; return true;
    }
    __device__ __forceinline__ void a_ready(const Unit&) const {}
    __device__ __forceinline__ void done(const Unit&) const {}
};

__device__ __forceinline__ unsigned cvt_pk_bf16(float lo, float hi) { unsigned r; asm volatile("v_cvt_pk_bf16_f32 %0, %1, %2" : "=v"(r) : "v"(lo), "v"(hi)); return r; }
struct EpiF32 {
    static constexpr bool PERM = false, AFTER_DRAIN = false;
    float* C; int ldc;
    __device__ __forceinline__ void operator()(const f32x4 (&acc)[2][2][4][2], const Unit& u, int wr, int wc, int fr, int fq) const {
        const int row0 = u.pm * BM + wr * 64 + fr, col0 = u.pn * BM + wc * 32 + 4 * fq;
#pragma unroll
        for (int ai = 0; ai < 2; ++ai)
#pragma unroll
            for (int m = 0; m < 4; ++m) { float* rowp = C + (size_t)(row0 + ai * HALF + m * 16) * ldc + col0;
#pragma unroll
                for (int bj = 0; bj < 2; ++bj)
#pragma unroll
                    for (int n = 0; n < 2; ++n) *(f32x4*)(rowp + bj * HALF + n * 16) = acc[ai][bj][m][n]; }
    }
};
template <int ACT  > struct EpiBf16 {
    static constexpr bool PERM = true, AFTER_DRAIN = false;
    bf16_t* O; int ldc;
    __device__ __forceinline__ void operator()(const f32x4 (&acc)[2][2][4][2], const Unit& u, int wr, int wc, int fr, int fq) const {
        const int row0 = u.pm * BM + wr * 64 + fr; const int col0 = u.pn * BM + wc * 32 + 8 * fq;
#pragma unroll
        for (int ai = 0; ai < 2; ++ai)
#pragma unroll
            for (int m = 0; m < 4; ++m) { bf16_t* rowp = O + (size_t)(row0 + ai * HALF + m * 16) * ldc + col0;
#pragma unroll
                for (int bj = 0; bj < 2; ++bj) { f32x4 v0 = acc[ai][bj][m][0], v1 = acc[ai][bj][m][1];
                    if (ACT == 2) {
#pragma unroll
                        for (int e = 0; e < 4; ++e) { float a = v0[e] > 0.f ? v0[e] : 0.f; v0[e] = a * a; float b = v1[e] > 0.f ? v1[e] : 0.f; v1[e] = b * b; } }
                    u32x4 w; w.x = cvt_pk_bf16(v0[0], v0[1]); w.y = cvt_pk_bf16(v0[2], v0[3]); w.z = cvt_pk_bf16(v1[0], v1[1]); w.w = cvt_pk_bf16(v1[2], v1[3]);
                    *(u32x4*)(rowp + bj * HALF) = w; } }
    }
};

template <class Epi, class Sched, bool ALIGN_EPI = false, bool SP2 = false>
__device__ __forceinline__ void gemm_phase(PG8_LAS unsigned char* lds, const Gemm g, const Sched& S, const Epi& E, const int tid) {
    const int wid = __builtin_amdgcn_readfirstlane(tid >> 6), lane = tid & 63, wr = wid >> 2, wc = wid & 3, fr = lane & 15, fq = lane >> 4;
    const int K = g.K, nt = K / BK;
    unsigned voffA[2], voffB[2];
#pragma unroll
    for (int i = 0; i < 2; ++i) { int R, C; stage_rc(tid * 16 + i * 8192, R, C); const int Rb = Epi::PERM ? ((R & ~31) + perm32(R & 31)) : R;
        voffA[i] = (unsigned)(R * K + C) * 2u; voffB[i] = (unsigned)(Rb * K + C) * 2u; }
    const size_t kstep = (size_t)(BK * 2);
    const size_t hstep = (size_t)HALF * K * 2;
    const size_t tstep = 2 * hstep;
    const unsigned ldsw = (unsigned)wid * 1024u;
    const int aoff = lds_byte(wr * 64 + fr, fq * 8), boff = lds_byte(wc * 32 + fr, fq * 8);
#define PG8_SA(b, h) (((b) * 2 + (h)) * HTB)
#define PG8_SB(b, h) ((4 + (b) * 2 + (h)) * HTB)
#define PG8_STAGE(bufoff, gbase, voff) do { _Pragma("unroll") for (int _i = 0; _i < 2; ++_i) \
        __builtin_amdgcn_global_load_lds((const unsigned*)((const char*)(gbase) + (voff)[_i]), (PG8_LAS unsigned*)(lds + (bufoff) + ldsw + _i * 8192), 16, 0, 0); } while (0)
#define PG8_LDA(dst, b, h) do { _Pragma("unroll") for (int m = 0; m < 4; ++m) _Pragma("unroll") for (int k = 0; k < 2; ++k) dst[m][k] = *(const PG8_LAS bf16x8*)(lds + PG8_SA(b, h) + aoff + m * 2048 + k * 1024); } while (0)
#define PG8_LDB(dst, b, h) do { _Pragma("unroll") for (int n = 0; n < 2; ++n) _Pragma("unroll") for (int k = 0; k < 2; ++k) dst[n][k] = *(const PG8_LAS bf16x8*)(lds + PG8_SB(b, h) + boff + n * 2048 + k * 1024); } while (0)
#define PG8_MMA(ai, bj, At, Bt) do { __builtin_amdgcn_s_setprio(1); _Pragma("unroll") for (int m = 0; m < 4; ++m) _Pragma("unroll") for (int n = 0; n < 2; ++n) _Pragma("unroll") for (int k = 0; k < 2; ++k) \
        acc[ai][bj][m][n] = __builtin_amdgcn_mfma_f32_16x16x32_bf16(Bt[n][k], At[m][k], acc[ai][bj][m][n], 0, 0, 0); __builtin_amdgcn_s_setprio(0); } while (0)
#define PG8_WAIT_V(n) asm volatile("s_waitcnt vmcnt(" #n ")" ::: "memory")
#define PG8_WAIT_L(n) asm volatile("s_waitcnt lgkmcnt(" #n ")" ::: "memory")
#define PG8_BAR __builtin_amdgcn_s_barrier()
#define PG8_SCHED __builtin_amdgcn_sched_barrier(0)
    Unit cur, nxt; int ui = 0;
    if (!S.next(0, cur)) return;
    f32x4 acc[2][2][4][2];
#pragma unroll
    for (int a = 0; a < 2; ++a)
#pragma unroll
        for (int b = 0; b < 2; ++b)
#pragma unroll
            for (int m = 0; m < 4; ++m)
#pragma unroll
                for (int n = 0; n < 2; ++n) acc[a][b][m][n] = (f32x4){0.f, 0.f, 0.f, 0.f};
    bf16x8 At[4][2], B0[2][2], B1[2][2];
    const char* cA = (const char*)g.A + (size_t)cur.pm * tstep; const char* cB = (const char*)g.Bt + (size_t)cur.pn * tstep;
    S.a_ready(cur);
    if constexpr (SP2) {
        PG8_STAGE(PG8_SB(0, 0), cB, voffB); PG8_STAGE(PG8_SB(0, 1), cB + hstep, voffB); PG8_STAGE(PG8_SA(0, 0), cA, voffA); PG8_STAGE(PG8_SA(0, 1), cA + hstep, voffA);
        if (wr == 1) PG8_BAR;
        PG8_WAIT_V(2); PG8_BAR;
        PG8_STAGE(PG8_SB(1, 0), cB + kstep, voffB); PG8_STAGE(PG8_SA(1, 0), cA + kstep, voffA); PG8_STAGE(PG8_SB(1, 1), cB + hstep + kstep, voffB);
        PG8_WAIT_V(6); PG8_BAR;
    } else {
        PG8_STAGE(PG8_SB(0, 0), cB, voffB); PG8_STAGE(PG8_SA(0, 0), cA, voffA); PG8_STAGE(PG8_SB(0, 1), cB + hstep, voffB); PG8_STAGE(PG8_SA(0, 1), cA + hstep, voffA);
        if (wr == 1) PG8_BAR;
        PG8_WAIT_V(4); PG8_BAR;
        PG8_STAGE(PG8_SB(1, 0), cB + kstep, voffB); PG8_STAGE(PG8_SA(1, 0), cA + kstep, voffA); PG8_STAGE(PG8_SB(1, 1), cB + hstep + kstep, voffB);
        PG8_WAIT_V(6); PG8_BAR;
    }
    for (;;) {
        const bool has_next = S.next(ui + 1, nxt);
        const char* nA = has_next ? (const char*)g.A + (size_t)nxt.pm * tstep : cA; const char* nB = has_next ? (const char*)g.Bt + (size_t)nxt.pn * tstep : cB;
        for (int t = 0; t < nt; t += 2) {
            const bool last = (t == nt - 2);
            const char* a1 = cA + (size_t)(t + 1) * kstep;
            const char* a2 = last ? nA : cA + (size_t)(t + 2) * kstep; const char* b2 = last ? nB : cB + (size_t)(t + 2) * kstep;
            const char* a3 = a2 + kstep; const char* b3 = b2 + kstep;
            if (last && has_next) S.a_ready(nxt);
            if constexpr (SP2) {
            PG8_LDB(B0, 0, 0); PG8_LDB(B1, 0, 1); PG8_SCHED; PG8_LDA(At, 0, 0); PG8_STAGE(PG8_SA(1, 1), a1 + hstep, voffA);
            PG8_WAIT_V(8); PG8_WAIT_L(0); PG8_BAR; PG8_MMA(0, 0, At, B0); PG8_MMA(0, 1, At, B1); PG8_BAR; PG8_SCHED;
            PG8_LDA(At, 0, 1); PG8_STAGE(PG8_SB(0, 0), b2, voffB); PG8_STAGE(PG8_SB(0, 1), b2 + hstep, voffB); PG8_STAGE(PG8_SA(0, 0), a2, voffA);
            PG8_WAIT_V(8); PG8_WAIT_L(0); PG8_BAR; PG8_MMA(1, 0, At, B0); PG8_MMA(1, 1, At, B1); PG8_BAR; PG8_SCHED;
            PG8_LDB(B0, 1, 0); PG8_LDB(B1, 1, 1); PG8_SCHED; PG8_LDA(At, 1, 0); PG8_STAGE(PG8_SA(0, 1), a2 + hstep, voffA);
            PG8_WAIT_V(8); PG8_WAIT_L(0); PG8_BAR; PG8_MMA(0, 0, At, B0); PG8_MMA(0, 1, At, B1); PG8_BAR; PG8_SCHED;
            PG8_LDA(At, 1, 1); PG8_STAGE(PG8_SB(1, 0), b3, voffB); PG8_STAGE(PG8_SB(1, 1), b3 + hstep, voffB); PG8_STAGE(PG8_SA(1, 0), a3, voffA);
            PG8_WAIT_V(8); PG8_WAIT_L(0); PG8_BAR; PG8_MMA(1, 0, At, B0); PG8_MMA(1, 1, At, B1); PG8_BAR; PG8_SCHED;
            } else {
            PG8_LDB(B0, 0, 0); PG8_SCHED; PG8_LDA(At, 0, 0); PG8_STAGE(PG8_SA(1, 1), a1 + hstep, voffA);
            PG8_WAIT_L(8); PG8_BAR; PG8_WAIT_L(0); PG8_MMA(0, 0, At, B0); PG8_BAR; PG8_SCHED;
            PG8_LDB(B1, 0, 1); PG8_STAGE(PG8_SB(0, 0), b2, voffB);
            PG8_BAR; PG8_WAIT_L(0); PG8_MMA(0, 1, At, B1); PG8_BAR;
            PG8_LDA(At, 0, 1); PG8_STAGE(PG8_SA(0, 0), a2, voffA);
            PG8_BAR; PG8_WAIT_L(0); PG8_MMA(1, 0, At, B0); PG8_BAR; PG8_SCHED;
            PG8_STAGE(PG8_SB(0, 1), b2 + hstep, voffB);
            PG8_WAIT_V(6); PG8_BAR; PG8_MMA(1, 1, At, B1); PG8_BAR;
            PG8_LDB(B0, 1, 0); PG8_SCHED; PG8_LDA(At, 1, 0); PG8_STAGE(PG8_SA(0, 1), a2 + hstep, voffA);
            PG8_WAIT_L(8); PG8_BAR; PG8_WAIT_L(0); PG8_MMA(0, 0, At, B0); PG8_BAR; PG8_SCHED;
            PG8_LDB(B1, 1, 1); PG8_STAGE(PG8_SB(1, 0), b3, voffB);
            PG8_BAR; PG8_WAIT_L(0); PG8_MMA(0, 1, At, B1); PG8_BAR;
            PG8_LDA(At, 1, 1); PG8_STAGE(PG8_SA(1, 0), a3, voffA);
            PG8_BAR; PG8_WAIT_L(0); PG8_MMA(1, 0, At, B0); PG8_BAR; PG8_SCHED;
            PG8_STAGE(PG8_SB(1, 1), b3 + hstep, voffB);
            PG8_WAIT_V(6); PG8_BAR; PG8_MMA(1, 1, At, B1); PG8_BAR;
            }
        }
        if constexpr (ALIGN_EPI) { if (wr == 0) PG8_BAR; }
        if constexpr (!Epi::AFTER_DRAIN) { E(acc, cur, wr, wc, fr, fq); S.done(cur); }
        if (!has_next) break;
#pragma unroll
        for (int a = 0; a < 2; ++a)
#pragma unroll
            for (int b = 0; b < 2; ++b)
#pragma unroll
                for (int m = 0; m < 4; ++m)
#pragma unroll
                    for (int n = 0; n < 2; ++n) acc[a][b][m][n] = (f32x4){0.f, 0.f, 0.f, 0.f};
        cur = nxt; cA = nA; cB = nB; ++ui;
        if constexpr (ALIGN_EPI) { if (wr == 1) PG8_BAR; }
    }
    PG8_WAIT_V(0);
    if constexpr (!ALIGN_EPI) { if (wr == 0) PG8_BAR; }
    PG8_BAR;
    if constexpr (Epi::AFTER_DRAIN) { E.fused(acc, cur, wr, wc, fr, fq, lds, wid, lane); S.done(cur); }
#undef PG8_SA
#undef PG8_SB
#undef PG8_STAGE
#undef PG8_LDA
#undef PG8_LDB
#undef PG8_MMA
#undef PG8_WAIT_V
#undef PG8_WAIT_L
#undef PG8_BAR
#undef PG8_SCHED
}
}

#define GAS __attribute__((address_space(1)))
#define LAS __attribute__((address_space(3)))
typedef unsigned short bf16;
typedef unsigned v4u __attribute__((ext_vector_type(4)));
typedef unsigned v2u __attribute__((ext_vector_type(2)));
typedef float f32x4 __attribute__((ext_vector_type(4)));
typedef float f32x16 __attribute__((ext_vector_type(16)));
typedef short bf16x8 __attribute__((ext_vector_type(8)));
typedef GAS unsigned gu32;
#define RLX_AGENT __ATOMIC_RELAXED, __HIP_MEMORY_SCOPE_AGENT
#define LDS_WAIT() asm volatile("s_waitcnt lgkmcnt(0)" ::: "memory")
#define VM_WAIT() asm volatile("s_waitcnt vmcnt(0)" ::: "memory")
#define LDS_BARRIER() do { asm volatile("s_waitcnt lgkmcnt(0)" ::: "memory"); __builtin_amdgcn_s_barrier(); asm volatile("" ::: "memory"); } while (0)

constexpr int NWAVES = 8, NTHR = 512;
constexpr int BATCH = 2, SEQ = 4096, T = BATCH * SEQ, D = 2048, C = 1024, NH = 16, HD = 64;
constexpr int AH = 8, AD = 128, MB = 256, NBLK = SEQ / MB;
constexpr int NSHIFT = 3328, NIN = 6400, NZ = 6656, FF = 8192;
constexpr int ZQ = 3328, ZK = 4352, ZV = 5376, ZVD = 6400;
constexpr int DEPTH = 2;
constexpr float NORM_EPS = 1e-6f, LNX_EPS = 64e-5f;

constexpr size_t MiB = 1u << 20;
constexpr size_t WS_CTL = 0, CTL_ZERO_BYTES = 1 * MiB;
constexpr size_t WS_WIN = 1 * MiB, WS_WOUT = 27 * MiB, WS_WUP = 35 * MiB, WS_WDN = 67 * MiB;
constexpr size_t WS_VF = 99 * MiB;
constexpr size_t WS_HN = 131 * MiB;
constexpr size_t WS_YC = 163 * MiB;
constexpr size_t WS_Z = 195 * MiB;
constexpr size_t WS_XL = 299 * MiB;
constexpr size_t WS_LW = 304 * MiB;
constexpr size_t WS_ROPE = 323 * MiB;
constexpr size_t WS_SV = 325 * MiB;
constexpr size_t WS_SG = 341 * MiB;
constexpr size_t WS_AQ = 357 * MiB, WS_AK = 373 * MiB, WS_AVT = 389 * MiB;
constexpr size_t WS_KM = 405 * MiB;
constexpr size_t WS_CHUNK = 406 * MiB;
constexpr size_t WS_U = 195 * MiB;
constexpr size_t WS_Y2 = 195 * MiB;
constexpr size_t WS_M = 131 * MiB;
constexpr size_t WS_END = 502 * MiB;
constexpr int CW_BAR = 4096;

constexpr int RING_BYTES = 155648;
constexpr int LDSCTL_OFF = RING_BYTES, MISC_OFF = LDSCTL_OFF + 320;
constexpr int LDS_BYTES = RING_BYTES + 1024;
constexpr int PTAB_OFF = MISC_OFF + 128;

__device__ __forceinline__ unsigned f2bf(float f) { unsigned u = __builtin_bit_cast(unsigned, f); return (u + 0x7fffu + ((u >> 16) & 1u)) >> 16; }
__device__ __forceinline__ unsigned pk2(float lo, float hi) { return f2bf(lo) | (f2bf(hi) << 16); }
__device__ __forceinline__ float bf2f(unsigned short b) { return __builtin_bit_cast(float, (unsigned)b << 16); }
__device__ __forceinline__ float bflo(unsigned w) { return __builtin_bit_cast(float, w << 16); }
__device__ __forceinline__ float bfhi(unsigned w) { return __builtin_bit_cast(float, w & 0xffff0000u); }

#define XB_TMO      128
#define XB_XCNT(j)  (256  + 64 * (j))
#define XB_XSUB(j)  (1280 + 64 * (j))
#define XB_XGEN(j)  (2304 + 64 * (j))
#define XB_TOP      3328
#define XB_TOPGEN   3392
#define XCD_BAR_WORDS 3456
#define XB_SPIN_CAP (1u << 20)
__device__ __forceinline__ unsigned xb_ld(unsigned* p)              { return __hip_atomic_load(p, __ATOMIC_RELAXED, __HIP_MEMORY_SCOPE_AGENT); }
__device__ __forceinline__ unsigned xb_add(unsigned* p, unsigned v) { return __hip_atomic_fetch_add(p, v, __ATOMIC_RELAXED, __HIP_MEMORY_SCOPE_AGENT); }
__device__ __forceinline__ unsigned xb_xcc_id() { return (unsigned)__builtin_amdgcn_s_getreg((3 << 11) | 20) & 0xFu; }
#define XB_SPIN(cond, bar) do { unsigned _sp = 0; while (cond) { __builtin_amdgcn_s_sleep(1); \
    if ((++_sp & 255u) == 0u) { if (xb_ld(&(bar)[XB_TMO])) break; if (_sp > XB_SPIN_CAP) { atomicAdd(&(bar)[XB_TMO], 1u); break; } } } } while (0)
struct XcdBarrier { unsigned* bar; unsigned x; volatile LAS unsigned* st; };
__device__ __forceinline__ XcdBarrier xcd_barrier_post(unsigned* bar, volatile LAS unsigned* st) {
    XcdBarrier b; b.bar = bar; b.x = xb_xcc_id(); b.st = st;
    if (threadIdx.x == 0) (void)xb_add(&bar[XB_XCNT(b.x)], 1u);
    return b;
}
__device__ __forceinline__ void xcd_barrier_complete(unsigned* bar, unsigned x, unsigned& nloc, unsigned& nx) {
    const unsigned G = gridDim.x * gridDim.y * gridDim.z;
    unsigned sum, cnt, mine, sp = 0u;
    for (;;) {
        sum = 0u; cnt = 0u; mine = 0u;
#pragma unroll
        for (unsigned j = 0; j < 16; ++j) { const unsigned c = xb_ld(&bar[XB_XCNT(j)]); sum += c; cnt += (c > 0u) ? 1u : 0u; mine = (j == x) ? c : mine; }
        if (sum == G) break;
        __builtin_amdgcn_s_sleep(1);
        if ((++sp & 255u) == 0u) { if (xb_ld(&bar[XB_TMO])) break; if (sp > XB_SPIN_CAP) { atomicAdd(&bar[XB_TMO], 1u); break; } }
    }
    nloc = mine > 0u ? mine : 1u; nx = cnt > 0u ? cnt : 1u;
}
__device__ __forceinline__ void xcd_barrier(const XcdBarrier& b) {
    asm volatile("s_waitcnt vmcnt(0)" ::: "memory");
    __syncthreads();
    if (threadIdx.x == 0) {
        unsigned* bar = b.bar;
        __builtin_amdgcn_s_waitcnt(0);
        unsigned nloc = b.st[0], nx = b.st[1];
        if (nloc == 0u) { xcd_barrier_complete(bar, b.x, nloc, nx); b.st[0] = nloc; b.st[1] = nx; }
        const unsigned old = xb_add(&bar[XB_XSUB(b.x)], 1u);
        const unsigned gen = old / nloc;
        if (old + 1u == (gen + 1u) * nloc) {
            __builtin_amdgcn_fence(__ATOMIC_RELEASE, "agent");
            asm volatile("s_waitcnt vmcnt(0)" ::: "memory");
            const unsigned og = xb_add(&bar[XB_TOP], 1u);
            const unsigned tg = og / nx;
            if (og + 1u == (tg + 1u) * nx) xb_add(&bar[XB_TOPGEN], 1u);
            else XB_SPIN(xb_ld(&bar[XB_TOPGEN]) == tg, bar);
            __builtin_amdgcn_fence(__ATOMIC_ACQUIRE, "agent");
            xb_add(&bar[XB_XGEN(b.x)], 1u);
            asm volatile("s_waitcnt vmcnt(0)" ::: "memory");
        } else {
            XB_SPIN(xb_ld(&bar[XB_XGEN(b.x)]) == gen, bar);
            __builtin_amdgcn_fence(__ATOMIC_ACQUIRE, "agent");
            asm volatile("s_waitcnt vmcnt(0)" ::: "memory");
        }
    }
    __syncthreads();
}

struct Frame {
    LAS unsigned char* lds;
    volatile LAS unsigned* MISC;
    gu32* ctl;
    int tid, lane, wave, vcu, G, bx;
    float* out;
    unsigned char* ws;
};
enum { I_X = 0, I_NMIXPRE, I_NMIXPOST, I_NMLPPRE, I_NMLPPOST, I_WIN, I_WINV, I_MU, I_MUV, I_W0, I_W2, I_A0, I_A2, I_V0, I_V2, I_G2, I_KK, I_KA, I_RK, I_LNG, I_LNB, I_WOUT, I_WUP, I_WDN };

__device__ __forceinline__ const float* inp_(const Frame& F, int i) {
    const unsigned long long v = *(const LAS unsigned long long*)(F.lds + PTAB_OFF + 8 * i);
    const unsigned lo = __builtin_amdgcn_readfirstlane((unsigned)v), hi = __builtin_amdgcn_readfirstlane((unsigned)(v >> 32));
    return (const float*)(const GAS float*)(((unsigned long long)hi << 32) | lo);
}
#define INP(i) inp_(F, (i))
#define DPP_ADD(v, ctrl) ((v) + __builtin_bit_cast(float, __builtin_amdgcn_update_dpp(0, __builtin_bit_cast(int, (v)), (ctrl), 0xF, 0xF, true)))
__device__ __forceinline__ float wave_sum(float v) {
    v = DPP_ADD(v, 0xB1);
    v = DPP_ADD(v, 0x4E);
    v = DPP_ADD(v, 0x141);
    v = DPP_ADD(v, 0x140);
    const float r0 = __builtin_bit_cast(float, __builtin_amdgcn_readlane(__builtin_bit_cast(int, v), 0)), r1 = __builtin_bit_cast(float, __builtin_amdgcn_readlane(__builtin_bit_cast(int, v), 16));
    const float r2 = __builtin_bit_cast(float, __builtin_amdgcn_readlane(__builtin_bit_cast(int, v), 32)), r3 = __builtin_bit_cast(float, __builtin_amdgcn_readlane(__builtin_bit_cast(int, v), 48));
    return (r0 + r1) + (r2 + r3);
}
__device__ __forceinline__ void transpose_item(const float* W, int K, int N, bf16* WT, int row_off, LAS float* scr, int item, int lane) {
    const int nblk = N / 32, kb = item / nblk, nb = item % nblk, k0 = 64 * kb, n0 = 32 * nb;
#pragma unroll 8
    for (int i = 0; i < 32; ++i) { const int kk = 2 * i + (lane >> 5); scr[kk * 33 + (lane & 31)] = W[(size_t)(k0 + kk) * N + n0 + (lane & 31)]; }
    LDS_WAIT(); asm volatile("" ::: "memory");
    const int c = lane & 7;
#pragma unroll
    for (int j = 0; j < 4; ++j) { const int n = (lane >> 3) + 8 * j; const LAS float* s = scr + (8 * c) * 33 + n;
        v4u o; o.x = pk2(s[0 * 33], s[1 * 33]); o.y = pk2(s[2 * 33], s[3 * 33]); o.z = pk2(s[4 * 33], s[5 * 33]); o.w = pk2(s[6 * 33], s[7 * 33]);
        *(GAS v4u*)(WT + (size_t)(row_off + n0 + n) * K + k0 + 8 * c) = o; }
    LDS_WAIT(); asm volatile("" ::: "memory");
}
__device__ __forceinline__ void rmsnorm_row_to_bf16(const float* xrow, const float* gain, bf16* orow, int lane) {
    const GAS f32x4* xr = (const GAS f32x4*)xrow + lane; const GAS f32x4* gr = (const GAS f32x4*)gain + lane;
    f32x4 v[8]; float s = 0.f;
#pragma unroll
    for (int j = 0; j < 8; ++j) { v[j] = xr[64 * j]; s += (v[j].x * v[j].x + v[j].y * v[j].y) + (v[j].z * v[j].z + v[j].w * v[j].w); }
    const float rs = 1.0f / sqrtf(wave_sum(s) * (1.f / D) + NORM_EPS);
    GAS v2u* o8 = (GAS v2u*)orow + lane;
#pragma unroll
    for (int j = 0; j < 8; ++j) { const f32x4 g = gr[64 * j]; v2u w; w.x = pk2(v[j].x * rs * g.x, v[j].y * rs * g.y); w.y = pk2(v[j].z * rs * g.z, v[j].w * rs * g.w); o8[64 * j] = w; }
}
__device__ __forceinline__ void ph_convert(Frame& F, int L) {
    LAS float* scr = (LAS float*)(F.lds + F.wave * 16384);
    const int gw = F.vcu * NWAVES + F.wave, NGW = F.G * NWAVES;
    bf16* WinT = (bf16*)(F.ws + WS_WIN); bf16* WoutT = (bf16*)(F.ws + WS_WOUT); bf16* WupT = (bf16*)(F.ws + WS_WUP); bf16* WdnT = (bf16*)(F.ws + WS_WDN);
    constexpr int I_IN = (D / 64) * (NIN / 32), I_VR = (D / 64), I_OUT = (D / 64) * (D / 32), I_UP = (D / 64) * (FF / 32), I_DN = (FF / 64) * (D / 32);
    const int nvr = (L > 0) ? I_VR : 0;
    const int NITEMS = I_IN + nvr + I_OUT + I_UP + I_DN;
    for (int it = gw; it < NITEMS; it += NGW) {
        int r = it;
        if (r < I_IN) { transpose_item(INP(I_WIN) + (size_t)L * D * NIN, D, NIN, WinT, 0, scr, r, F.lane); continue; } r -= I_IN;
        if (r < nvr) { transpose_item(INP(I_WINV) + (size_t)(L - 1) * D * 32, D, 32, WinT, NIN, scr, r, F.lane); continue; } r -= nvr;
        if (r < I_OUT) { transpose_item(INP(I_WOUT) + (size_t)L * D * D, D, D, WoutT, 0, scr, r, F.lane); continue; } r -= I_OUT;
        if (r < I_UP) { transpose_item(INP(I_WUP) + (size_t)L * D * FF, D, FF, WupT, 0, scr, r, F.lane); continue; } r -= I_UP;
        transpose_item(INP(I_WDN) + (size_t)L * FF * D, FF, D, WdnT, 0, scr, r, F.lane);
    }
    if (L > 0) {
        const int gt = F.vcu * NTHR + F.tid, NGT = F.G * NTHR;
        for (int i = gt; i < (NZ - NIN - 32) * (D / 8); i += NGT) *(GAS v4u*)(WinT + (size_t)(NIN + 32) * D + (size_t)i * 8) = (v4u){0u, 0u, 0u, 0u};
    }
    {
        bf16* W2T = (bf16*)(F.ws + WS_LW); bf16* A2T = W2T + C * 64; bf16* G2T = A2T + C * 64; bf16* V2T = G2T + C * 128;
        for (int it = gw; it < 32 + 32 + 64; it += NGW) {
            if (it < 32) transpose_item(INP(I_W2) + (size_t)L * 64 * C, 64, C, W2T, 0, scr, it, F.lane);
            else if (it < 64) transpose_item(INP(I_A2) + (size_t)L * 64 * C, 64, C, A2T, 0, scr, it - 32, F.lane);
            else transpose_item(INP(I_G2) + (size_t)L * 128 * C, 128, C, G2T, 0, scr, it - 64, F.lane);
        }
        const int gt = F.vcu * NTHR + F.tid, NGT = F.G * NTHR;
        if (L > 0) { const float* v2 = INP(I_V2) + (size_t)(L - 1) * 32 * C; for (int i = gt; i < 32 * C; i += NGT) { const int cch = i >> 5, k = i & 31; V2T[i] = (bf16)f2bf(v2[(size_t)k * C + cch]); } }
        if (L == 0) { float* RC = (float*)(F.ws + WS_ROPE); float* RS = RC + SEQ * 64;
            for (int i = gt; i < SEQ * 64; i += NGT) { const int pos = i >> 6, d = i & 63; const float inv_freq = exp2f(-(float)d * (13.287712379549449f / 64.0f)); float sn, cs; sincosf((float)pos * inv_freq, &sn, &cs); RC[i] = cs; RS[i] = sn; } }
    }
    if (L == 0) {
        bf16* HN = (bf16*)(F.ws + WS_HN);
        for (int m = gw; m < T; m += NGW) rmsnorm_row_to_bf16(INP(I_X) + (size_t)m * D, INP(I_NMIXPRE), HN + (size_t)m * D, F.lane);
    }
}
__device__ __forceinline__ void ph_resnorm(Frame& F, const float* y, const float* xin, const float* gA, const float* gB, float* xout, bf16* hn) {
    const int gw = F.vcu * NWAVES + F.wave, NGW = F.G * NWAVES;
    for (int m = gw; m < T; m += NGW) {
        const GAS f32x4* yr = (const GAS f32x4*)(y + (size_t)m * D) + F.lane; const GAS f32x4* xr = (const GAS f32x4*)(xin + (size_t)m * D) + F.lane;
        const GAS f32x4* ga = (const GAS f32x4*)gA + F.lane;
        f32x4 v[8]; float s = 0.f;
#pragma unroll
        for (int j = 0; j < 8; ++j) { v[j] = yr[64 * j]; s += (v[j].x * v[j].x + v[j].y * v[j].y) + (v[j].z * v[j].z + v[j].w * v[j].w); }
        const float rs = 1.0f / sqrtf(wave_sum(s) * (1.f / D) + NORM_EPS);
        float s2 = 0.f;
        GAS f32x4* xo = (GAS f32x4*)(xout + (size_t)m * D) + F.lane;
#pragma unroll
        for (int j = 0; j < 8; ++j) { const f32x4 g = ga[64 * j]; const f32x4 x = xr[64 * j];
            v[j].x = x.x + v[j].x * rs * g.x; v[j].y = x.y + v[j].y * rs * g.y; v[j].z = x.z + v[j].z * rs * g.z; v[j].w = x.w + v[j].w * rs * g.w;
            xo[64 * j] = v[j]; s2 += (v[j].x * v[j].x + v[j].y * v[j].y) + (v[j].z * v[j].z + v[j].w * v[j].w); }
        if (gB) {
            const float rs2 = 1.0f / sqrtf(wave_sum(s2) * (1.f / D) + NORM_EPS);
            const GAS f32x4* gb = (const GAS f32x4*)gB + F.lane; GAS v2u* o8 = (GAS v2u*)(hn + (size_t)m * D) + F.lane;
#pragma unroll
            for (int j = 0; j < 8; ++j) { const f32x4 g = gb[64 * j]; v2u w; w.x = pk2(v[j].x * rs2 * g.x, v[j].y * rs2 * g.y); w.y = pk2(v[j].z * rs2 * g.z, v[j].w * rs2 * g.w); o8[64 * j] = w; }
        }
    }
}
__device__ __forceinline__ float sigmoidf_(float x) { return 1.0f / (1.0f + __expf(-x)); }
__device__ __forceinline__ float softplusf_(float x) { return fmaxf(x, 0.f) + log1pf(__expf(-fabsf(x))); }

__device__ __forceinline__ void prep_xl_items(Frame& F, int L) {
    const bf16* Z = (const bf16*)(F.ws + WS_Z); bf16* XL = (bf16*)(F.ws + WS_XL);
    const float* mu = INP(I_MU) + (size_t)L * NSHIFT; const float* muv = INP(I_MUV) + (size_t)(L > 0 ? L - 1 : 0) * 32;
    const int gt = F.vcu * NTHR + F.tid, NGT = F.G * NTHR;
    for (int it = gt; it < T * 36; it += NGT) {
        const int t = it / 36, j8 = it - t * 36, s = t & (SEQ - 1);
        v4u o = (v4u){0u, 0u, 0u, 0u};
        if (j8 < 32 || L > 0) {
            const int col = (j8 < 32) ? (3072 + 8 * j8) : (ZVD + 8 * (j8 - 32));
            const float* mup = (j8 < 32) ? (mu + col) : (muv + 8 * (j8 - 32));
            const v4u zc = *(const GAS v4u*)(Z + (size_t)t * NZ + col);
            v4u zp = (v4u){0u, 0u, 0u, 0u}; if (s) zp = *(const GAS v4u*)(Z + (size_t)(t - 1) * NZ + col);
            const f32x4 m0 = *(const GAS f32x4*)mup, m1 = *(const GAS f32x4*)(mup + 4);
            float f[8];
#pragma unroll
            for (int q = 0; q < 4; ++q) { const float c0 = bflo(zc[q]), c1 = bfhi(zc[q]), p0 = bflo(zp[q]), p1 = bfhi(zp[q]);
                const float ma = (q < 2) ? m0[2 * q] : m1[2 * q - 4], mb = (q < 2) ? m0[2 * q + 1] : m1[2 * q - 3];
                f[2 * q] = c0 + (p0 - c0) * ma; f[2 * q + 1] = c1 + (p1 - c1) * mb; }
            if (j8 < 8) {
#pragma unroll
                for (int q = 0; q < 8; ++q) f[q] = tanhf(f[q]);
            } else if (j8 >= 16 && j8 < 32) {
#pragma unroll
                for (int q = 0; q < 8; ++q) f[q] = sigmoidf_(f[q]);
            }
            o = (v4u){pk2(f[0], f[1]), pk2(f[2], f[3]), pk2(f[4], f[5]), pk2(f[6], f[7])};
        }
        *(GAS v4u*)(XL + (size_t)t * 288 + 8 * j8) = o;
    }
}
constexpr float QSC = 0.08838834764831845f * 1.4426950408889634f;
__device__ __forceinline__ void prep_attn_unit(Frame& F, int u) {
    const bf16* Z = (const bf16*)(F.ws + WS_Z);
    bf16* AQ = (bf16*)(F.ws + WS_AQ); bf16* AKp = (bf16*)(F.ws + WS_AK); float* KM = (float*)(F.ws + WS_KM);
    const float* RC = (const float*)(F.ws + WS_ROPE); const float* RS = RC + SEQ * 64;
    const int b = u / (NBLK * AH), rem = u % (NBLK * AH), blk = rem / AH, h = rem % AH;
    const int tid = F.tid, d = 8 * (tid & 7), tg = tid >> 3;
    const int tb = b * SEQ + blk * MB;
    LAS float* red = (LAS float*)F.lds;
    LDS_BARRIER();
    float ks[16];
#pragma unroll
    for (int q = 0; q < 16; ++q) ks[q] = 0.f;
#pragma unroll
    for (int i = 0; i < 4; ++i) {
        const int tok = tg + 64 * i; const int pos = blk * MB + tok; const size_t t = (size_t)(tb + tok);
        const f32x4 c0 = *(const GAS f32x4*)(RC + pos * 64 + d), c1 = *(const GAS f32x4*)(RC + pos * 64 + d + 4);
        const f32x4 s0 = *(const GAS f32x4*)(RS + pos * 64 + d), s1 = *(const GAS f32x4*)(RS + pos * 64 + d + 4);
        const v4u ql = *(const GAS v4u*)(Z + t * NZ + ZQ + h * AD + d), qh = *(const GAS v4u*)(Z + t * NZ + ZQ + h * AD + 64 + d);
        const v4u kl = *(const GAS v4u*)(Z + t * NZ + ZK + h * AD + d), kh = *(const GAS v4u*)(Z + t * NZ + ZK + h * AD + 64 + d);
        float qlo[8], qhi[8], klo[8], khi[8];
#pragma unroll
        for (int q = 0; q < 4; ++q) { qlo[2 * q] = bflo(ql[q]); qlo[2 * q + 1] = bfhi(ql[q]); qhi[2 * q] = bflo(qh[q]); qhi[2 * q + 1] = bfhi(qh[q]);
            klo[2 * q] = bflo(kl[q]); klo[2 * q + 1] = bfhi(kl[q]); khi[2 * q] = bflo(kh[q]); khi[2 * q + 1] = bfhi(kh[q]); }
        float oq1[8], oq2[8], ok1[8], ok2[8];
#pragma unroll
        for (int q = 0; q < 8; ++q) { const float cs = (q < 4) ? c0[q] : c1[q - 4], sn = (q < 4) ? s0[q] : s1[q - 4];
            oq1[q] = (qlo[q] * cs - qhi[q] * sn) * QSC; oq2[q] = (qhi[q] * cs + qlo[q] * sn) * QSC; ok1[q] = klo[q] * cs - khi[q] * sn; ok2[q] = khi[q] * cs + klo[q] * sn;
            ks[q] += ok1[q]; ks[8 + q] += ok2[q]; }
        *(GAS v4u*)(AQ + t * C + h * AD + d) = (v4u){pk2(oq1[0], oq1[1]), pk2(oq1[2], oq1[3]), pk2(oq1[4], oq1[5]), pk2(oq1[6], oq1[7])};
        *(GAS v4u*)(AQ + t * C + h * AD + 64 + d) = (v4u){pk2(oq2[0], oq2[1]), pk2(oq2[2], oq2[3]), pk2(oq2[4], oq2[5]), pk2(oq2[6], oq2[7])};
        *(GAS v4u*)(AKp + t * C + h * AD + d) = (v4u){pk2(ok1[0], ok1[1]), pk2(ok1[2], ok1[3]), pk2(ok1[4], ok1[5]), pk2(ok1[6], ok1[7])};
        *(GAS v4u*)(AKp + t * C + h * AD + 64 + d) = (v4u){pk2(ok2[0], ok2[1]), pk2(ok2[2], ok2[3]), pk2(ok2[4], ok2[5]), pk2(ok2[6], ok2[7])};
    }
    *(LAS f32x4*)(red + tg * 128 + d) = (f32x4){ks[0], ks[1], ks[2], ks[3]}; *(LAS f32x4*)(red + tg * 128 + d + 4) = (f32x4){ks[4], ks[5], ks[6], ks[7]};
    *(LAS f32x4*)(red + tg * 128 + 64 + d) = (f32x4){ks[8], ks[9], ks[10], ks[11]}; *(LAS f32x4*)(red + tg * 128 + 64 + d + 4) = (f32x4){ks[12], ks[13], ks[14], ks[15]};
    LDS_BARRIER();
    if (tid < 128) { float s = 0.f;
#pragma unroll 8
        for (int w = 0; w < 64; ++w) s += red[w * 128 + tid];
        KM[((size_t)(b * AH + h) * NBLK + blk) * AD + tid] = s * (1.0f / MB); }
}
__device__ __forceinline__ void ph_prep(Frame& F, int L) {
    prep_xl_items(F, L);
    for (int u = F.vcu; u < BATCH * NBLK * AH; u += F.G) prep_attn_unit(F, u);
}

typedef short bf16x4 __attribute__((ext_vector_type(4)));
constexpr int NCHK = SEQ / 64;
constexpr int NUNIT = BATCH * NH * NCHK;
constexpr int CP = 144, MATB = 64 * CP;
constexpr int L_ARA = 0, L_ARR = MATB, L_BKB = 2 * MATB, L_BKK = 3 * MATB, L_AT = 4 * MATB, L_BT = 5 * MATB, L_KT = 6 * MATB, L_VT = 7 * MATB;
constexpr int L_AAB = 8 * MATB, L_AAK = 9 * MATB, L_ARB = 10 * MATB, L_ARK = 11 * MATB, L_ND = 12 * MATB, L_TB = L_ND + 4096;
constexpr int XLP = 592;
constexpr int L_XL = 8 * MATB, L_LW = L_XL + 64 * XLP, L_LA = L_LW + 16384, L_LV = L_LA + 8192, L_LG = L_LV + 8192, L_SEG = L_LG + 8192, L_GL = L_SEG + 2048;
static_assert(L_TB + 2048 <= L_SEG && L_GL + 256 <= RING_BYTES, "wkv LDS map");
constexpr int L_W2T = L_ARA, L_PT = L_BKB, L_QT = L_BKK;
constexpr size_t WS_CM = WS_CHUNK, WS_CG = WS_CM + (size_t)NUNIT * 8192, WS_CRY = WS_CG + (size_t)NUNIT * 16384, WS_CYC = WS_CRY + (size_t)NUNIT * 8192;
static_assert(WS_CYC + (size_t)NUNIT * 16384 <= WS_END, "chunk outputs");
constexpr size_t WS_CS = WS_HN;
constexpr size_t WS_BON = WS_HN + (size_t)NUNIT * 8192;
static_assert(WS_BON + (size_t)T * NH * 4 <= WS_YC, "HN region");

__device__ __forceinline__ f32x4 mfma32(bf16x8 a, bf16x8 b, f32x4 c) { return __builtin_amdgcn_mfma_f32_16x16x32_bf16(a, b, c, 0, 0, 0); }
__device__ __forceinline__ f32x4 mfma16(bf16x4 a, bf16x4 b, f32x4 c) { return __builtin_amdgcn_mfma_f32_16x16x16bf16_1k(a, b, c, 0, 0, 0); }
__device__ __forceinline__ v2u pk4(f32x4 v) { v2u w; w.x = pk2(v[0], v[1]); w.y = pk2(v[2], v[3]); return w; }

__device__ __forceinline__ void wkv_r1_unit(Frame& F, int L, int unit) {
    const int c = unit % NCHK, bh = unit / NCHK, h = bh % NH, b = bh / NH;
    const int tid = F.tid, lane = F.lane, w = F.wave, fr = lane & 15, g = lane >> 4;
    LAS unsigned char* lds = F.lds;
    const bf16* Z = (const bf16*)(F.ws + WS_Z);
    const size_t tok0 = (size_t)b * SEQ + (size_t)c * 64;
    LDS_BARRIER();
    { const bf16* XLg = (const bf16*)(F.ws + WS_XL) + tok0 * 288;
      for (int idx = tid; idx < 64 * 36; idx += NTHR) { const int row = idx / 36, ch = idx - row * 36;
          *(LAS v4u*)(lds + L_XL + row * XLP + ch * 16) = *(const GAS v4u*)(XLg + row * 288 + ch * 8); } }
    LDS_BARRIER();
    {
        const int nt = w & 3, mt0 = 2 * (w >> 2), cl = 16 * nt + fr, ch = h * HD + cl;
        const bf16* W2T = (const bf16*)(F.ws + WS_LW); const bf16* A2T = W2T + C * 64; const bf16* G2T = A2T + C * 64; const bf16* V2T = G2T + C * 128;
        const float w0c = INP(I_W0)[(size_t)L * C + ch], a0c = INP(I_A0)[(size_t)L * C + ch];
        const LAS unsigned char* xa0 = lds + L_XL + (16 * mt0 + fr) * XLP + g * 16; const LAS unsigned char* xa1 = xa0 + 16 * XLP;
        {
            const bf16x8 b0 = *(const GAS bf16x8*)(W2T + (size_t)ch * 64 + 8 * g), b1 = *(const GAS bf16x8*)(W2T + (size_t)ch * 64 + 32 + 8 * g);
            f32x4 c0 = (f32x4){0.f, 0.f, 0.f, 0.f}, c1 = c0;
            c0 = mfma32(*(const LAS bf16x8*)(xa0), b0, c0); c0 = mfma32(*(const LAS bf16x8*)(xa0 + 64), b1, c0);
            c1 = mfma32(*(const LAS bf16x8*)(xa1), b0, c1); c1 = mfma32(*(const LAS bf16x8*)(xa1 + 64), b1, c1);
#pragma unroll
            for (int i = 0; i < 4; ++i) { const float wl0 = -softplusf_(-(c0[i] + w0c)) - 0.5f, wl1 = -softplusf_(-(c1[i] + w0c)) - 0.5f;
                ((LAS float*)(lds + L_LW))[(16 * mt0 + 4 * g + i) * 64 + cl] = -__expf(wl0); ((LAS float*)(lds + L_LW))[(16 * mt0 + 16 + 4 * g + i) * 64 + cl] = -__expf(wl1); }
        }
        {
            const bf16x8 b0 = *(const GAS bf16x8*)(A2T + (size_t)ch * 64 + 8 * g), b1 = *(const GAS bf16x8*)(A2T + (size_t)ch * 64 + 32 + 8 * g);
            f32x4 c0 = (f32x4){0.f, 0.f, 0.f, 0.f}, c1 = c0;
            c0 = mfma32(*(const LAS bf16x8*)(xa0 + 128), b0, c0); c0 = mfma32(*(const LAS bf16x8*)(xa0 + 192), b1, c0);
            c1 = mfma32(*(const LAS bf16x8*)(xa1 + 128), b0, c1); c1 = mfma32(*(const LAS bf16x8*)(xa1 + 192), b1, c1);
#pragma unroll
            for (int i = 0; i < 4; ++i) { ((LAS unsigned short*)(lds + L_LA))[(16 * mt0 + 4 * g + i) * 64 + cl] = (unsigned short)f2bf(sigmoidf_(c0[i] + a0c));
                ((LAS unsigned short*)(lds + L_LA))[(16 * mt0 + 16 + 4 * g + i) * 64 + cl] = (unsigned short)f2bf(sigmoidf_(c1[i] + a0c)); }
        }
        {
            f32x4 c0 = (f32x4){0.f, 0.f, 0.f, 0.f}, c1 = c0;
#pragma unroll
            for (int ks = 0; ks < 4; ++ks) { const bf16x8 bb = *(const GAS bf16x8*)(G2T + (size_t)ch * 128 + 32 * ks + 8 * g);
                c0 = mfma32(*(const LAS bf16x8*)(xa0 + 256 + 64 * ks), bb, c0); c1 = mfma32(*(const LAS bf16x8*)(xa1 + 256 + 64 * ks), bb, c1); }
#pragma unroll
            for (int i = 0; i < 4; ++i) { ((LAS unsigned short*)(lds + L_LG))[(16 * mt0 + 4 * g + i) * 64 + cl] = (unsigned short)f2bf(c0[i]); ((LAS unsigned short*)(lds + L_LG))[(16 * mt0 + 16 + 4 * g + i) * 64 + cl] = (unsigned short)f2bf(c1[i]); }
        }
        if (L > 0) {
            const float v0c = INP(I_V0)[(size_t)(L - 1) * C + ch];
            const bf16x8 b0 = *(const GAS bf16x8*)(V2T + (size_t)ch * 32 + 8 * g);
            f32x4 c0 = (f32x4){0.f, 0.f, 0.f, 0.f}, c1 = c0;
            c0 = mfma32(*(const LAS bf16x8*)(xa0 + 512), b0, c0); c1 = mfma32(*(const LAS bf16x8*)(xa1 + 512), b0, c1);
#pragma unroll
            for (int i = 0; i < 4; ++i) { ((LAS unsigned short*)(lds + L_LV))[(16 * mt0 + 4 * g + i) * 64 + cl] = (unsigned short)f2bf(sigmoidf_(c0[i] + v0c));
                ((LAS unsigned short*)(lds + L_LV))[(16 * mt0 + 16 + 4 * g + i) * 64 + cl] = (unsigned short)f2bf(sigmoidf_(c1[i] + v0c)); }
        }
    }
    LDS_BARRIER();
    {
        const int sg = w, j = lane, ch = h * HD + j;
        const float* mu = INP(I_MU) + (size_t)L * NSHIFT;
        const float mur = mu[ch], muk = mu[C + ch], muv = mu[2 * C + ch];
        const float kkc = INP(I_KK)[(size_t)L * C + ch], kac = INP(I_KA)[(size_t)L * C + ch], rkj = INP(I_RK)[(size_t)L * C + ch];
        float* VF = (float*)(F.ws + WS_VF); bf16* SVg = (bf16*)(F.ws + WS_SV); bf16* SGg = (bf16*)(F.ws + WS_SG);
        const size_t tokA = tok0 + 8 * sg;
        const GAS bf16* Zg = (const GAS bf16*)Z + tokA * NZ + ch;
        unsigned short zr_[9], zk_[9], zv_[9];
        { const bool hasprev = (c != 0 || sg != 0); const GAS bf16* zp = hasprev ? (Zg - NZ) : Zg;
          zr_[0] = zp[0]; zk_[0] = zp[C]; zv_[0] = zp[2 * C]; if (!hasprev) { zr_[0] = 0; zk_[0] = 0; zv_[0] = 0; } }
#pragma unroll
        for (int e = 0; e < 8; ++e) { zr_[e + 1] = Zg[(size_t)e * NZ]; zk_[e + 1] = Zg[(size_t)e * NZ + C]; zv_[e + 1] = Zg[(size_t)e * NZ + 2 * C]; }
        float lw[8], cum[8], rf[8], kf[8], kkf[8], af[8], vfin[8]; unsigned vb[8];
        float vfv[8];
#pragma unroll
        for (int e = 0; e < 8; ++e) vfv[e] = 0.f;
        if (L > 0) { const GAS float* VFg = (const GAS float*)VF + tokA * C + ch;
#pragma unroll
            for (int e = 0; e < 8; ++e) vfv[e] = VFg[(size_t)e * C]; }
        GAS bf16* SVo = (GAS bf16*)SVg + tokA * C + ch; GAS bf16* SGo = (GAS bf16*)SGg + tokA * C + ch;
#pragma unroll
        for (int e = 0; e < 8; ++e) {
            const int t = 8 * sg + e;
            const float zr = bf2f(zr_[e + 1]), zk = bf2f(zk_[e + 1]), zv = bf2f(zv_[e + 1]), zpr = bf2f(zr_[e]), zpk = bf2f(zk_[e]), zpv = bf2f(zv_[e]);
            const float r = zr + (zpr - zr) * mur, k = zk + (zpk - zk) * muk; float v = zv + (zpv - zv) * muv;
            lw[e] = ((const LAS float*)(lds + L_LW))[t * 64 + j];
            const float a = bf2f(((const LAS unsigned short*)(lds + L_LA))[t * 64 + j]);
            { const float sv = bf2f(((const LAS unsigned short*)(lds + L_LV))[t * 64 + j]); const float v1 = v + (vfv[e] - v) * sv; v = (L > 0) ? v1 : v; }
            vfin[e] = v; vb[e] = f2bf(v); SVo[(size_t)e * C] = (bf16)vb[e]; SGo[(size_t)e * C] = ((const LAS unsigned short*)(lds + L_LG))[t * 64 + j];
            float kk = k * kkc; const float ss = wave_sum(kk * kk); kk = kk / fmaxf(sqrtf(ss), 1e-12f);
            rf[e] = r; kf[e] = k * (1.f + (a - 1.f) * kac); kkf[e] = kk; af[e] = a;
        }
        if (L == 0) { GAS float* VFo = (GAS float*)VF + tokA * C + ch;
#pragma unroll
            for (int e = 0; e < 8; ++e) VFo[(size_t)e * C] = vfin[e]; }
        float run = 0.f;
#pragma unroll
        for (int e = 0; e < 8; ++e) { run += lw[e]; cum[e] = run; }
        LAS float* seg = (LAS float*)(lds + L_SEG);
        seg[sg * 64 + j] = run;
        LDS_BARRIER();
        float off = 0.f, tot = 0.f;
#pragma unroll
        for (int s2 = 0; s2 < 8; ++s2) { const float v = seg[s2 * 64 + j]; tot += v; off += (s2 < sg) ? v : 0.f; }
        if (sg == 0) ((LAS float*)(lds + L_GL))[j] = __expf(tot);
        unsigned at8[4], bt8[4], kt8[4], vt8[4];
        GAS float* BON = (GAS float*)(F.ws + WS_BON);
#pragma unroll
        for (int e = 0; e < 8; ++e) {
            const float cu = cum[e] + off, ce = cu - lw[e];
            const float eC = __expf(cu), eE = __expf(ce), eN = __expf(-cu);
            const unsigned At = f2bf(-kkf[e] * eE), Rt = f2bf(rf[e] * eC), Bt = f2bf(kkf[e] * af[e] * eN), Kt = f2bf(kf[e] * eN);
            const int t = 8 * sg + e;
            *(LAS unsigned short*)(lds + L_ARA + t * CP + j * 2) = (unsigned short)At;
            *(LAS unsigned short*)(lds + L_ARR + t * CP + j * 2) = (unsigned short)Rt;
            *(LAS unsigned short*)(lds + L_BKB + t * CP + j * 2) = (unsigned short)Bt;
            *(LAS unsigned short*)(lds + L_BKK + t * CP + j * 2) = (unsigned short)Kt;
            if (e & 1) { at8[e >> 1] |= At << 16; bt8[e >> 1] |= Bt << 16; kt8[e >> 1] |= Kt << 16; vt8[e >> 1] |= vb[e] << 16; }
            else { at8[e >> 1] = At; bt8[e >> 1] = Bt; kt8[e >> 1] = Kt; vt8[e >> 1] = vb[e]; }
            const float bs = wave_sum(rf[e] * kf[e] * rkj);
            if (j == 0) BON[(tok0 + t) * NH + h] = bs;
        }
        *(LAS v4u*)(lds + L_AT + j * CP + sg * 16) = (v4u){at8[0], at8[1], at8[2], at8[3]};
        *(LAS v4u*)(lds + L_BT + j * CP + sg * 16) = (v4u){bt8[0], bt8[1], bt8[2], bt8[3]};
        *(LAS v4u*)(lds + L_KT + j * CP + sg * 16) = (v4u){kt8[0], kt8[1], kt8[2], kt8[3]};
        *(LAS v4u*)(lds + L_VT + j * CP + sg * 16) = (v4u){vt8[0], vt8[1], vt8[2], vt8[3]};
    }
    LDS_BARRIER();
    {
        const int tq = w & 3; const bool isA = w < 4;
        const LAS unsigned char* Bsrc = lds + (isA ? L_ARA : L_ARR) + (16 * tq + fr) * CP + g * 16;
        const bf16x8 b0 = *(const LAS bf16x8*)Bsrc, b1 = *(const LAS bf16x8*)(Bsrc + 64);
        const int t = 16 * tq + fr;
#pragma unroll
        for (int mt = 0; mt < 8; ++mt) {
            const int sq = mt & 3; const bool isB = mt < 4;
            f32x4 acc = (f32x4){0.f, 0.f, 0.f, 0.f};
            if (sq <= tq) {
                const LAS unsigned char* Asrc = lds + (isB ? L_BKB : L_BKK) + (16 * sq + fr) * CP + g * 16;
                acc = mfma32(*(const LAS bf16x8*)Asrc, b0, acc);
                acc = mfma32(*(const LAS bf16x8*)(Asrc + 64), b1, acc);
            }
            const int s0 = 16 * sq + 4 * g;
#pragma unroll
            for (int i = 0; i < 4; ++i) { const bool keep = isA ? (s0 + i < t) : (s0 + i <= t); acc[i] = keep ? acc[i] : 0.f; }
            const int dst = isB ? (isA ? L_AAB : L_ARB) : (isA ? L_AAK : L_ARK);
            *(LAS v2u*)(lds + dst + t * CP + s0 * 2) = pk4(acc);
            if (isA && isB && sq == tq) *(LAS f32x4*)(lds + L_ND + tq * 1024 + fr * 64 + g * 16) = acc;
        }
    }
    LDS_BARRIER();
    if (w == 0) {
        const int bi = lane >> 4, cc = lane & 15;
        const LAS float* Nb = (const LAS float*)(lds + L_ND + bi * 1024);
        float x[16];
#pragma unroll
        for (int r = 0; r < 16; ++r) {
            float acc = (r == cc) ? 1.f : 0.f;
#pragma unroll
            for (int kq = 0; kq < (r + 3) / 4; ++kq) { const f32x4 n4 = *(const LAS f32x4*)(Nb + r * 16 + 4 * kq);
#pragma unroll
                for (int z = 0; z < 4; ++z) if (4 * kq + z < r) acc += n4[z] * x[4 * kq + z]; }
            x[r] = acc;
            *(LAS unsigned short*)(lds + L_TB + bi * 512 + r * 32 + cc * 2) = (unsigned short)f2bf(acc);
        }
    } else {
        for (int ti = w - 1; ti < 16; ti += 7) {
            const int mt = ti >> 2, nt = ti & 3;
            const LAS unsigned char* Asrc = lds + L_AAK + (16 * mt + fr) * CP + g * 16;
            const LAS unsigned char* Bsrc = lds + L_VT + (16 * nt + fr) * CP + g * 16;
            f32x4 acc = (f32x4){0.f, 0.f, 0.f, 0.f};
            acc = mfma32(*(const LAS bf16x8*)Asrc, *(const LAS bf16x8*)Bsrc, acc);
            acc = mfma32(*(const LAS bf16x8*)(Asrc + 64), *(const LAS bf16x8*)(Bsrc + 64), acc);
            *(LAS v2u*)(lds + L_W2T + (16 * nt + fr) * CP + (16 * mt + 4 * g) * 2) = pk4(acc);
        }
    }
    LDS_BARRIER();
    {
        const LAS unsigned char* rhs = lds + (w < 4 ? L_AT : L_W2T) + (16 * (w & 3) + fr) * CP;
        LAS unsigned char* xout = lds + (w < 4 ? L_PT : L_QT) + (16 * (w & 3) + fr) * CP;
        bf16x4 X[4];
#pragma unroll
        for (int bq = 0; bq < 4; ++bq) {
            const v2u rv = *(const LAS v2u*)(rhs + (16 * bq + 4 * g) * 2);
            f32x4 y = (f32x4){bflo(rv.x), bfhi(rv.x), bflo(rv.y), bfhi(rv.y)};
#pragma unroll
            for (int kb = 0; kb < bq; ++kb) {
                const bf16x4 nf = *(const LAS bf16x4*)(lds + L_AAB + (16 * bq + fr) * CP + (16 * kb + 4 * g) * 2);
                y = mfma16(nf, X[kb], y);
            }
            const v2u yb = pk4(y);
            const bf16x4 tf = *(const LAS bf16x4*)(lds + L_TB + bq * 512 + fr * 32 + g * 8);
            const f32x4 xr = mfma16(tf, __builtin_bit_cast(bf16x4, yb), (f32x4){0.f, 0.f, 0.f, 0.f});
            const v2u xb = pk4(xr);
            X[bq] = __builtin_bit_cast(bf16x4, xb);
            *(LAS v2u*)(xout + (16 * bq + 4 * g) * 2) = xb;
        }
    }
    LDS_BARRIER();
    {
        const int nt = w & 3;
        const LAS float* GL = (const LAS float*)(lds + L_GL);
        if (w < 4) {
            const LAS unsigned char* Bb = lds + L_BT + (16 * nt + fr) * CP + g * 16;
            const bf16x8 bb0 = *(const LAS bf16x8*)Bb, bb1 = *(const LAS bf16x8*)(Bb + 64);
            const LAS unsigned char* Bq = lds + L_QT + (16 * nt + fr) * CP + g * 16;
            const bf16x8 bq0 = *(const LAS bf16x8*)Bq, bq1 = *(const LAS bf16x8*)(Bq + 64);
            const LAS unsigned char* Bv = lds + L_VT + (16 * nt + fr) * CP + g * 16;
            const bf16x8 bv0 = *(const LAS bf16x8*)Bv, bv1 = *(const LAS bf16x8*)(Bv + 64);
            const int jn = 16 * nt + fr; const float glj = GL[jn];
            bf16* Mg = (bf16*)(F.ws + WS_CM) + (size_t)unit * 4096;
            float* Gg = (float*)(F.ws + WS_CG) + (size_t)unit * 4096;
#pragma unroll
            for (int mt = 0; mt < 4; ++mt) {
                const LAS unsigned char* Ap = lds + L_PT + (16 * mt + fr) * CP + g * 16;
                f32x4 acc = (f32x4){0.f, 0.f, 0.f, 0.f};
                acc = mfma32(*(const LAS bf16x8*)Ap, bb0, acc); acc = mfma32(*(const LAS bf16x8*)(Ap + 64), bb1, acc);
#pragma unroll
                for (int i = 0; i < 4; ++i) acc[i] = glj * (acc[i] + ((16 * mt + 4 * g + i == jn) ? 1.f : 0.f));
                *(GAS v2u*)(Mg + (((nt * 2 + (mt >> 1)) * 2 + (mt & 1)) * 64 + lane) * 4) = pk4(acc);
                const LAS unsigned char* Ab = lds + L_BT + (16 * mt + fr) * CP + g * 16;
                const LAS unsigned char* Ak = lds + L_KT + (16 * mt + fr) * CP + g * 16;
                f32x4 ga = (f32x4){0.f, 0.f, 0.f, 0.f};
                ga = mfma32(*(const LAS bf16x8*)Ab, bq0, ga); ga = mfma32(*(const LAS bf16x8*)(Ab + 64), bq1, ga);
                ga = mfma32(*(const LAS bf16x8*)Ak, bv0, ga); ga = mfma32(*(const LAS bf16x8*)(Ak + 64), bv1, ga);
                const f32x4 gl4 = *(const LAS f32x4*)(GL + 16 * mt + 4 * g);
                ga = ga * gl4;
                *(GAS f32x4*)(Gg + ((nt * 4 + mt) * 64 + lane) * 4) = ga;
            }
        } else {
            const LAS unsigned char* Bb = lds + L_ARB + (16 * nt + fr) * CP + g * 16;
            const bf16x8 bb0 = *(const LAS bf16x8*)Bb, bb1 = *(const LAS bf16x8*)(Bb + 64);
            const LAS unsigned char* Bk = lds + L_ARK + (16 * nt + fr) * CP + g * 16;
            const bf16x8 bk0 = *(const LAS bf16x8*)Bk, bk1 = *(const LAS bf16x8*)(Bk + 64);
            const int tn = 16 * nt + fr;
            bf16* Ryg = (bf16*)(F.ws + WS_CRY) + (size_t)unit * 4096;
            float* Ycg = (float*)(F.ws + WS_CYC) + (size_t)unit * 4096;
#pragma unroll
            for (int mt = 0; mt < 4; ++mt) {
                const LAS unsigned char* Ap = lds + L_PT + (16 * mt + fr) * CP + g * 16;
                const v2u rv = *(const LAS v2u*)(lds + L_ARR + tn * CP + (16 * mt + 4 * g) * 2);
                f32x4 acc = (f32x4){bflo(rv.x), bfhi(rv.x), bflo(rv.y), bfhi(rv.y)};
                acc = mfma32(*(const LAS bf16x8*)Ap, bb0, acc); acc = mfma32(*(const LAS bf16x8*)(Ap + 64), bb1, acc);
                *(GAS v2u*)(Ryg + ((nt * 4 + mt) * 64 + lane) * 4) = pk4(acc);
                const LAS unsigned char* Aq = lds + L_QT + (16 * mt + fr) * CP + g * 16;
                const LAS unsigned char* Av = lds + L_VT + (16 * mt + fr) * CP + g * 16;
                f32x4 ya = (f32x4){0.f, 0.f, 0.f, 0.f};
                ya = mfma32(*(const LAS bf16x8*)Aq, bb0, ya); ya = mfma32(*(const LAS bf16x8*)(Aq + 64), bb1, ya);
                ya = mfma32(*(const LAS bf16x8*)Av, bk0, ya); ya = mfma32(*(const LAS bf16x8*)(Av + 64), bk1, ya);
                *(GAS f32x4*)(Ycg + ((mt * 4 + nt) * 64 + lane) * 4) = ya;
            }
        }
    }
}
constexpr int R2_SLOT = 8192 + 16384, R2_NS = 5;
__device__ __forceinline__ void wkv_r2_head(Frame& F, int bh) {
    const int lane = F.lane, w = F.wave, nt = w & 3;
    LAS unsigned char* lds = F.lds;
    const bf16* Mg = (const bf16*)(F.ws + WS_CM) + (size_t)bh * NCHK * 4096;
    const float* Gg = (const float*)(F.ws + WS_CG) + (size_t)bh * NCHK * 4096;
    bf16* Sg = (bf16*)(F.ws + WS_CS) + (size_t)bh * NCHK * 4096;
    f32x4 S[4];
#pragma unroll
    for (int mt = 0; mt < 4; ++mt) S[mt] = (f32x4){0.f, 0.f, 0.f, 0.f};
#define R2_ISSUE(cidx) do { const int sl_ = (cidx) % R2_NS; const bf16* Mc_ = Mg + (size_t)(cidx) * 4096; const float* Gc_ = Gg + (size_t)(cidx) * 4096; \
        _Pragma("unroll") for (int i_ = 0; i_ < 2; ++i_) { const int pi_ = nt * 2 + i_; __builtin_amdgcn_global_load_lds((const GAS unsigned*)(Mc_ + pi_ * 512 + lane * 8), (LAS unsigned*)(lds + sl_ * R2_SLOT + pi_ * 1024), 16, 0, 0); } \
        _Pragma("unroll") for (int i_ = 0; i_ < 4; ++i_) { const int pi_ = nt * 4 + i_; __builtin_amdgcn_global_load_lds((const GAS unsigned*)(Gc_ + pi_ * 256 + lane * 4), (LAS unsigned*)(lds + sl_ * R2_SLOT + 8192 + pi_ * 1024), 16, 0, 0); } } while (0)
    LDS_BARRIER();
    if (w >= 4) { R2_ISSUE(0); R2_ISSUE(1); R2_ISSUE(2); R2_ISSUE(3); asm volatile("s_waitcnt vmcnt(18)" ::: "memory"); }
    LDS_BARRIER();
    for (int c = 0; c < NCHK; ++c) {
        if (w >= 4) {
            if (c + 4 < NCHK) { R2_ISSUE(c + 4); asm volatile("s_waitcnt vmcnt(18)" ::: "memory"); }
            else asm volatile("s_waitcnt vmcnt(0)" ::: "memory");
        } else {
            const LAS unsigned char* sp_ = lds + (c % R2_NS) * R2_SLOT;
            v2u sb[4];
#pragma unroll
            for (int mt = 0; mt < 4; ++mt) { sb[mt] = pk4(S[mt]); *(GAS v2u*)(Sg + (size_t)c * 4096 + ((nt * 4 + mt) * 64 + lane) * 4) = sb[mt]; }
            const bf16x8 bf0 = __builtin_bit_cast(bf16x8, (v4u){sb[0].x, sb[0].y, sb[1].x, sb[1].y});
            const bf16x8 bf1 = __builtin_bit_cast(bf16x8, (v4u){sb[2].x, sb[2].y, sb[3].x, sb[3].y});
#pragma unroll
            for (int mt = 0; mt < 4; ++mt) {
                const LAS unsigned char* mp = sp_ + ((mt * 4) * 64 + lane) * 8;
                const v2u a00 = *(const LAS v2u*)mp, a01 = *(const LAS v2u*)(mp + 512), a10 = *(const LAS v2u*)(mp + 1024), a11 = *(const LAS v2u*)(mp + 1536);
                f32x4 acc = *(const LAS f32x4*)(sp_ + 8192 + ((nt * 4 + mt) * 64 + lane) * 16);
                acc = mfma32(__builtin_bit_cast(bf16x8, (v4u){a00.x, a00.y, a01.x, a01.y}), bf0, acc);
                acc = mfma32(__builtin_bit_cast(bf16x8, (v4u){a10.x, a10.y, a11.x, a11.y}), bf1, acc);
                S[mt] = acc;
            }
        }
        LDS_BARRIER();
    }
#undef R2_ISSUE
}
__device__ __forceinline__ void wkv_r3_wave(Frame& F, int L, int unit) {
    const int c = unit % NCHK, bh = unit / NCHK, h = bh % NH, b = bh / NH;
    const int lane = F.lane, fr = lane & 15, g = lane >> 4;
    const bf16* Sg = (const bf16*)(F.ws + WS_CS) + (size_t)unit * 4096;
    const bf16* Ryg = (const bf16*)(F.ws + WS_CRY) + (size_t)unit * 4096;
    const float* Ycg = (const float*)(F.ws + WS_CYC) + (size_t)unit * 4096;
    const bf16* SV = (const bf16*)(F.ws + WS_SV); const bf16* SG = (const bf16*)(F.ws + WS_SG); const float* BON = (const float*)(F.ws + WS_BON);
    bf16* YC = (bf16*)(F.ws + WS_YC);
    const float* lg = INP(I_LNG) + (size_t)L * C + h * HD; const float* lb = INP(I_LNB) + (size_t)L * C + h * HD;
    const size_t tok0 = (size_t)b * SEQ + (size_t)c * 64;
    bf16x8 sa[4][2];
#pragma unroll
    for (int mt = 0; mt < 4; ++mt)
#pragma unroll
        for (int ks = 0; ks < 2; ++ks) { const v2u s0 = *(const GAS v2u*)(Sg + ((mt * 4 + 2 * ks) * 64 + lane) * 4), s1 = *(const GAS v2u*)(Sg + ((mt * 4 + 2 * ks + 1) * 64 + lane) * 4);
            sa[mt][ks] = __builtin_bit_cast(bf16x8, (v4u){s0.x, s0.y, s1.x, s1.y}); }
    f32x4 lgv[4], lbv[4];
#pragma unroll
    for (int mt = 0; mt < 4; ++mt) { lgv[mt] = *(const GAS f32x4*)(lg + 16 * mt + 4 * g); lbv[mt] = *(const GAS f32x4*)(lb + 16 * mt + 4 * g); }
#pragma unroll
    for (int nt = 0; nt < 4; ++nt) {
        const int t = 16 * nt + fr;
        const v2u r00 = *(const GAS v2u*)(Ryg + ((nt * 4 + 0) * 64 + lane) * 4), r01 = *(const GAS v2u*)(Ryg + ((nt * 4 + 1) * 64 + lane) * 4), r10 = *(const GAS v2u*)(Ryg + ((nt * 4 + 2) * 64 + lane) * 4), r11 = *(const GAS v2u*)(Ryg + ((nt * 4 + 3) * 64 + lane) * 4);
        const bf16x8 rb0 = __builtin_bit_cast(bf16x8, (v4u){r00.x, r00.y, r01.x, r01.y}), rb1 = __builtin_bit_cast(bf16x8, (v4u){r10.x, r10.y, r11.x, r11.y});
        f32x4 y[4]; float s = 0.f;
#pragma unroll
        for (int mt = 0; mt < 4; ++mt) {
            f32x4 acc = *(const GAS f32x4*)(Ycg + ((mt * 4 + nt) * 64 + lane) * 4);
            acc = mfma32(sa[mt][0], rb0, acc); acc = mfma32(sa[mt][1], rb1, acc);
            y[mt] = acc; s += (acc[0] + acc[1]) + (acc[2] + acc[3]);
        }
        s += __shfl_xor(s, 16); s += __shfl_xor(s, 32);
        const float mean = s * (1.f / HD); float q = 0.f;
#pragma unroll
        for (int mt = 0; mt < 4; ++mt) { y[mt] = y[mt] - mean; q += (y[mt][0] * y[mt][0] + y[mt][1] * y[mt][1]) + (y[mt][2] * y[mt][2] + y[mt][3] * y[mt][3]); }
        q += __shfl_xor(q, 16); q += __shfl_xor(q, 32);
        const float rstd = 1.0f / sqrtf(q * (1.f / HD) + LNX_EPS);
        const float bon = BON[(tok0 + t) * NH + h];
#pragma unroll
        for (int mt = 0; mt < 4; ++mt) {
            const size_t o = (tok0 + t) * C + h * HD + 16 * mt + 4 * g;
            const v2u vv = *(const GAS v2u*)(SV + o), gg = *(const GAS v2u*)(SG + o);
            f32x4 r;
            r[0] = (y[mt][0] * rstd * lgv[mt][0] + lbv[mt][0] + bon * bflo(vv.x)) * bflo(gg.x);
            r[1] = (y[mt][1] * rstd * lgv[mt][1] + lbv[mt][1] + bon * bfhi(vv.x)) * bfhi(gg.x);
            r[2] = (y[mt][2] * rstd * lgv[mt][2] + lbv[mt][2] + bon * bflo(vv.y)) * bflo(gg.y);
            r[3] = (y[mt][3] * rstd * lgv[mt][3] + lbv[mt][3] + bon * bfhi(vv.y)) * bfhi(gg.y);
            *(GAS v2u*)(YC + (tok0 + t) * D + h * HD + 16 * mt + 4 * g) = pk4(r);
        }
    }
}

__device__ __forceinline__ int crow(int r, int hi) { return (r & 3) + 8 * (r >> 2) + 4 * hi; }
typedef short s16x4 __attribute__((ext_vector_type(4)));
typedef float f32x2_t __attribute__((ext_vector_type(2))); typedef __bf16 bf16x2_t __attribute__((ext_vector_type(2)));
__device__ __forceinline__ unsigned cvtpk(float lo, float hi) { f32x2_t v = {lo, hi}; bf16x2_t b = __builtin_convertvector(v, bf16x2_t); return __builtin_bit_cast(unsigned, b); }
__device__ __forceinline__ s16x4 vtr(const LAS unsigned char* p) { return __builtin_bit_cast(s16x4, __builtin_amdgcn_ds_read_tr16_b64_v4i16((LAS s16x4*)p)); }
constexpr float ATT_THR = 6.0f;
constexpr int A_KB = 0, A_VB = 65536, A_KM = 131072;
__device__ __forceinline__ void attn2_unit(Frame& F, int b, int h, int qb, int half) {
    const bf16* AQ = (const bf16*)(F.ws + WS_AQ); const bf16* AKp = (const bf16*)(F.ws + WS_AK); const bf16* Z = (const bf16*)(F.ws + WS_Z); const float* KM = (const float*)(F.ws + WS_KM);
    bf16* YC = (bf16*)(F.ws + WS_YC);
    const int tid = F.tid, lane = F.lane, w = F.wave, qg = w & 3, kvh = w >> 2, r32 = lane & 31, hi = lane >> 5;
    LAS unsigned char* lds = F.lds;
    const size_t tb = (size_t)b * SEQ; const int q0w = qb * MB + 128 * half + 32 * qg;
    LDS_BARRIER();
    for (int i = tid; i < NBLK * AD; i += NTHR) { const float v = KM[(size_t)(b * AH + h) * NBLK * AD + i]; const unsigned hb = f2bf(v); const float rem = v - __builtin_bit_cast(float, hb << 16);
        ((LAS unsigned short*)(lds + A_KM))[i] = (unsigned short)hb; ((LAS unsigned short*)(lds + A_KM + 4096))[i] = (unsigned short)f2bf(rem); }
    bf16x8 qr[8];
    { const bf16* Qp = AQ + (tb + q0w + r32) * C + h * AD + hi * 8;
#pragma unroll
      for (int d0 = 0; d0 < 8; ++d0) qr[d0] = *(const GAS bf16x8*)(Qp + d0 * 16); }
    const int n_own = half ? 2 : 1, NS = n_own + 2 * qb;
    const bf16* Kg = AKp + tb * C + h * AD; const bf16* Vg = Z + tb * NZ + ZV + h * AD;
#define STEP_KB(si) (((si) < n_own) ? (qb * MB + 128 * (si)) : ((((si) - n_own) >> 1) * MB + 128 * (((si) - n_own) & 1)))
    const int dl_r = lane >> 4, dl_cs = lane & 15;
#define ATT_LOAD(si, bi) do { const int kb_ = STEP_KB(si); _Pragma("unroll") for (int i_ = 0; i_ < 4; ++i_) { const int pi_ = w + 8 * i_; const int row_ = 4 * pi_ + dl_r; \
        __builtin_amdgcn_global_load_lds((const GAS unsigned*)(Kg + (size_t)(kb_ + row_) * C + ((dl_cs ^ (row_ & 15)) << 3)), (LAS unsigned*)(lds + A_KB + (bi) * 32768 + pi_ * 1024), 16, 0, 0); \
        __builtin_amdgcn_global_load_lds((const GAS unsigned*)(Vg + (size_t)(kb_ + row_) * NZ + ((dl_cs ^ ((row_ & 3) << 2)) << 3)), (LAS unsigned*)(lds + A_VB + (bi) * 32768 + pi_ * 1024), 16, 0, 0); } } while (0)
    ATT_LOAD(0, 0);
    LDS_BARRIER();
    unsigned selmask;
    {
        f32x16 ga = (f32x16){0.f};
        const bool rowok = r32 < 16;
#pragma unroll
        for (int d0 = 0; d0 < 8; ++d0) {
            const LAS unsigned char* kp = lds + A_KM + (r32 & 15) * 256 + d0 * 32 + hi * 16;
            bf16x8 ah = *(const LAS bf16x8*)kp, al = *(const LAS bf16x8*)(kp + 4096);
            if (!rowok) { ah = (bf16x8){0, 0, 0, 0, 0, 0, 0, 0}; al = ah; }
            ga = __builtin_amdgcn_mfma_f32_32x32x16_bf16(ah, qr[d0], ga, 0, 0, 0);
            ga = __builtin_amdgcn_mfma_f32_32x32x16_bf16(al, qr[d0], ga, 0, 0, 0);
        }
        float gt[16];
#pragma unroll
        for (int r = 0; r < 4; ++r) { const float o0 = __shfl_xor(ga[r], 32), o1 = __shfl_xor(ga[4 + r], 32);
            gt[r] = hi ? o0 : ga[r]; gt[4 + r] = hi ? ga[r] : o0; gt[8 + r] = hi ? o1 : ga[4 + r]; gt[12 + r] = hi ? ga[4 + r] : o1; }
        float g1 = -INFINITY, g2 = -INFINITY, g3 = -INFINITY; int i1 = 0, i2 = 0, i3 = 0;
#pragma unroll
        for (int n = 0; n < 16; ++n) { if (n < qb) { const float g = gt[n];
            if (g > g1) { g3 = g2; i3 = i2; g2 = g1; i2 = i1; g1 = g; i1 = n; }
            else if (g > g2) { g3 = g2; i3 = i2; g2 = g; i2 = n; }
            else if (g > g3) { g3 = g; i3 = n; } } }
        selmask = (qb <= 3) ? ((1u << qb) - 1u) : ((1u << i1) | (1u << i2) | (1u << i3));
    }
    f32x16 O[4];
#pragma unroll
    for (int dt = 0; dt < 4; ++dt) O[dt] = (f32x16){0.f};
    float m_run = -1e30f, l_run = 0.f;
    VM_WAIT();
    LDS_BARRIER();
    const int qpos = q0w + r32;
    const int trq = (lane & 15) >> 2, trp = lane & 3, trg = (lane >> 4) & 1;
    for (int si = 0; si < NS; ++si) {
        if (si + 1 < NS) ATT_LOAD(si + 1, (si + 1) & 1);
        const bool own = si < n_own;
        const int kt = STEP_KB(si) + 64 * kvh;
        const bool skip = own && (kt > q0w + 31);
        if (!skip) {
            const LAS unsigned char* kb_ = lds + A_KB + (si & 1) * 32768 + (64 * kvh) * 256;
            const LAS unsigned char* vb_ = lds + A_VB + (si & 1) * 32768 + (64 * kvh) * 256;
            f32x16 p[2];
#pragma unroll
            for (int kb2 = 0; kb2 < 2; ++kb2) {
                f32x16 acc = (f32x16){0.f};
                const int row = 32 * kb2 + r32;
#pragma unroll
                for (int d0 = 0; d0 < 8; ++d0) {
                    const bf16x8 kf = *(const LAS bf16x8*)(kb_ + row * 256 + (((2 * d0 + hi) ^ (row & 15)) << 4));
                    acc = __builtin_amdgcn_mfma_f32_32x32x16_bf16(kf, qr[d0], acc, 0, 0, 0);
                }
                p[kb2] = acc;
            }
            if (own && (kt + 63 > q0w)) {
#pragma unroll
                for (int kb2 = 0; kb2 < 2; ++kb2)
#pragma unroll
                    for (int r = 0; r < 16; ++r) { const int kpos = kt + 32 * kb2 + crow(r, hi); p[kb2][r] = (kpos <= qpos) ? p[kb2][r] : -1e30f; }
            }
            const bool ok = own || ((selmask >> ((si - n_own) >> 1)) & 1u);
            float mx = fmaxf(p[0][0], p[1][0]);
#pragma unroll
            for (int r = 1; r < 16; ++r) mx = fmaxf(mx, fmaxf(p[0][r], p[1][r]));
            mx = fmaxf(mx, __shfl_xor(mx, 32));
            mx = ok ? mx : -1e30f;
            if (__any(mx > m_run + ATT_THR)) {
                const float m_new = fmaxf(m_run, mx); const float alpha = __builtin_amdgcn_exp2f(m_run - m_new);
                m_run = m_new; l_run *= alpha;
#pragma unroll
                for (int dt = 0; dt < 4; ++dt)
#pragma unroll
                    for (int r = 0; r < 16; ++r) O[dt][r] *= alpha;
            }
            float ls = 0.f;
#pragma unroll
            for (int kb2 = 0; kb2 < 2; ++kb2)
#pragma unroll
                for (int r = 0; r < 16; ++r) { const float e = __builtin_amdgcn_exp2f(p[kb2][r] - m_run); p[kb2][r] = e; ls += e; }
            l_run += ok ? ls : 0.f;
            const unsigned okm = ok ? 0xffffffffu : 0u;
#pragma unroll
            for (int kb2 = 0; kb2 < 2; ++kb2)
#pragma unroll
                for (int s = 0; s < 2; ++s) {
                    v4u pw; pw.x = cvtpk(p[kb2][8 * s + 0], p[kb2][8 * s + 1]) & okm; pw.y = cvtpk(p[kb2][8 * s + 2], p[kb2][8 * s + 3]) & okm;
                    pw.z = cvtpk(p[kb2][8 * s + 4], p[kb2][8 * s + 5]) & okm; pw.w = cvtpk(p[kb2][8 * s + 6], p[kb2][8 * s + 7]) & okm;
                    const bf16x8 pf = __builtin_bit_cast(bf16x8, pw);
                    const int key0 = 32 * kb2 + 16 * s + 4 * hi + trq;
#pragma unroll
                    for (int dt = 0; dt < 4; ++dt) {
                        const int dby = (32 * dt + 16 * trg + 4 * trp) * 2;
                        const s16x4 lo = vtr(vb_ + key0 * 256 + (dby ^ ((key0 & 3) << 6)));
                        const s16x4 hi4 = vtr(vb_ + (key0 + 8) * 256 + (dby ^ (((key0 + 8) & 3) << 6)));
                        const bf16x8 vf = (bf16x8){lo[0], lo[1], lo[2], lo[3], hi4[0], hi4[1], hi4[2], hi4[3]};
                        O[dt] = __builtin_amdgcn_mfma_f32_32x32x16_bf16(vf, pf, O[dt], 0, 0, 0);
                    }
                }
        }
        VM_WAIT();
        LDS_BARRIER();
    }
    LAS float* cb = (LAS float*)lds + (size_t)qg * 64 * 67;
    if (kvh == 1) {
        LAS float* cp = cb + lane * 67;
        cp[64] = m_run; cp[65] = l_run;
#pragma unroll
        for (int dt = 0; dt < 4; ++dt)
#pragma unroll
            for (int r = 0; r < 16; ++r) cp[dt * 16 + r] = O[dt][r];
    }
    LDS_BARRIER();
    if (kvh == 0) {
        const LAS float* cp = cb + lane * 67;
        const float m1 = cp[64], l1 = cp[65];
        const float m = fmaxf(m_run, m1); const float a0 = __builtin_amdgcn_exp2f(m_run - m), a1 = __builtin_amdgcn_exp2f(m1 - m);
        float l = l_run * a0 + l1 * a1; l += __shfl_xor(l, 32);
        const float inv = 1.0f / l;
#pragma unroll
        for (int dt = 0; dt < 4; ++dt)
#pragma unroll
            for (int r = 0; r < 16; ++r) O[dt][r] = (O[dt][r] * a0 + cp[dt * 16 + r] * a1) * inv;
    }
    LDS_BARRIER();
    if (kvh == 0) {
        LAS unsigned char* st = lds + 69632 + qg * (32 * 272);
#pragma unroll
        for (int dt = 0; dt < 4; ++dt)
#pragma unroll
            for (int rq = 0; rq < 4; ++rq) { v2u wv; wv.x = cvtpk(O[dt][4 * rq], O[dt][4 * rq + 1]); wv.y = cvtpk(O[dt][4 * rq + 2], O[dt][4 * rq + 3]);
                *(LAS v2u*)(st + r32 * 272 + (32 * dt + 8 * rq + 4 * hi) * 2) = wv; }
        LDS_WAIT(); asm volatile("" ::: "memory");
#pragma unroll
        for (int i = 0; i < 8; ++i) { const int row = i * 4 + (lane >> 4), ch = lane & 15;
            const v4u v = *(const LAS v4u*)(st + row * 272 + ch * 16);
            *(GAS v4u*)(YC + (tb + q0w + row) * D + C + h * AD + ch * 8) = v; }
    }
#undef STEP_KB
#undef ATT_LOAD
}
__device__ __forceinline__ void ph_wkv_r1(Frame& F, int L) { const int upc = (NUNIT + F.G - 1) / F.G; for (int k = 0; k < upc; ++k) { const int u = F.vcu * upc + k; if (u < NUNIT) wkv_r1_unit(F, L, u); } }
__device__ __forceinline__ void ph_wkv_r2(Frame& F) { for (int bh = F.vcu; bh < BATCH * NH; bh += F.G) wkv_r2_head(F, bh); }
__device__ __forceinline__ void ph_mixer(Frame& F, int L) {
    for (int u = F.vcu * NWAVES + F.wave; u < NUNIT; u += F.G * NWAVES) wkv_r3_wave(F, L, u);
    for (int it = F.vcu; it < BATCH * AH * NBLK; it += F.G) { const int bh = it >> 4, rem = it & 15, qlo = rem >> 1, hf = rem & 1;
        for (int k = 0; k < 2; ++k) attn2_unit(F, bh / AH, bh % AH, k ? qlo : NBLK - 1 - qlo, k ? hf : 1 - hf); }
}

constexpr int PH_PER_LAYER = 11, NPHASE = DEPTH * PH_PER_LAYER;
#ifndef MK_N_LAUNCHES
#define MK_N_LAUNCHES 1
#endif
struct Args { const float* in[24]; float* out; unsigned char* ws; int ph_lo, ph_hi, li, pad; };
__global__ void __launch_bounds__(NTHR, 2) mega_fwd(Args args) {
    extern __shared__ __attribute__((aligned(16))) unsigned char lds[];
    Frame F;
    F.lds = (LAS unsigned char*)lds;
    F.MISC = (volatile LAS unsigned*)(F.lds + MISC_OFF);
    F.tid = threadIdx.x; F.lane = F.tid & 63; F.wave = __builtin_amdgcn_readfirstlane(F.tid >> 6);
    F.G = gridDim.x; { const int bx = blockIdx.x; F.vcu = (F.G % 8 == 0) ? (bx % 8) * (F.G / 8) + bx / 8 : bx; }
    F.ws = args.ws; F.out = args.out; F.ctl = (gu32*)(args.ws + WS_CTL);
    for (int u = F.tid; u < (LDS_BYTES - LDSCTL_OFF) / 4; u += NTHR) ((LAS unsigned*)(F.lds + LDSCTL_OFF))[u] = 0u;
    __syncthreads();
    if (F.tid < 24) *(LAS unsigned long long*)(F.lds + PTAB_OFF + 8 * F.tid) = (unsigned long long)args.in[F.tid];
    __syncthreads();
    XcdBarrier bar; bar.bar = (unsigned*)(F.ctl + CW_BAR) + args.li * XCD_BAR_WORDS; bar.x = 0; bar.st = nullptr;
    const bool one_launch = (args.ph_hi - args.ph_lo) > 1;
    if (one_launch) bar = xcd_barrier_post((unsigned*)(F.ctl + CW_BAR) + args.li * XCD_BAR_WORDS, F.MISC + 8);
    bf16* HN = (bf16*)(F.ws + WS_HN); bf16* YC = (bf16*)(F.ws + WS_YC); bf16* Zb = (bf16*)(F.ws + WS_Z); bf16* U = (bf16*)(F.ws + WS_U);
    float* Y2 = (float*)(F.ws + WS_Y2); float* Mo = (float*)(F.ws + WS_M);
#ifdef PROBE_DUP_MASK
    bool dup_done = false;
#endif
    for (int ph = args.ph_lo; ph < args.ph_hi; ++ph) {
        const int L = ph / PH_PER_LAYER, p = ph % PH_PER_LAYER;
        { int t_ = threadIdx.x; asm volatile("" : "+v"(t_)); F.tid = t_; F.lane = t_ & 63; F.wave = __builtin_amdgcn_readfirstlane(t_ >> 6); }
        { unsigned long long w_ = (unsigned long long)args.ws, o_ = (unsigned long long)args.out; asm volatile("" : "+s"(w_), "+s"(o_)); F.ws = (unsigned char*)(GAS unsigned char*)w_; F.out = (float*)(GAS float*)o_; F.ctl = (gu32*)w_; }
        { int g_ = gridDim.x, b_ = blockIdx.x; asm volatile("" : "+s"(g_), "+s"(b_)); F.G = g_; F.bx = b_; F.vcu = (g_ % 8 == 0) ? (b_ % 8) * (g_ / 8) + b_ / 8 : b_; }
        { unsigned l_ = (unsigned)(unsigned long long)(LAS unsigned char*)lds; asm volatile("" : "+s"(l_)); F.lds = (LAS unsigned char*)(unsigned long long)l_; }
        switch (p) {
        case 0: ph_convert(F, L); break;
        case 1: { pg8::Gemm g{HN, (const bf16*)(F.ws + WS_WIN), T, (L == 0) ? NIN : NZ, D}; pg8::StaticOrder S; S.init(T, (L == 0) ? NIN : NZ, F.G, F.bx);
                  pg8::EpiBf16<0> E{Zb, NZ}; pg8::gemm_phase<pg8::EpiBf16<0>, pg8::StaticOrder, true, true>(F.lds, g, S, E, F.tid); } break;
        case 2: ph_prep(F, L); break;
        case 3: ph_wkv_r1(F, L); break;
        case 4: ph_wkv_r2(F); break;
        case 5: ph_mixer(F, L); break;
        case 6: { pg8::Gemm g{YC, (const bf16*)(F.ws + WS_WOUT), T, D, D}; pg8::StaticOrder S; S.init(T, D, F.G, F.bx);
                  pg8::EpiF32 E{Y2, D}; pg8::gemm_phase<pg8::EpiF32, pg8::StaticOrder, true, true>(F.lds, g, S, E, F.tid); } break;
        case 7: ph_resnorm(F, Y2, (L == 0) ? INP(I_X) : F.out, INP(I_NMIXPOST) + (size_t)L * D, INP(I_NMLPPRE) + (size_t)L * D, F.out, HN); break;
        case 8: { pg8::Gemm g{HN, (const bf16*)(F.ws + WS_WUP), T, FF, D}; pg8::StaticOrder S; S.init(T, FF, F.G, F.bx);
                  pg8::EpiBf16<2> E{U, FF}; pg8::gemm_phase<pg8::EpiBf16<2>, pg8::StaticOrder, true, true>(F.lds, g, S, E, F.tid); } break;
        case 9: { pg8::Gemm g{U, (const bf16*)(F.ws + WS_WDN), T, D, FF}; pg8::StaticOrder S; S.init(T, D, F.G, F.bx);
                  pg8::EpiF32 E{Mo, D}; pg8::gemm_phase<pg8::EpiF32, pg8::StaticOrder, true, true>(F.lds, g, S, E, F.tid); } break;
        case 10: ph_resnorm(F, Mo, F.out, INP(I_NMLPPOST) + (size_t)L * D, (L + 1 < DEPTH) ? INP(I_NMIXPRE) + (size_t)(L + 1) * D : nullptr, F.out, HN); break;
        }
        if (ph + 1 < args.ph_hi) xcd_barrier(bar);
#ifdef PROBE_DUP_MASK
        if (((PROBE_DUP_MASK >> p) & 1) && !dup_done) { dup_done = true; --ph; } else dup_done = false;
#endif
    }
}

extern "C" void kernel_launch(void* const* d_in, const int* in_sizes, int n_in, void* d_out, int out_size, void* d_ws, size_t ws_size, hipStream_t stream) {
    static int grid = 0;
    if (grid == 0) {
        if (n_in != 24 || in_sizes[0] != T * D || out_size != T * D || ws_size < WS_END) { fprintf(stderr, "kernel_launch: unexpected shapes (n_in %d, in0 %d, out %d, ws %zu)\n", n_in, n_in > 0 ? in_sizes[0] : -1, out_size, ws_size); grid = -1; return; }
        int dev = 0, cus = 0, per_cu = 0;
        if (hipGetDevice(&dev) != hipSuccess || hipDeviceGetAttribute(&cus, hipDeviceAttributeMultiprocessorCount, dev) != hipSuccess) { grid = -1; return; }
        if (hipFuncSetAttribute((const void*)mega_fwd, hipFuncAttributeMaxDynamicSharedMemorySize, LDS_BYTES) != hipSuccess) { fprintf(stderr, "kernel_launch: hipFuncSetAttribute failed\n"); grid = -1; return; }
        if (hipOccupancyMaxActiveBlocksPerMultiprocessor(&per_cu, (const void*)mega_fwd, NTHR, LDS_BYTES) != hipSuccess || per_cu < 1) { fprintf(stderr, "kernel_launch: occupancy query says %d\n", per_cu); per_cu = 1; }
        (void)hipGetLastError();
        grid = cus * (per_cu > 1 ? 1 : per_cu);
    }
    if (grid < 0) return;
    (void)hipMemsetAsync((char*)d_ws + WS_CTL, 0, CTL_ZERO_BYTES, stream);
    Args a{};
    for (int i = 0; i < 24; ++i) a.in[i] = (const float*)d_in[i];
    a.out = (float*)d_out; a.ws = (unsigned char*)d_ws;
    const int nl = MK_N_LAUNCHES;
    for (int li = 0; li < nl; ++li) {
        a.li = li; a.ph_lo = (int)((long)NPHASE * li / nl); a.ph_hi = (int)((long)NPHASE * (li + 1) / nl);
        if (a.ph_hi - a.ph_lo > 1) {
            void* kargs[] = {&a};
            hipError_t e = hipLaunchCooperativeKernel((const void*)mega_fwd, dim3(grid), dim3(NTHR), kargs, LDS_BYTES, stream);
            if (e != hipSuccess) fprintf(stderr, "kernel_launch: cooperative launch failed: %s (grid %d)\n", hipGetErrorString(e), grid);
        } else {
            hipLaunchKernelGGL(mega_fwd, dim3(grid), dim3(NTHR), LDS_BYTES, stream, a);
        }
    }
}
```

```cpp
#include <hip/hip_runtime.h>
#include <cstdio>
#include <cstdint>
namespace pg8 {
#define PG8_LAS __attribute__((address_space(3)))
typedef unsigned short bf16_t;
typedef short bf16x8 __attribute__((ext_vector_type(8)));
typedef float f32x4 __attribute__((ext_vector_type(4)));
typedef unsigned u32x4 __attribute__((ext_vector_type(4)));
constexpr int BM = 256, BK = 64, HALF = 128, HTB = HALF * BK * 2  , STAGE_BYTES = 8 * HTB, NXCD = 8, WGM = 8;

__host__ __device__ __forceinline__ int lds_byte(int r, int c) { const int st = (r >> 4) * 2 + (c >> 5), rr = r & 15, cc = c & 31, ob = rr * 64 + cc * 2; return st * 1024 + (ob ^ (((ob >> 9) & 1) << 5)); }
__host__ __device__ __forceinline__ void stage_rc(int b, int& R, int& C) { const int st = b / 1024, sb = b % 1024, swz = sb ^ (((sb >> 9) & 1) << 5); R = (st >> 1) * 16 + swz / 64; C = (st & 1) * 32 + (swz % 64) / 2; }
__host__ __device__ __forceinline__ int perm32(int rho) { const int n = rho >> 4, i = rho & 15; return 8 * (i >> 2) + 4 * n + (i & 3); }

struct Unit { int pm, pn; };
struct Gemm { const bf16_t* A; const bf16_t* Bt; int M, N, K; };

struct StaticOrder {
    int nM, nN, nwg, G, c;
    __host__ __device__ void init(int M, int N, int G_, int c_) { nM = M / BM; nN = N / BM; nwg = nM * nN; G = G_; c = c_; }
    __host__ __device__ bool next(int i, Unit& u) const {
        const long L = (long)i * G + c; if (L >= nwg) return false;
        int wgid = (int)L; { const int q = nwg / NXCD, r = nwg % NXCD, xcd = wgid % NXCD, off = wgid / NXCD; wgid = (xcd < r ? xcd * (q + 1) : r * (q + 1) + (xcd - r) * q) + off; }
        const int nig = WGM * nN, gid = wgid / nig, fm = gid * WGM, gsz = (nM - fm) < WGM ? (nM - fm) : WGM;
        u.pm = fm + ((wgid % nig) % gsz); u.pn = (wgid % nig) / gsz; return true;
    }
    __device__ __forceinline__ void a_ready(const Unit&) const {}
    __device__ __forceinline__ void done(const Unit&) const {}
};

__device__ __forceinline__ unsigned cvt_pk_bf16(float lo, float hi) { unsigned r; asm volatile("v_cvt_pk_bf16_f32 %0, %1, %2" : "=v"(r) : "v"(lo), "v"(hi)); return r; }
struct EpiF32 {
    static constexpr bool PERM = false, AFTER_DRAIN = false;
    float* C; int ldc;
    __device__ __forceinline__ void operator()(const f32x4 (&acc)[2][2][4][2], const Unit& u, int wr, int wc, int fr, int fq) const {
        const int row0 = u.pm * BM + wr * 64 + fr, col0 = u.pn * BM + wc * 32 + 4 * fq;
#pragma unroll
        for (int ai = 0; ai < 2; ++ai)
#pragma unroll
            for (int m = 0; m < 4; ++m) { float* rowp = C + (size_t)(row0 + ai * HALF + m * 16) * ldc + col0;
#pragma unroll
                for (int bj = 0; bj < 2; ++bj)
#pragma unroll
                    for (int n = 0; n < 2; ++n) *(f32x4*)(rowp + bj * HALF + n * 16) = acc[ai][bj][m][n]; }
    }
};
template <int ACT  > struct EpiBf16 {
    static constexpr bool PERM = true, AFTER_DRAIN = false;
    bf16_t* O; int ldc;
    __device__ __forceinline__ void operator()(const f32x4 (&acc)[2][2][4][2], const Unit& u, int wr, int wc, int fr, int fq) const {
        const int row0 = u.pm * BM + wr * 64 + fr; const int col0 = u.pn * BM + wc * 32 + 8 * fq;
#pragma unroll
        for (int ai = 0; ai < 2; ++ai)
#pragma unroll
            for (int m = 0; m < 4; ++m) { bf16_t* rowp = O + (size_t)(row0 + ai * HALF + m * 16) * ldc + col0;
#pragma unroll
                for (int bj = 0; bj < 2; ++bj) { f32x4 v0 = acc[ai][bj][m][0], v1 = acc[ai][bj][m][1];
                    if (ACT == 2) {
#pragma unroll
                        for (int e = 0; e < 4; ++e) { float a = v0[e] > 0.f ? v0[e] : 0.f; v0[e] = a * a; float b = v1[e] > 0.f ? v1[e] : 0.f; v1[e] = b * b; } }
                    u32x4 w; w.x = cvt_pk_bf16(v0[0], v0[1]); w.y = cvt_pk_bf16(v0[2], v0[3]); w.z = cvt_pk_bf16(v1[0], v1[1]); w.w = cvt_pk_bf16(v1[2], v1[3]);
                    *(u32x4*)(rowp + bj * HALF) = w; } }
    }
};

template <class Epi, class Sched, bool ALIGN_EPI = false, bool SP2 = false>
__device__ __forceinline__ void gemm_phase(PG8_LAS unsigned char* lds, const Gemm g, const Sched& S, const Epi& E, const int tid) {
    const int wid = __builtin_amdgcn_readfirstlane(tid >> 6), lane = tid & 63, wr = wid >> 2, wc = wid & 3, fr = lane & 15, fq = lane >> 4;
    const int K = g.K, nt = K / BK;
    unsigned voffA[2], voffB[2];
#pragma unroll
    for (int i = 0; i < 2; ++i) { int R, C; stage_rc(tid * 16 + i * 8192, R, C); const int Rb = Epi::PERM ? ((R & ~31) + perm32(R & 31)) : R;
        voffA[i] = (unsigned)(R * K + C) * 2u; voffB[i] = (unsigned)(Rb * K + C) * 2u; }
    const size_t kstep = (size_t)(BK * 2);
    const size_t hstep = (size_t)HALF * K * 2;
    const size_t tstep = 2 * hstep;
    const unsigned ldsw = (unsigned)wid * 1024u;
    const int aoff = lds_byte(wr * 64 + fr, fq * 8), boff = lds_byte(wc * 32 + fr, fq * 8);
#define PG8_SA(b, h) (((b) * 2 + (h)) * HTB)
#define PG8_SB(b, h) ((4 + (b) * 2 + (h)) * HTB)
#define PG8_STAGE(bufoff, gbase, voff) do { _Pragma("unroll") for (int _i = 0; _i < 2; ++_i) \
        __builtin_amdgcn_global_load_lds((const unsigned*)((const char*)(gbase) + (voff)[_i]), (PG8_LAS unsigned*)(lds + (bufoff) + ldsw + _i * 8192), 16, 0, 0); } while (0)
#define PG8_LDA(dst, b, h) do { _Pragma("unroll") for (int m = 0; m < 4; ++m) _Pragma("unroll") for (int k = 0; k < 2; ++k) dst[m][k] = *(const PG8_LAS bf16x8*)(lds + PG8_SA(b, h) + aoff + m * 2048 + k * 1024); } while (0)
#define PG8_LDB(dst, b, h) do { _Pragma("unroll") for (int n = 0; n < 2; ++n) _Pragma("unroll") for (int k = 0; k < 2; ++k) dst[n][k] = *(const PG8_LAS bf16x8*)(lds + PG8_SB(b, h) + boff + n * 2048 + k * 1024); } while (0)
#define PG8_MMA(ai, bj, At, Bt) do { __builtin_amdgcn_s_setprio(1); _Pragma("unroll") for (int m = 0; m < 4; ++m) _Pragma("unroll") for (int n = 0; n < 2; ++n) _Pragma("unroll") for (int k = 0; k < 2; ++k) \
        acc[ai][bj][m][n] = __builtin_amdgcn_mfma_f32_16x16x32_bf16(Bt[n][k], At[m][k], acc[ai][bj][m][n], 0, 0, 0); __builtin_amdgcn_s_setprio(0); } while (0)
#define PG8_WAIT_V(n) asm volatile("s_waitcnt vmcnt(" #n ")" ::: "memory")
#define PG8_WAIT_L(n) asm volatile("s_waitcnt lgkmcnt(" #n ")" ::: "memory")
#define PG8_BAR __builtin_amdgcn_s_barrier()
#define PG8_SCHED __builtin_amdgcn_sched_barrier(0)
    Unit cur, nxt; int ui = 0;
    if (!S.next(0, cur)) return;
    f32x4 acc[2][2][4][2];
#pragma unroll
    for (int a = 0; a < 2; ++a)
#pragma unroll
        for (int b = 0; b < 2; ++b)
#pragma unroll
            for (int m = 0; m < 4; ++m)
#pragma unroll
                for (int n = 0; n < 2; ++n) acc[a][b][m][n] = (f32x4){0.f, 0.f, 0.f, 0.f};
    bf16x8 At[4][2], B0[2][2], B1[2][2];
    const char* cA = (const char*)g.A + (size_t)cur.pm * tstep; const char* cB = (const char*)g.Bt + (size_t)cur.pn * tstep;
    S.a_ready(cur);
    if constexpr (SP2) {
        PG8_STAGE(PG8_SB(0, 0), cB, voffB); PG8_STAGE(PG8_SB(0, 1), cB + hstep, voffB); PG8_STAGE(PG8_SA(0, 0), cA, voffA); PG8_STAGE(PG8_SA(0, 1), cA + hstep, voffA);
        if (wr == 1) PG8_BAR;
        PG8_WAIT_V(2); PG8_BAR;
        PG8_STAGE(PG8_SB(1, 0), cB + kstep, voffB); PG8_STAGE(PG8_SA(1, 0), cA + kstep, voffA); PG8_STAGE(PG8_SB(1, 1), cB + hstep + kstep, voffB);
        PG8_WAIT_V(6); PG8_BAR;
    } else {
        PG8_STAGE(PG8_SB(0, 0), cB, voffB); PG8_STAGE(PG8_SA(0, 0), cA, voffA); PG8_STAGE(PG8_SB(0, 1), cB + hstep, voffB); PG8_STAGE(PG8_SA(0, 1), cA + hstep, voffA);
        if (wr == 1) PG8_BAR;
        PG8_WAIT_V(4); PG8_BAR;
        PG8_STAGE(PG8_SB(1, 0), cB + kstep, voffB); PG8_STAGE(PG8_SA(1, 0), cA + kstep, voffA); PG8_STAGE(PG8_SB(1, 1), cB + hstep + kstep, voffB);
        PG8_WAIT_V(6); PG8_BAR;
    }
    for (;;) {
        const bool has_next = S.next(ui + 1, nxt);
        const char* nA = has_next ? (const char*)g.A + (size_t)nxt.pm * tstep : cA; const char* nB = has_next ? (const char*)g.Bt + (size_t)nxt.pn * tstep : cB;
        for (int t = 0; t < nt; t += 2) {
            const bool last = (t == nt - 2);
            const char* a1 = cA + (size_t)(t + 1) * kstep;
            const char* a2 = last ? nA : cA + (size_t)(t + 2) * kstep; const char* b2 = last ? nB : cB + (size_t)(t + 2) * kstep;
            const char* a3 = a2 + kstep; const char* b3 = b2 + kstep;
            if (last && has_next) S.a_ready(nxt);
            if constexpr (SP2) {
            PG8_LDB(B0, 0, 0); PG8_LDB(B1, 0, 1); PG8_SCHED; PG8_LDA(At, 0, 0); PG8_STAGE(PG8_SA(1, 1), a1 + hstep, voffA);
            PG8_WAIT_V(8); PG8_WAIT_L(0); PG8_BAR; PG8_MMA(0, 0, At, B0); PG8_MMA(0, 1, At, B1); PG8_BAR; PG8_SCHED;
            PG8_LDA(At, 0, 1); PG8_STAGE(PG8_SB(0, 0), b2, voffB); PG8_STAGE(PG8_SB(0, 1), b2 + hstep, voffB); PG8_STAGE(PG8_SA(0, 0), a2, voffA);
            PG8_WAIT_V(8); PG8_WAIT_L(0); PG8_BAR; PG8_MMA(1, 0, At, B0); PG8_MMA(1, 1, At, B1); PG8_BAR; PG8_SCHED;
            PG8_LDB(B0, 1, 0); PG8_LDB(B1, 1, 1); PG8_SCHED; PG8_LDA(At, 1, 0); PG8_STAGE(PG8_SA(0, 1), a2 + hstep, voffA);
            PG8_WAIT_V(8); PG8_WAIT_L(0); PG8_BAR; PG8_MMA(0, 0, At, B0); PG8_MMA(0, 1, At, B1); PG8_BAR; PG8_SCHED;
            PG8_LDA(At, 1, 1); PG8_STAGE(PG8_SB(1, 0), b3, voffB); PG8_STAGE(PG8_SB(1, 1), b3 + hstep, voffB); PG8_STAGE(PG8_SA(1, 0), a3, voffA);
            PG8_WAIT_V(8); PG8_WAIT_L(0); PG8_BAR; PG8_MMA(1, 0, At, B0); PG8_MMA(1, 1, At, B1); PG8_BAR; PG8_SCHED;
            } else {
            PG8_LDB(B0, 0, 0); PG8_SCHED; PG8_LDA(At, 0, 0); PG8_STAGE(PG8_SA(1, 1), a1 + hstep, voffA);
            PG8_WAIT_L(8); PG8_BAR; PG8_WAIT_L(0); PG8_MMA(0, 0, At, B0); PG8_BAR; PG8_SCHED;
            PG8_LDB(B1, 0, 1); PG8_STAGE(PG8_SB(0, 0), b2, voffB);
            PG8_BAR; PG8_WAIT_L(0); PG8_MMA(0, 1, At, B1); PG8_BAR;
            PG8_LDA(At, 0, 1); PG8_STAGE(PG8_SA(0, 0), a2, voffA);
            PG8_BAR; PG8_WAIT_L(0); PG8_MMA(1, 0, At, B0); PG8_BAR; PG8_SCHED;
            PG8_STAGE(PG8_SB(0, 1), b2 + hstep, voffB);
            PG8_WAIT_V(6); PG8_BAR; PG8_MMA(1, 1, At, B1); PG8_BAR;
            PG8_LDB(B0, 1, 0); PG8_SCHED; PG8_LDA(At, 1, 0); PG8_STAGE(PG8_SA(0, 1), a2 + hstep, voffA);
            PG8_WAIT_L(8); PG8_BAR; PG8_WAIT_L(0); PG8_MMA(0, 0, At, B0); PG8_BAR; PG8_SCHED;
            PG8_LDB(B1, 1, 1); PG8_STAGE(PG8_SB(1, 0), b3, voffB);
            PG8_BAR; PG8_WAIT_L(0); PG8_MMA(0, 1, At, B1); PG8_BAR;
            PG8_LDA(At, 1, 1); PG8_STAGE(PG8_SA(1, 0), a3, voffA);
            PG8_BAR; PG8_WAIT_L(0); PG8_MMA(1, 0, At, B0); PG8_BAR; PG8_SCHED;
            PG8_STAGE(PG8_SB(1, 1), b3 + hstep, voffB);
            PG8_WAIT_V(6); PG8_BAR; PG8_MMA(1, 1, At, B1); PG8_BAR;
            }
        }
        if constexpr (ALIGN_EPI) { if (wr == 0) PG8_BAR; }
        if constexpr (!Epi::AFTER_DRAIN) { E(acc, cur, wr, wc, fr, fq); S.done(cur); }
        if (!has_next) break;
#pragma unroll
        for (int a = 0; a < 2; ++a)
#pragma unroll
            for (int b = 0; b < 2; ++b)
#pragma unroll
                for (int m = 0; m < 4; ++m)
#pragma unroll
                    for (int n = 0; n < 2; ++n) acc[a][b][m][n] = (f32x4){0.f, 0.f, 0.f, 0.f};
        cur = nxt; cA = nA; cB = nB; ++ui;
        if constexpr (ALIGN_EPI) { if (wr == 1) PG8_BAR; }
    }
    PG8_WAIT_V(0);
    if constexpr (!ALIGN_EPI) { if (wr == 0) PG8_BAR; }
    PG8_BAR;
    if constexpr (Epi::AFTER_DRAIN) { E.fused(acc, cur, wr, wc, fr, fq, lds, wid, lane); S.done(cur); }
#undef PG8_SA
#undef PG8_SB
#undef PG8_STAGE
#undef PG8_LDA
#undef PG8_LDB
#undef PG8_MMA
#undef PG8_WAIT_V
#undef PG8_WAIT_L
#undef PG8_BAR
#undef PG8_SCHED
}
}

#define GAS __attribute__((address_space(1)))
#define LAS __attribute__((address_space(3)))
typedef unsigned short bf16;
typedef unsigned v4u __attribute__((ext_vector_type(4)));
typedef unsigned v2u __attribute__((ext_vector_type(2)));
typedef float f32x4 __attribute__((ext_vector_type(4)));
typedef float f32x16 __attribute__((ext_vector_type(16)));
typedef short bf16x8 __attribute__((ext_vector_type(8)));
typedef GAS unsigned gu32;
#define RLX_AGENT __ATOMIC_RELAXED, __HIP_MEMORY_SCOPE_AGENT
#define LDS_WAIT() asm volatile("s_waitcnt lgkmcnt(0)" ::: "memory")
#define VM_WAIT() asm volatile("s_waitcnt vmcnt(0)" ::: "memory")
#define LDS_BARRIER() do { asm volatile("s_waitcnt lgkmcnt(0)" ::: "memory"); __builtin_amdgcn_s_barrier(); asm volatile("" ::: "memory"); } while (0)

constexpr int NWAVES = 8, NTHR = 512;
constexpr int BATCH = 2, SEQ = 4096, T = BATCH * SEQ, D = 2048, C = 1024, NH = 16, HD = 64;
constexpr int AH = 8, AD = 128, MB = 256, NBLK = SEQ / MB;
constexpr int NSHIFT = 3328, NIN = 6400, NZ = 6656, FF = 8192;
constexpr int ZQ = 3328, ZK = 4352, ZV = 5376, ZVD = 6400;
constexpr int DEPTH = 2;
constexpr float NORM_EPS = 1e-6f, LNX_EPS = 64e-5f;

constexpr size_t MiB = 1u << 20;
constexpr size_t WS_CTL = 0, CTL_ZERO_BYTES = 1 * MiB;
constexpr size_t WS_WIN = 1 * MiB, WS_WOUT = 27 * MiB, WS_WUP = 35 * MiB, WS_WDN = 67 * MiB;
constexpr size_t WS_VF = 99 * MiB;
constexpr size_t WS_HN = 131 * MiB;
constexpr size_t WS_YC = 163 * MiB;
constexpr size_t WS_Z = 195 * MiB;
constexpr size_t WS_XL = 299 * MiB;
constexpr size_t WS_LW = 304 * MiB;
constexpr size_t WS_ROPE = 323 * MiB;
constexpr size_t WS_SV = 325 * MiB;
constexpr size_t WS_SG = 341 * MiB;
constexpr size_t WS_AQ = 357 * MiB, WS_AK = 373 * MiB, WS_AVT = 389 * MiB;
constexpr size_t WS_KM = 405 * MiB;
constexpr size_t WS_CHUNK = 406 * MiB;
constexpr size_t WS_U = 195 * MiB;
constexpr size_t WS_Y2 = 195 * MiB;
constexpr size_t WS_M = 131 * MiB;
constexpr size_t WS_END = 502 * MiB;
constexpr int CW_BAR = 4096;

constexpr int RING_BYTES = 155648;
constexpr int LDSCTL_OFF = RING_BYTES, MISC_OFF = LDSCTL_OFF + 320;
constexpr int LDS_BYTES = RING_BYTES + 1024;
constexpr int PTAB_OFF = MISC_OFF + 128;

typedef float f32x2_t __attribute__((ext_vector_type(2))); typedef __bf16 bf16x2_t __attribute__((ext_vector_type(2)));
__device__ __forceinline__ unsigned pk2(float lo, float hi) { f32x2_t v = {lo, hi}; bf16x2_t b = __builtin_convertvector(v, bf16x2_t); return __builtin_bit_cast(unsigned, b); }
__device__ __forceinline__ unsigned f2bf(float f) { return pk2(f, 0.f) & 0xffffu; }
__device__ __forceinline__ float bf2f(unsigned short b) { return __builtin_bit_cast(float, (unsigned)b << 16); }
__device__ __forceinline__ float bflo(unsigned w) { return __builtin_bit_cast(float, w << 16); }
__device__ __forceinline__ float bfhi(unsigned w) { return __builtin_bit_cast(float, w & 0xffff0000u); }

#define XB_TMO      128
#define XB_XCNT(j)  (256  + 64 * (j))
#define XB_XSUB(j)  (1280 + 64 * (j))
#define XB_XGEN(j)  (2304 + 64 * (j))
#define XB_TOP      3328
#define XB_TOPGEN   3392
#define XCD_BAR_WORDS 3456
#define XB_SPIN_CAP (1u << 20)
__device__ __forceinline__ unsigned xb_ld(unsigned* p)              { return __hip_atomic_load(p, __ATOMIC_RELAXED, __HIP_MEMORY_SCOPE_AGENT); }
__device__ __forceinline__ unsigned xb_add(unsigned* p, unsigned v) { return __hip_atomic_fetch_add(p, v, __ATOMIC_RELAXED, __HIP_MEMORY_SCOPE_AGENT); }
__device__ __forceinline__ unsigned xb_xcc_id() { return (unsigned)__builtin_amdgcn_s_getreg((3 << 11) | 20) & 0xFu; }
#define XB_SPIN(cond, bar) do { unsigned _sp = 0; while (cond) { __builtin_amdgcn_s_sleep(1); \
    if ((++_sp & 255u) == 0u) { if (xb_ld(&(bar)[XB_TMO])) break; if (_sp > XB_SPIN_CAP) { atomicAdd(&(bar)[XB_TMO], 1u); break; } } } } while (0)
struct XcdBarrier { unsigned* bar; unsigned x; volatile LAS unsigned* st; };
__device__ __forceinline__ XcdBarrier xcd_barrier_post(unsigned* bar, volatile LAS unsigned* st) {
    XcdBarrier b; b.bar = bar; b.x = xb_xcc_id(); b.st = st;
    if (threadIdx.x == 0) (void)xb_add(&bar[XB_XCNT(b.x)], 1u);
    return b;
}
__device__ __forceinline__ void xcd_barrier_complete(unsigned* bar, unsigned x, unsigned& nloc, unsigned& nx) {
    const unsigned G = gridDim.x * gridDim.y * gridDim.z;
    unsigned sum, cnt, mine, sp = 0u;
    for (;;) {
        sum = 0u; cnt = 0u; mine = 0u;
#pragma unroll
        for (unsigned j = 0; j < 16; ++j) { const unsigned c = xb_ld(&bar[XB_XCNT(j)]); sum += c; cnt += (c > 0u) ? 1u : 0u; mine = (j == x) ? c : mine; }
        if (sum == G) break;
        __builtin_amdgcn_s_sleep(1);
        if ((++sp & 255u) == 0u) { if (xb_ld(&bar[XB_TMO])) break; if (sp > XB_SPIN_CAP) { atomicAdd(&bar[XB_TMO], 1u); break; } }
    }
    nloc = mine > 0u ? mine : 1u; nx = cnt > 0u ? cnt : 1u;
}
__device__ __forceinline__ void xcd_barrier(const XcdBarrier& b) {
    asm volatile("s_waitcnt vmcnt(0)" ::: "memory");
    __syncthreads();
    if (threadIdx.x == 0) {
        unsigned* bar = b.bar;
        __builtin_amdgcn_s_waitcnt(0);
        unsigned nloc = b.st[0], nx = b.st[1];
        if (nloc == 0u) { xcd_barrier_complete(bar, b.x, nloc, nx); b.st[0] = nloc; b.st[1] = nx; }
        const unsigned old = xb_add(&bar[XB_XSUB(b.x)], 1u);
        const unsigned gen = old / nloc;
        if (old + 1u == (gen + 1u) * nloc) {
            __builtin_amdgcn_fence(__ATOMIC_RELEASE, "agent");
            asm volatile("s_waitcnt vmcnt(0)" ::: "memory");
            const unsigned og = xb_add(&bar[XB_TOP], 1u);
            const unsigned tg = og / nx;
            if (og + 1u == (tg + 1u) * nx) xb_add(&bar[XB_TOPGEN], 1u);
            else XB_SPIN(xb_ld(&bar[XB_TOPGEN]) == tg, bar);
            __builtin_amdgcn_fence(__ATOMIC_ACQUIRE, "agent");
            xb_add(&bar[XB_XGEN(b.x)], 1u);
            asm volatile("s_waitcnt vmcnt(0)" ::: "memory");
        } else {
            XB_SPIN(xb_ld(&bar[XB_XGEN(b.x)]) == gen, bar);
            __builtin_amdgcn_fence(__ATOMIC_ACQUIRE, "agent");
            asm volatile("s_waitcnt vmcnt(0)" ::: "memory");
        }
    }
    __syncthreads();
}

struct Frame {
    LAS unsigned char* lds;
    volatile LAS unsigned* MISC;
    gu32* ctl;
    int tid, lane, wave, vcu, G, bx;
    float* out;
    unsigned char* ws;
};
enum { I_X = 0, I_NMIXPRE, I_NMIXPOST, I_NMLPPRE, I_NMLPPOST, I_WIN, I_WINV, I_MU, I_MUV, I_W0, I_W2, I_A0, I_A2, I_V0, I_V2, I_G2, I_KK, I_KA, I_RK, I_LNG, I_LNB, I_WOUT, I_WUP, I_WDN };

__device__ __forceinline__ const float* inp_(const Frame& F, int i) {
    const unsigned long long v = *(const LAS unsigned long long*)(F.lds + PTAB_OFF + 8 * i);
    const unsigned lo = __builtin_amdgcn_readfirstlane((unsigned)v), hi = __builtin_amdgcn_readfirstlane((unsigned)(v >> 32));
    return (const float*)(const GAS float*)(((unsigned long long)hi << 32) | lo);
}
#define INP(i) inp_(F, (i))
#define DPP_ADD(v, ctrl) ((v) + __builtin_bit_cast(float, __builtin_amdgcn_update_dpp(0, __builtin_bit_cast(int, (v)), (ctrl), 0xF, 0xF, true)))
__device__ __forceinline__ float wave_sum(float v) {
    v = DPP_ADD(v, 0xB1);
    v = DPP_ADD(v, 0x4E);
    v = DPP_ADD(v, 0x141);
    v = DPP_ADD(v, 0x140);
    const float r0 = __builtin_bit_cast(float, __builtin_amdgcn_readlane(__builtin_bit_cast(int, v), 0)), r1 = __builtin_bit_cast(float, __builtin_amdgcn_readlane(__builtin_bit_cast(int, v), 16));
    const float r2 = __builtin_bit_cast(float, __builtin_amdgcn_readlane(__builtin_bit_cast(int, v), 32)), r3 = __builtin_bit_cast(float, __builtin_amdgcn_readlane(__builtin_bit_cast(int, v), 48));
    return (r0 + r1) + (r2 + r3);
}
__device__ __forceinline__ void transpose_item(const float* W, int K, int N, bf16* WT, int row_off, LAS float* scr, int item, int lane) {
    const int nblk = N / 32, kb = item / nblk, nb = item % nblk, k0 = 64 * kb, n0 = 32 * nb;
#pragma unroll 8
    for (int i = 0; i < 32; ++i) { const int kk = 2 * i + (lane >> 5); scr[kk * 33 + (lane & 31)] = W[(size_t)(k0 + kk) * N + n0 + (lane & 31)]; }
    LDS_WAIT(); asm volatile("" ::: "memory");
    const int c = lane & 7;
#pragma unroll
    for (int j = 0; j < 4; ++j) { const int n = (lane >> 3) + 8 * j; const LAS float* s = scr + (8 * c) * 33 + n;
        v4u o; o.x = pk2(s[0 * 33], s[1 * 33]); o.y = pk2(s[2 * 33], s[3 * 33]); o.z = pk2(s[4 * 33], s[5 * 33]); o.w = pk2(s[6 * 33], s[7 * 33]);
        *(GAS v4u*)(WT + (size_t)(row_off + n0 + n) * K + k0 + 8 * c) = o; }
    LDS_WAIT(); asm volatile("" ::: "memory");
}
__device__ __forceinline__ void rmsnorm_row_to_bf16(const float* xrow, const float* gain, bf16* orow, int lane) {
    const GAS f32x4* xr = (const GAS f32x4*)xrow + lane; const GAS f32x4* gr = (const GAS f32x4*)gain + lane;
    f32x4 v[8]; float s = 0.f;
#pragma unroll
    for (int j = 0; j < 8; ++j) { v[j] = xr[64 * j]; s += (v[j].x * v[j].x + v[j].y * v[j].y) + (v[j].z * v[j].z + v[j].w * v[j].w); }
    const float rs = 1.0f / sqrtf(wave_sum(s) * (1.f / D) + NORM_EPS);
    GAS v2u* o8 = (GAS v2u*)orow + lane;
#pragma unroll
    for (int j = 0; j < 8; ++j) { const f32x4 g = gr[64 * j]; v2u w; w.x = pk2(v[j].x * rs * g.x, v[j].y * rs * g.y); w.y = pk2(v[j].z * rs * g.z, v[j].w * rs * g.w); o8[64 * j] = w; }
}
__device__ __forceinline__ void ph_convert(Frame& F, int L) {
    LAS float* scr = (LAS float*)(F.lds + F.wave * 16384);
    const int gw = F.vcu * NWAVES + F.wave, NGW = F.G * NWAVES;
    bf16* WinT = (bf16*)(F.ws + WS_WIN); bf16* WoutT = (bf16*)(F.ws + WS_WOUT); bf16* WupT = (bf16*)(F.ws + WS_WUP); bf16* WdnT = (bf16*)(F.ws + WS_WDN);
    constexpr int I_IN = (D / 64) * (NIN / 32), I_VR = (D / 64), I_OUT = (D / 64) * (D / 32), I_UP = (D / 64) * (FF / 32), I_DN = (FF / 64) * (D / 32);
    const int nvr = (L > 0) ? I_VR : 0;
    const int NITEMS = I_IN + nvr + I_OUT + I_UP + I_DN;
    for (int it = gw; it < NITEMS; it += NGW) {
        int r = it;
        if (r < I_IN) { transpose_item(INP(I_WIN) + (size_t)L * D * NIN, D, NIN, WinT, 0, scr, r, F.lane); continue; } r -= I_IN;
        if (r < nvr) { transpose_item(INP(I_WINV) + (size_t)(L - 1) * D * 32, D, 32, WinT, NIN, scr, r, F.lane); continue; } r -= nvr;
        if (r < I_OUT) { transpose_item(INP(I_WOUT) + (size_t)L * D * D, D, D, WoutT, 0, scr, r, F.lane); continue; } r -= I_OUT;
        if (r < I_UP) { transpose_item(INP(I_WUP) + (size_t)L * D * FF, D, FF, WupT, 0, scr, r, F.lane); continue; } r -= I_UP;
        transpose_item(INP(I_WDN) + (size_t)L * FF * D, FF, D, WdnT, 0, scr, r, F.lane);
    }
    if (L > 0) {
        const int gt = F.vcu * NTHR + F.tid, NGT = F.G * NTHR;
        for (int i = gt; i < (NZ - NIN - 32) * (D / 8); i += NGT) *(GAS v4u*)(WinT + (size_t)(NIN + 32) * D + (size_t)i * 8) = (v4u){0u, 0u, 0u, 0u};
    }
    {
        bf16* W2T = (bf16*)(F.ws + WS_LW); bf16* A2T = W2T + C * 64; bf16* G2T = A2T + C * 64; bf16* V2T = G2T + C * 128;
        for (int it = gw; it < 32 + 32 + 64; it += NGW) {
            if (it < 32) transpose_item(INP(I_W2) + (size_t)L * 64 * C, 64, C, W2T, 0, scr, it, F.lane);
            else if (it < 64) transpose_item(INP(I_A2) + (size_t)L * 64 * C, 64, C, A2T, 0, scr, it - 32, F.lane);
            else transpose_item(INP(I_G2) + (size_t)L * 128 * C, 128, C, G2T, 0, scr, it - 64, F.lane);
        }
        const int gt = F.vcu * NTHR + F.tid, NGT = F.G * NTHR;
        if (L > 0) { const float* v2 = INP(I_V2) + (size_t)(L - 1) * 32 * C; for (int i = gt; i < 32 * C; i += NGT) { const int cch = i >> 5, k = i & 31; V2T[i] = (bf16)f2bf(v2[(size_t)k * C + cch]); } }
        if (L == 0) { float* RC = (float*)(F.ws + WS_ROPE); float* RS = RC + SEQ * 64;
            for (int i = gt; i < SEQ * 64; i += NGT) { const int pos = i >> 6, d = i & 63; const float inv_freq = exp2f(-(float)d * (13.287712379549449f / 64.0f)); float sn, cs; sincosf((float)pos * inv_freq, &sn, &cs); RC[i] = cs; RS[i] = sn; } }
    }
    if (L == 0) {
        bf16* HN = (bf16*)(F.ws + WS_HN);
        for (int m = gw; m < T; m += NGW) rmsnorm_row_to_bf16(INP(I_X) + (size_t)m * D, INP(I_NMIXPRE), HN + (size_t)m * D, F.lane);
    }
}
__device__ __forceinline__ void ph_resnorm(Frame& F, const float* y, const float* xin, const float* gA, const float* gB, float* xout, bf16* hn) {
    const int gw = F.vcu * NWAVES + F.wave, NGW = F.G * NWAVES;
    for (int m = gw; m < T; m += NGW) {
        const GAS f32x4* yr = (const GAS f32x4*)(y + (size_t)m * D) + F.lane; const GAS f32x4* xr = (const GAS f32x4*)(xin + (size_t)m * D) + F.lane;
        const GAS f32x4* ga = (const GAS f32x4*)gA + F.lane;
        f32x4 v[8]; float s = 0.f;
#pragma unroll
        for (int j = 0; j < 8; ++j) { v[j] = yr[64 * j]; s += (v[j].x * v[j].x + v[j].y * v[j].y) + (v[j].z * v[j].z + v[j].w * v[j].w); }
        const float rs = 1.0f / sqrtf(wave_sum(s) * (1.f / D) + NORM_EPS);
        float s2 = 0.f;
        GAS f32x4* xo = (GAS f32x4*)(xout + (size_t)m * D) + F.lane;
#pragma unroll
        for (int j = 0; j < 8; ++j) { const f32x4 g = ga[64 * j]; const f32x4 x = xr[64 * j];
            v[j].x = x.x + v[j].x * rs * g.x; v[j].y = x.y + v[j].y * rs * g.y; v[j].z = x.z + v[j].z * rs * g.z; v[j].w = x.w + v[j].w * rs * g.w;
            xo[64 * j] = v[j]; s2 += (v[j].x * v[j].x + v[j].y * v[j].y) + (v[j].z * v[j].z + v[j].w * v[j].w); }
        if (gB) {
            const float rs2 = 1.0f / sqrtf(wave_sum(s2) * (1.f / D) + NORM_EPS);
            const GAS f32x4* gb = (const GAS f32x4*)gB + F.lane; GAS v2u* o8 = (GAS v2u*)(hn + (size_t)m * D) + F.lane;
#pragma unroll
            for (int j = 0; j < 8; ++j) { const f32x4 g = gb[64 * j]; v2u w; w.x = pk2(v[j].x * rs2 * g.x, v[j].y * rs2 * g.y); w.y = pk2(v[j].z * rs2 * g.z, v[j].w * rs2 * g.w); o8[64 * j] = w; }
        }
    }
}
__device__ __forceinline__ float sigmoidf_(float x) { return __builtin_amdgcn_rcpf(1.0f + __expf(-x)); }
__device__ __forceinline__ float softplusf_(float x) { return fmaxf(x, 0.f) + __logf(1.0f + __expf(-fabsf(x))); }

__device__ __forceinline__ void prep_xl_items(Frame& F, int L) {
    const bf16* Z = (const bf16*)(F.ws + WS_Z); bf16* XL = (bf16*)(F.ws + WS_XL);
    const float* mu = INP(I_MU) + (size_t)L * NSHIFT; const float* muv = INP(I_MUV) + (size_t)(L > 0 ? L - 1 : 0) * 32;
    const int gt = F.vcu * NTHR + F.tid, NGT = F.G * NTHR;
    for (int it = gt; it < T * 36; it += NGT) {
        const int t = it / 36, j8 = it - t * 36, s = t & (SEQ - 1);
        v4u o = (v4u){0u, 0u, 0u, 0u};
        if (j8 < 32 || L > 0) {
            const int col = (j8 < 32) ? (3072 + 8 * j8) : (ZVD + 8 * (j8 - 32));
            const float* mup = (j8 < 32) ? (mu + col) : (muv + 8 * (j8 - 32));
            const v4u zc = *(const GAS v4u*)(Z + (size_t)t * NZ + col);
            v4u zp = (v4u){0u, 0u, 0u, 0u}; if (s) zp = *(const GAS v4u*)(Z + (size_t)(t - 1) * NZ + col);
            const f32x4 m0 = *(const GAS f32x4*)mup, m1 = *(const GAS f32x4*)(mup + 4);
            float f[8];
#pragma unroll
            for (int q = 0; q < 4; ++q) { const float c0 = bflo(zc[q]), c1 = bfhi(zc[q]), p0 = bflo(zp[q]), p1 = bfhi(zp[q]);
                const float ma = (q < 2) ? m0[2 * q] : m1[2 * q - 4], mb = (q < 2) ? m0[2 * q + 1] : m1[2 * q - 3];
                f[2 * q] = c0 + (p0 - c0) * ma; f[2 * q + 1] = c1 + (p1 - c1) * mb; }
            if (j8 < 8) {
#pragma unroll
                for (int q = 0; q < 8; ++q) f[q] = tanhf(f[q]);
            } else if (j8 >= 16 && j8 < 32) {
#pragma unroll
                for (int q = 0; q < 8; ++q) f[q] = sigmoidf_(f[q]);
            }
            o = (v4u){pk2(f[0], f[1]), pk2(f[2], f[3]), pk2(f[4], f[5]), pk2(f[6], f[7])};
        }
        *(GAS v4u*)(XL + (size_t)t * 288 + 8 * j8) = o;
    }
}
constexpr float QSC = 0.08838834764831845f * 1.4426950408889634f;
__device__ __forceinline__ void prep_attn_unit(Frame& F, int u) {
    const bf16* Z = (const bf16*)(F.ws + WS_Z);
    bf16* AQ = (bf16*)(F.ws + WS_AQ); bf16* AKp = (bf16*)(F.ws + WS_AK); float* KM = (float*)(F.ws + WS_KM);
    const float* RC = (const float*)(F.ws + WS_ROPE); const float* RS = RC + SEQ * 64;
    const int b = u / (NBLK * AH), rem = u % (NBLK * AH), blk = rem / AH, h = rem % AH;
    const int tid = F.tid, d = 8 * (tid & 7), tg = tid >> 3;
    const int tb = b * SEQ + blk * MB;
    LAS float* red = (LAS float*)F.lds;
    LDS_BARRIER();
    float ks[16];
#pragma unroll
    for (int q = 0; q < 16; ++q) ks[q] = 0.f;
#pragma unroll
    for (int i = 0; i < 4; ++i) {
        const int tok = tg + 64 * i; const int pos = blk * MB + tok; const size_t t = (size_t)(tb + tok);
        const f32x4 c0 = *(const GAS f32x4*)(RC + pos * 64 + d), c1 = *(const GAS f32x4*)(RC + pos * 64 + d + 4);
        const f32x4 s0 = *(const GAS f32x4*)(RS + pos * 64 + d), s1 = *(const GAS f32x4*)(RS + pos * 64 + d + 4);
        const v4u ql = *(const GAS v4u*)(Z + t * NZ + ZQ + h * AD + d), qh = *(const GAS v4u*)(Z + t * NZ + ZQ + h * AD + 64 + d);
        const v4u kl = *(const GAS v4u*)(Z + t * NZ + ZK + h * AD + d), kh = *(const GAS v4u*)(Z + t * NZ + ZK + h * AD + 64 + d);
        float qlo[8], qhi[8], klo[8], khi[8];
#pragma unroll
        for (int q = 0; q < 4; ++q) { qlo[2 * q] = bflo(ql[q]); qlo[2 * q + 1] = bfhi(ql[q]); qhi[2 * q] = bflo(qh[q]); qhi[2 * q + 1] = bfhi(qh[q]);
            klo[2 * q] = bflo(kl[q]); klo[2 * q + 1] = bfhi(kl[q]); khi[2 * q] = bflo(kh[q]); khi[2 * q + 1] = bfhi(kh[q]); }
        float oq1[8], oq2[8], ok1[8], ok2[8];
#pragma unroll
        for (int q = 0; q < 8; ++q) { const float cs = (q < 4) ? c0[q] : c1[q - 4], sn = (q < 4) ? s0[q] : s1[q - 4];
            oq1[q] = (qlo[q] * cs - qhi[q] * sn) * QSC; oq2[q] = (qhi[q] * cs + qlo[q] * sn) * QSC; ok1[q] = klo[q] * cs - khi[q] * sn; ok2[q] = khi[q] * cs + klo[q] * sn;
            ks[q] += ok1[q]; ks[8 + q] += ok2[q]; }
        *(GAS v4u*)(AQ + t * C + h * AD + d) = (v4u){pk2(oq1[0], oq1[1]), pk2(oq1[2], oq1[3]), pk2(oq1[4], oq1[5]), pk2(oq1[6], oq1[7])};
        *(GAS v4u*)(AQ + t * C + h * AD + 64 + d) = (v4u){pk2(oq2[0], oq2[1]), pk2(oq2[2], oq2[3]), pk2(oq2[4], oq2[5]), pk2(oq2[6], oq2[7])};
        *(GAS v4u*)(AKp + t * C + h * AD + d) = (v4u){pk2(ok1[0], ok1[1]), pk2(ok1[2], ok1[3]), pk2(ok1[4], ok1[5]), pk2(ok1[6], ok1[7])};
        *(GAS v4u*)(AKp + t * C + h * AD + 64 + d) = (v4u){pk2(ok2[0], ok2[1]), pk2(ok2[2], ok2[3]), pk2(ok2[4], ok2[5]), pk2(ok2[6], ok2[7])};
    }
    *(LAS f32x4*)(red + tg * 128 + d) = (f32x4){ks[0], ks[1], ks[2], ks[3]}; *(LAS f32x4*)(red + tg * 128 + d + 4) = (f32x4){ks[4], ks[5], ks[6], ks[7]};
    *(LAS f32x4*)(red + tg * 128 + 64 + d) = (f32x4){ks[8], ks[9], ks[10], ks[11]}; *(LAS f32x4*)(red + tg * 128 + 64 + d + 4) = (f32x4){ks[12], ks[13], ks[14], ks[15]};
    LDS_BARRIER();
    if (tid < 128) { float s = 0.f;
#pragma unroll 8
        for (int w = 0; w < 64; ++w) s += red[w * 128 + tid];
        KM[((size_t)(b * AH + h) * NBLK + blk) * AD + tid] = s * (1.0f / MB); }
}
__device__ __forceinline__ void ph_prep(Frame& F, int L) {
    prep_xl_items(F, L);
    for (int u = F.vcu; u < BATCH * NBLK * AH; u += F.G) prep_attn_unit(F, u);
}

typedef short bf16x4 __attribute__((ext_vector_type(4)));
constexpr int NCHK = SEQ / 64;
constexpr int NUNIT = BATCH * NH * NCHK;
constexpr int CP = 144, MATB = 64 * CP;
constexpr int L_ARA = 0, L_ARR = MATB, L_BKB = 2 * MATB, L_BKK = 3 * MATB, L_AT = 4 * MATB, L_BT = 5 * MATB, L_KT = 6 * MATB, L_VT = 7 * MATB;
constexpr int L_AAB = 8 * MATB, L_AAK = 9 * MATB, L_ARB = 10 * MATB, L_ARK = 11 * MATB, L_ND = 12 * MATB, L_TB = L_ND + 4096;
constexpr int XLP = 592;
constexpr int L_XL = 8 * MATB, L_LW = L_XL + 64 * XLP, L_LA = L_LW + 16384, L_LV = L_LA + 8192, L_LG = L_LV + 8192, L_SEG = L_LG + 8192, L_GL = L_SEG + 2048;
static_assert(L_TB + 2048 <= L_SEG && L_GL + 256 <= RING_BYTES, "wkv LDS map");
constexpr int L_W2T = L_ARA, L_PT = L_BKB, L_QT = L_BKK;
constexpr size_t WS_CM = WS_CHUNK, WS_CG = WS_CM + (size_t)NUNIT * 8192, WS_CRY = WS_CG + (size_t)NUNIT * 16384, WS_CYC = WS_CRY + (size_t)NUNIT * 8192;
static_assert(WS_CYC + (size_t)NUNIT * 16384 <= WS_END, "chunk outputs");
constexpr size_t WS_CS = WS_HN;
constexpr size_t WS_BON = WS_HN + (size_t)NUNIT * 8192;
static_assert(WS_BON + (size_t)T * NH * 4 <= WS_YC, "HN region");

__device__ __forceinline__ f32x4 mfma32(bf16x8 a, bf16x8 b, f32x4 c) { return __builtin_amdgcn_mfma_f32_16x16x32_bf16(a, b, c, 0, 0, 0); }
__device__ __forceinline__ f32x4 mfma16(bf16x4 a, bf16x4 b, f32x4 c) { return __builtin_amdgcn_mfma_f32_16x16x16bf16_1k(a, b, c, 0, 0, 0); }
__device__ __forceinline__ v2u pk4(f32x4 v) { v2u w; w.x = pk2(v[0], v[1]); w.y = pk2(v[2], v[3]); return w; }

__device__ __forceinline__ void wkv_r1_unit(Frame& F, int L, int unit) {
    const int c = unit % NCHK, bh = unit / NCHK, h = bh % NH, b = bh / NH;
    const int tid = F.tid, lane = F.lane, w = F.wave, fr = lane & 15, g = lane >> 4;
    LAS unsigned char* lds = F.lds;
    const bf16* Z = (const bf16*)(F.ws + WS_Z);
    const size_t tok0 = (size_t)b * SEQ + (size_t)c * 64;
    bf16x8 lwf[9];
    { const int chw = h * HD + 16 * (w & 3) + fr;
      const GAS bf16* W2T = (const GAS bf16*)(F.ws + WS_LW); const GAS bf16* A2T = W2T + C * 64; const GAS bf16* G2T = A2T + C * 64; const GAS bf16* V2T = G2T + C * 128;
      lwf[0] = *(const GAS bf16x8*)(W2T + (size_t)chw * 64 + 8 * g); lwf[1] = *(const GAS bf16x8*)(W2T + (size_t)chw * 64 + 32 + 8 * g);
      lwf[2] = *(const GAS bf16x8*)(A2T + (size_t)chw * 64 + 8 * g); lwf[3] = *(const GAS bf16x8*)(A2T + (size_t)chw * 64 + 32 + 8 * g);
#pragma unroll
      for (int ks = 0; ks < 4; ++ks) lwf[4 + ks] = *(const GAS bf16x8*)(G2T + (size_t)chw * 128 + 32 * ks + 8 * g);
      lwf[8] = lwf[0]; if (L > 0) lwf[8] = *(const GAS bf16x8*)(V2T + (size_t)chw * 32 + 8 * g); }
    LDS_BARRIER();
    { const bf16* XLg = (const bf16*)(F.ws + WS_XL) + tok0 * 288;
      for (int idx = tid; idx < 64 * 36; idx += NTHR) { const int row = idx / 36, ch = idx - row * 36;
          *(LAS v4u*)(lds + L_XL + row * XLP + ch * 16) = *(const GAS v4u*)(XLg + row * 288 + ch * 8); } }
    LDS_BARRIER();
    {
        const int nt = w & 3, mt0 = 2 * (w >> 2), cl = 16 * nt + fr, ch = h * HD + cl;
        const float w0c = INP(I_W0)[(size_t)L * C + ch], a0c = INP(I_A0)[(size_t)L * C + ch];
        const LAS unsigned char* xa0 = lds + L_XL + (16 * mt0 + fr) * XLP + g * 16; const LAS unsigned char* xa1 = xa0 + 16 * XLP;
        {
            const bf16x8 b0 = lwf[0], b1 = lwf[1];
            f32x4 c0 = (f32x4){0.f, 0.f, 0.f, 0.f}, c1 = c0;
            c0 = mfma32(*(const LAS bf16x8*)(xa0), b0, c0); c0 = mfma32(*(const LAS bf16x8*)(xa0 + 64), b1, c0);
            c1 = mfma32(*(const LAS bf16x8*)(xa1), b0, c1); c1 = mfma32(*(const LAS bf16x8*)(xa1 + 64), b1, c1);
#pragma unroll
            for (int i = 0; i < 4; ++i) { const float wl0 = -softplusf_(-(c0[i] + w0c)) - 0.5f, wl1 = -softplusf_(-(c1[i] + w0c)) - 0.5f;
                ((LAS float*)(lds + L_LW))[(16 * mt0 + 4 * g + i) * 64 + cl] = -__expf(wl0); ((LAS float*)(lds + L_LW))[(16 * mt0 + 16 + 4 * g + i) * 64 + cl] = -__expf(wl1); }
        }
        {
            const bf16x8 b0 = lwf[2], b1 = lwf[3];
            f32x4 c0 = (f32x4){0.f, 0.f, 0.f, 0.f}, c1 = c0;
            c0 = mfma32(*(const LAS bf16x8*)(xa0 + 128), b0, c0); c0 = mfma32(*(const LAS bf16x8*)(xa0 + 192), b1, c0);
            c1 = mfma32(*(const LAS bf16x8*)(xa1 + 128), b0, c1); c1 = mfma32(*(const LAS bf16x8*)(xa1 + 192), b1, c1);
#pragma unroll
            for (int i = 0; i < 4; ++i) { ((LAS unsigned short*)(lds + L_LA))[(16 * mt0 + 4 * g + i) * 64 + cl] = (unsigned short)f2bf(sigmoidf_(c0[i] + a0c));
                ((LAS unsigned short*)(lds + L_LA))[(16 * mt0 + 16 + 4 * g + i) * 64 + cl] = (unsigned short)f2bf(sigmoidf_(c1[i] + a0c)); }
        }
        {
            f32x4 c0 = (f32x4){0.f, 0.f, 0.f, 0.f}, c1 = c0;
#pragma unroll
            for (int ks = 0; ks < 4; ++ks) { const bf16x8 bb = lwf[4 + ks];
                c0 = mfma32(*(const LAS bf16x8*)(xa0 + 256 + 64 * ks), bb, c0); c1 = mfma32(*(const LAS bf16x8*)(xa1 + 256 + 64 * ks), bb, c1); }
#pragma unroll
            for (int i = 0; i < 4; ++i) { ((LAS unsigned short*)(lds + L_LG))[(16 * mt0 + 4 * g + i) * 64 + cl] = (unsigned short)f2bf(c0[i]); ((LAS unsigned short*)(lds + L_LG))[(16 * mt0 + 16 + 4 * g + i) * 64 + cl] = (unsigned short)f2bf(c1[i]); }
        }
        if (L > 0) {
            const float v0c = INP(I_V0)[(size_t)(L - 1) * C + ch];
            const bf16x8 b0 = lwf[8];
            f32x4 c0 = (f32x4){0.f, 0.f, 0.f, 0.f}, c1 = c0;
            c0 = mfma32(*(const LAS bf16x8*)(xa0 + 512), b0, c0); c1 = mfma32(*(const LAS bf16x8*)(xa1 + 512), b0, c1);
#pragma unroll
            for (int i = 0; i < 4; ++i) { ((LAS unsigned short*)(lds + L_LV))[(16 * mt0 + 4 * g + i) * 64 + cl] = (unsigned short)f2bf(sigmoidf_(c0[i] + v0c));
                ((LAS unsigned short*)(lds + L_LV))[(16 * mt0 + 16 + 4 * g + i) * 64 + cl] = (unsigned short)f2bf(sigmoidf_(c1[i] + v0c)); }
        }
    }
    LDS_BARRIER();
    {
        const int sg = w, j = lane, ch = h * HD + j;
        const float* mu = INP(I_MU) + (size_t)L * NSHIFT;
        const float mur = mu[ch], muk = mu[C + ch], muv = mu[2 * C + ch];
        const float kkc = INP(I_KK)[(size_t)L * C + ch], kac = INP(I_KA)[(size_t)L * C + ch], rkj = INP(I_RK)[(size_t)L * C + ch];
        float* VF = (float*)(F.ws + WS_VF); bf16* SVg = (bf16*)(F.ws + WS_SV); bf16* SGg = (bf16*)(F.ws + WS_SG);
        const size_t tokA = tok0 + 8 * sg;
        const GAS bf16* Zg = (const GAS bf16*)Z + tokA * NZ + ch;
        unsigned short zr_[9], zk_[9], zv_[9];
        { const bool hasprev = (c != 0 || sg != 0); const GAS bf16* zp = hasprev ? (Zg - NZ) : Zg;
          zr_[0] = zp[0]; zk_[0] = zp[C]; zv_[0] = zp[2 * C]; if (!hasprev) { zr_[0] = 0; zk_[0] = 0; zv_[0] = 0; } }
#pragma unroll
        for (int e = 0; e < 8; ++e) { zr_[e + 1] = Zg[(size_t)e * NZ]; zk_[e + 1] = Zg[(size_t)e * NZ + C]; zv_[e + 1] = Zg[(size_t)e * NZ + 2 * C]; }
        float lw[8], cum[8], rf[8], kf[8], kkf[8], af[8], vfin[8]; unsigned vb[8];
        float vfv[8];
#pragma unroll
        for (int e = 0; e < 8; ++e) vfv[e] = 0.f;
        if (L > 0) { const GAS float* VFg = (const GAS float*)VF + tokA * C + ch;
#pragma unroll
            for (int e = 0; e < 8; ++e) vfv[e] = VFg[(size_t)e * C]; }
        GAS bf16* SVo = (GAS bf16*)SVg + tokA * C + ch; GAS bf16* SGo = (GAS bf16*)SGg + tokA * C + ch;
#pragma unroll
        for (int e = 0; e < 8; ++e) {
            const int t = 8 * sg + e;
            const float zr = bf2f(zr_[e + 1]), zk = bf2f(zk_[e + 1]), zv = bf2f(zv_[e + 1]), zpr = bf2f(zr_[e]), zpk = bf2f(zk_[e]), zpv = bf2f(zv_[e]);
            const float r = zr + (zpr - zr) * mur, k = zk + (zpk - zk) * muk; float v = zv + (zpv - zv) * muv;
            lw[e] = ((const LAS float*)(lds + L_LW))[t * 64 + j];
            const float a = bf2f(((const LAS unsigned short*)(lds + L_LA))[t * 64 + j]);
            { const float sv = bf2f(((const LAS unsigned short*)(lds + L_LV))[t * 64 + j]); const float v1 = v + (vfv[e] - v) * sv; v = (L > 0) ? v1 : v; }
            vfin[e] = v; vb[e] = f2bf(v); SVo[(size_t)e * C] = (bf16)vb[e]; SGo[(size_t)e * C] = ((const LAS unsigned short*)(lds + L_LG))[t * 64 + j];
            float kk = k * kkc; const float ss = wave_sum(kk * kk); kk = kk / fmaxf(sqrtf(ss), 1e-12f);
            rf[e] = r; kf[e] = k * (1.f + (a - 1.f) * kac); kkf[e] = kk; af[e] = a;
        }
        if (L == 0) { GAS float* VFo = (GAS float*)VF + tokA * C + ch;
#pragma unroll
            for (int e = 0; e < 8; ++e) VFo[(size_t)e * C] = vfin[e]; }
        float run = 0.f;
#pragma unroll
        for (int e = 0; e < 8; ++e) { run += lw[e]; cum[e] = run; }
        LAS float* seg = (LAS float*)(lds + L_SEG);
        seg[sg * 64 + j] = run;
        LDS_BARRIER();
        float off = 0.f, tot = 0.f;
#pragma unroll
        for (int s2 = 0; s2 < 8; ++s2) { const float v = seg[s2 * 64 + j]; tot += v; off += (s2 < sg) ? v : 0.f; }
        if (sg == 0) ((LAS float*)(lds + L_GL))[j] = __expf(tot);
        unsigned at8[4], bt8[4], kt8[4], vt8[4];
        GAS float* BON = (GAS float*)(F.ws + WS_BON);
#pragma unroll
        for (int e = 0; e < 8; ++e) {
            const float cu = cum[e] + off, ce = cu - lw[e];
            const float eC = __expf(cu), eE = __expf(ce), eN = __expf(-cu);
            const unsigned At = f2bf(-kkf[e] * eE), Rt = f2bf(rf[e] * eC), Bt = f2bf(kkf[e] * af[e] * eN), Kt = f2bf(kf[e] * eN);
            const int t = 8 * sg + e;
            *(LAS unsigned short*)(lds + L_ARA + t * CP + j * 2) = (unsigned short)At;
            *(LAS unsigned short*)(lds + L_ARR + t * CP + j * 2) = (unsigned short)Rt;
            *(LAS unsigned short*)(lds + L_BKB + t * CP + j * 2) = (unsigned short)Bt;
            *(LAS unsigned short*)(lds + L_BKK + t * CP + j * 2) = (unsigned short)Kt;
            if (e & 1) { at8[e >> 1] |= At << 16; bt8[e >> 1] |= Bt << 16; kt8[e >> 1] |= Kt << 16; vt8[e >> 1] |= vb[e] << 16; }
            else { at8[e >> 1] = At; bt8[e >> 1] = Bt; kt8[e >> 1] = Kt; vt8[e >> 1] = vb[e]; }
            const float bs = wave_sum(rf[e] * kf[e] * rkj);
            if (j == 0) BON[(tok0 + t) * NH + h] = bs;
        }
        *(LAS v4u*)(lds + L_AT + j * CP + sg * 16) = (v4u){at8[0], at8[1], at8[2], at8[3]};
        *(LAS v4u*)(lds + L_BT + j * CP + sg * 16) = (v4u){bt8[0], bt8[1], bt8[2], bt8[3]};
        *(LAS v4u*)(lds + L_KT + j * CP + sg * 16) = (v4u){kt8[0], kt8[1], kt8[2], kt8[3]};
        *(LAS v4u*)(lds + L_VT + j * CP + sg * 16) = (v4u){vt8[0], vt8[1], vt8[2], vt8[3]};
    }
    LDS_BARRIER();
    {
        const int tq = w & 3; const bool isA = w < 4;
        const LAS unsigned char* Bsrc = lds + (isA ? L_ARA : L_ARR) + (16 * tq + fr) * CP + g * 16;
        const bf16x8 b0 = *(const LAS bf16x8*)Bsrc, b1 = *(const LAS bf16x8*)(Bsrc + 64);
        const int t = 16 * tq + fr;
#pragma unroll
        for (int mt = 0; mt < 8; ++mt) {
            const int sq = mt & 3; const bool isB = mt < 4;
            f32x4 acc = (f32x4){0.f, 0.f, 0.f, 0.f};
            if (sq <= tq) {
                const LAS unsigned char* Asrc = lds + (isB ? L_BKB : L_BKK) + (16 * sq + fr) * CP + g * 16;
                acc = mfma32(*(const LAS bf16x8*)Asrc, b0, acc);
                acc = mfma32(*(const LAS bf16x8*)(Asrc + 64), b1, acc);
            }
            const int s0 = 16 * sq + 4 * g;
#pragma unroll
            for (int i = 0; i < 4; ++i) { const bool keep = isA ? (s0 + i < t) : (s0 + i <= t); acc[i] = keep ? acc[i] : 0.f; }
            const int dst = isB ? (isA ? L_AAB : L_ARB) : (isA ? L_AAK : L_ARK);
            *(LAS v2u*)(lds + dst + t * CP + s0 * 2) = pk4(acc);
            if (isA && isB && sq == tq) *(LAS f32x4*)(lds + L_ND + tq * 1024 + fr * 64 + g * 16) = acc;
        }
    }
    LDS_BARRIER();
    if (w == 0) {
        const int bi = lane >> 4, cc = lane & 15;
        const LAS float* Nb = (const LAS float*)(lds + L_ND + bi * 1024);
        float x[16];
#pragma unroll
        for (int r = 0; r < 16; ++r) {
            float acc = (r == cc) ? 1.f : 0.f;
#pragma unroll
            for (int kq = 0; kq < (r + 3) / 4; ++kq) { const f32x4 n4 = *(const LAS f32x4*)(Nb + r * 16 + 4 * kq);
#pragma unroll
                for (int z = 0; z < 4; ++z) if (4 * kq + z < r) acc += n4[z] * x[4 * kq + z]; }
            x[r] = acc;
            *(LAS unsigned short*)(lds + L_TB + bi * 512 + r * 32 + cc * 2) = (unsigned short)f2bf(acc);
        }
    } else {
        for (int ti = w - 1; ti < 16; ti += 7) {
            const int mt = ti >> 2, nt = ti & 3;
            const LAS unsigned char* Asrc = lds + L_AAK + (16 * mt + fr) * CP + g * 16;
            const LAS unsigned char* Bsrc = lds + L_VT + (16 * nt + fr) * CP + g * 16;
            f32x4 acc = (f32x4){0.f, 0.f, 0.f, 0.f};
            acc = mfma32(*(const LAS bf16x8*)Asrc, *(const LAS bf16x8*)Bsrc, acc);
            acc = mfma32(*(const LAS bf16x8*)(Asrc + 64), *(const LAS bf16x8*)(Bsrc + 64), acc);
            *(LAS v2u*)(lds + L_W2T + (16 * nt + fr) * CP + (16 * mt + 4 * g) * 2) = pk4(acc);
        }
    }
    LDS_BARRIER();
    {
        const LAS unsigned char* rhs = lds + (w < 4 ? L_AT : L_W2T) + (16 * (w & 3) + fr) * CP;
        LAS unsigned char* xout = lds + (w < 4 ? L_PT : L_QT) + (16 * (w & 3) + fr) * CP;
        bf16x4 X[4];
#pragma unroll
        for (int bq = 0; bq < 4; ++bq) {
            const v2u rv = *(const LAS v2u*)(rhs + (16 * bq + 4 * g) * 2);
            f32x4 y = (f32x4){bflo(rv.x), bfhi(rv.x), bflo(rv.y), bfhi(rv.y)};
#pragma unroll
            for (int kb = 0; kb < bq; ++kb) {
                const bf16x4 nf = *(const LAS bf16x4*)(lds + L_AAB + (16 * bq + fr) * CP + (16 * kb + 4 * g) * 2);
                y = mfma16(nf, X[kb], y);
            }
            const v2u yb = pk4(y);
            const bf16x4 tf = *(const LAS bf16x4*)(lds + L_TB + bq * 512 + fr * 32 + g * 8);
            const f32x4 xr = mfma16(tf, __builtin_bit_cast(bf16x4, yb), (f32x4){0.f, 0.f, 0.f, 0.f});
            const v2u xb = pk4(xr);
            X[bq] = __builtin_bit_cast(bf16x4, xb);
            *(LAS v2u*)(xout + (16 * bq + 4 * g) * 2) = xb;
        }
    }
    LDS_BARRIER();
    {
        const int nt = w & 3;
        const LAS float* GL = (const LAS float*)(lds + L_GL);
        if (w < 4) {
            const LAS unsigned char* Bb = lds + L_BT + (16 * nt + fr) * CP + g * 16;
            const bf16x8 bb0 = *(const LAS bf16x8*)Bb, bb1 = *(const LAS bf16x8*)(Bb + 64);
            const LAS unsigned char* Bq = lds + L_QT + (16 * nt + fr) * CP + g * 16;
            const bf16x8 bq0 = *(const LAS bf16x8*)Bq, bq1 = *(const LAS bf16x8*)(Bq + 64);
            const LAS unsigned char* Bv = lds + L_VT + (16 * nt + fr) * CP + g * 16;
            const bf16x8 bv0 = *(const LAS bf16x8*)Bv, bv1 = *(const LAS bf16x8*)(Bv + 64);
            const int jn = 16 * nt + fr; const float glj = GL[jn];
            bf16* Mg = (bf16*)(F.ws + WS_CM) + (size_t)unit * 4096;
            float* Gg = (float*)(F.ws + WS_CG) + (size_t)unit * 4096;
#pragma unroll
            for (int mt = 0; mt < 4; ++mt) {
                const LAS unsigned char* Ap = lds + L_PT + (16 * mt + fr) * CP + g * 16;
                f32x4 acc = (f32x4){0.f, 0.f, 0.f, 0.f};
                acc = mfma32(*(const LAS bf16x8*)Ap, bb0, acc); acc = mfma32(*(const LAS bf16x8*)(Ap + 64), bb1, acc);
#pragma unroll
                for (int i = 0; i < 4; ++i) acc[i] = glj * (acc[i] + ((16 * mt + 4 * g + i == jn) ? 1.f : 0.f));
                *(GAS v2u*)(Mg + (((nt * 2 + (mt >> 1)) * 2 + (mt & 1)) * 64 + lane) * 4) = pk4(acc);
                const LAS unsigned char* Ab = lds + L_BT + (16 * mt + fr) * CP + g * 16;
                const LAS unsigned char* Ak = lds + L_KT + (16 * mt + fr) * CP + g * 16;
                f32x4 ga = (f32x4){0.f, 0.f, 0.f, 0.f};
                ga = mfma32(*(const LAS bf16x8*)Ab, bq0, ga); ga = mfma32(*(const LAS bf16x8*)(Ab + 64), bq1, ga);
                ga = mfma32(*(const LAS bf16x8*)Ak, bv0, ga); ga = mfma32(*(const LAS bf16x8*)(Ak + 64), bv1, ga);
                const f32x4 gl4 = *(const LAS f32x4*)(GL + 16 * mt + 4 * g);
                ga = ga * gl4;
                *(GAS f32x4*)(Gg + ((nt * 4 + mt) * 64 + lane) * 4) = ga;
            }
        } else {
            const LAS unsigned char* Bb = lds + L_ARB + (16 * nt + fr) * CP + g * 16;
            const bf16x8 bb0 = *(const LAS bf16x8*)Bb, bb1 = *(const LAS bf16x8*)(Bb + 64);
            const LAS unsigned char* Bk = lds + L_ARK + (16 * nt + fr) * CP + g * 16;
            const bf16x8 bk0 = *(const LAS bf16x8*)Bk, bk1 = *(const LAS bf16x8*)(Bk + 64);
            const int tn = 16 * nt + fr;
            bf16* Ryg = (bf16*)(F.ws + WS_CRY) + (size_t)unit * 4096;
            float* Ycg = (float*)(F.ws + WS_CYC) + (size_t)unit * 4096;
#pragma unroll
            for (int mt = 0; mt < 4; ++mt) {
                const LAS unsigned char* Ap = lds + L_PT + (16 * mt + fr) * CP + g * 16;
                const v2u rv = *(const LAS v2u*)(lds + L_ARR + tn * CP + (16 * mt + 4 * g) * 2);
                f32x4 acc = (f32x4){bflo(rv.x), bfhi(rv.x), bflo(rv.y), bfhi(rv.y)};
                acc = mfma32(*(const LAS bf16x8*)Ap, bb0, acc); acc = mfma32(*(const LAS bf16x8*)(Ap + 64), bb1, acc);
                *(GAS v2u*)(Ryg + ((nt * 4 + mt) * 64 + lane) * 4) = pk4(acc);
                const LAS unsigned char* Aq = lds + L_QT + (16 * mt + fr) * CP + g * 16;
                const LAS unsigned char* Av = lds + L_VT + (16 * mt + fr) * CP + g * 16;
                f32x4 ya = (f32x4){0.f, 0.f, 0.f, 0.f};
                ya = mfma32(*(const LAS bf16x8*)Aq, bb0, ya); ya = mfma32(*(const LAS bf16x8*)(Aq + 64), bb1, ya);
                ya = mfma32(*(const LAS bf16x8*)Av, bk0, ya); ya = mfma32(*(const LAS bf16x8*)(Av + 64), bk1, ya);
                *(GAS f32x4*)(Ycg + ((mt * 4 + nt) * 64 + lane) * 4) = ya;
            }
        }
    }
}
constexpr int R2_SLOT = 8192 + 16384, R2_NS = 6;
__device__ __forceinline__ void wkv_r2_head(Frame& F, int bh) {
    const int lane = F.lane, w = F.wave, nt = w & 3;
    LAS unsigned char* lds = F.lds;
    const bf16* Mg = (const bf16*)(F.ws + WS_CM) + (size_t)bh * NCHK * 4096;
    const float* Gg = (const float*)(F.ws + WS_CG) + (size_t)bh * NCHK * 4096;
    bf16* Sg = (bf16*)(F.ws + WS_CS) + (size_t)bh * NCHK * 4096;
    f32x4 S[4];
#pragma unroll
    for (int mt = 0; mt < 4; ++mt) S[mt] = (f32x4){0.f, 0.f, 0.f, 0.f};
#define R2_ISSUE(cidx) do { const int sl_ = (cidx) % R2_NS; const bf16* Mc_ = Mg + (size_t)(cidx) * 4096; const float* Gc_ = Gg + (size_t)(cidx) * 4096; \
        _Pragma("unroll") for (int i_ = 0; i_ < 2; ++i_) { const int pi_ = nt * 2 + i_; __builtin_amdgcn_global_load_lds((const GAS unsigned*)(Mc_ + pi_ * 512 + lane * 8), (LAS unsigned*)(lds + sl_ * R2_SLOT + pi_ * 1024), 16, 0, 0); } \
        _Pragma("unroll") for (int i_ = 0; i_ < 4; ++i_) { const int pi_ = nt * 4 + i_; __builtin_amdgcn_global_load_lds((const GAS unsigned*)(Gc_ + pi_ * 256 + lane * 4), (LAS unsigned*)(lds + sl_ * R2_SLOT + 8192 + pi_ * 1024), 16, 0, 0); } } while (0)
    LDS_BARRIER();
    if (w >= 4) { R2_ISSUE(0); R2_ISSUE(1); R2_ISSUE(2); R2_ISSUE(3); R2_ISSUE(4); asm volatile("s_waitcnt vmcnt(24)" ::: "memory"); }
    LDS_BARRIER();
    for (int c = 0; c < NCHK; ++c) {
        if (w >= 4) {
            if (c + 5 < NCHK) { R2_ISSUE(c + 5); asm volatile("s_waitcnt vmcnt(24)" ::: "memory"); }
            else asm volatile("s_waitcnt vmcnt(0)" ::: "memory");
        } else {
            const LAS unsigned char* sp_ = lds + (c % R2_NS) * R2_SLOT;
            v2u sb[4];
#pragma unroll
            for (int mt = 0; mt < 4; ++mt) { sb[mt] = pk4(S[mt]); *(GAS v2u*)(Sg + (size_t)c * 4096 + ((nt * 4 + mt) * 64 + lane) * 4) = sb[mt]; }
            const bf16x8 bf0 = __builtin_bit_cast(bf16x8, (v4u){sb[0].x, sb[0].y, sb[1].x, sb[1].y});
            const bf16x8 bf1 = __builtin_bit_cast(bf16x8, (v4u){sb[2].x, sb[2].y, sb[3].x, sb[3].y});
#pragma unroll
            for (int mt = 0; mt < 4; ++mt) {
                const LAS unsigned char* mp = sp_ + ((mt * 4) * 64 + lane) * 8;
                const v2u a00 = *(const LAS v2u*)mp, a01 = *(const LAS v2u*)(mp + 512), a10 = *(const LAS v2u*)(mp + 1024), a11 = *(const LAS v2u*)(mp + 1536);
                f32x4 acc = *(const LAS f32x4*)(sp_ + 8192 + ((nt * 4 + mt) * 64 + lane) * 16);
                acc = mfma32(__builtin_bit_cast(bf16x8, (v4u){a00.x, a00.y, a01.x, a01.y}), bf0, acc);
                acc = mfma32(__builtin_bit_cast(bf16x8, (v4u){a10.x, a10.y, a11.x, a11.y}), bf1, acc);
                S[mt] = acc;
            }
        }
        LDS_BARRIER();
    }
#undef R2_ISSUE
}
__device__ __forceinline__ void wkv_r3_wave(Frame& F, int L, int unit) {
    const int c = unit % NCHK, bh = unit / NCHK, h = bh % NH, b = bh / NH;
    const int lane = F.lane, fr = lane & 15, g = lane >> 4;
    const bf16* Sg = (const bf16*)(F.ws + WS_CS) + (size_t)unit * 4096;
    const bf16* Ryg = (const bf16*)(F.ws + WS_CRY) + (size_t)unit * 4096;
    const float* Ycg = (const float*)(F.ws + WS_CYC) + (size_t)unit * 4096;
    const bf16* SV = (const bf16*)(F.ws + WS_SV); const bf16* SG = (const bf16*)(F.ws + WS_SG); const float* BON = (const float*)(F.ws + WS_BON);
    bf16* YC = (bf16*)(F.ws + WS_YC);
    const float* lg = INP(I_LNG) + (size_t)L * C + h * HD; const float* lb = INP(I_LNB) + (size_t)L * C + h * HD;
    const size_t tok0 = (size_t)b * SEQ + (size_t)c * 64;
    bf16x8 sa[4][2];
#pragma unroll
    for (int mt = 0; mt < 4; ++mt)
#pragma unroll
        for (int ks = 0; ks < 2; ++ks) { const v2u s0 = *(const GAS v2u*)(Sg + ((mt * 4 + 2 * ks) * 64 + lane) * 4), s1 = *(const GAS v2u*)(Sg + ((mt * 4 + 2 * ks + 1) * 64 + lane) * 4);
            sa[mt][ks] = __builtin_bit_cast(bf16x8, (v4u){s0.x, s0.y, s1.x, s1.y}); }
    f32x4 lgv[4], lbv[4];
#pragma unroll
    for (int mt = 0; mt < 4; ++mt) { lgv[mt] = *(const GAS f32x4*)(lg + 16 * mt + 4 * g); lbv[mt] = *(const GAS f32x4*)(lb + 16 * mt + 4 * g); }
#pragma unroll
    for (int nt = 0; nt < 4; ++nt) {
        const int t = 16 * nt + fr;
        const v2u r00 = *(const GAS v2u*)(Ryg + ((nt * 4 + 0) * 64 + lane) * 4), r01 = *(const GAS v2u*)(Ryg + ((nt * 4 + 1) * 64 + lane) * 4), r10 = *(const GAS v2u*)(Ryg + ((nt * 4 + 2) * 64 + lane) * 4), r11 = *(const GAS v2u*)(Ryg + ((nt * 4 + 3) * 64 + lane) * 4);
        const bf16x8 rb0 = __builtin_bit_cast(bf16x8, (v4u){r00.x, r00.y, r01.x, r01.y}), rb1 = __builtin_bit_cast(bf16x8, (v4u){r10.x, r10.y, r11.x, r11.y});
        f32x4 y[4]; float s = 0.f;
#pragma unroll
        for (int mt = 0; mt < 4; ++mt) {
            f32x4 acc = *(const GAS f32x4*)(Ycg + ((mt * 4 + nt) * 64 + lane) * 4);
            acc = mfma32(sa[mt][0], rb0, acc); acc = mfma32(sa[mt][1], rb1, acc);
            y[mt] = acc; s += (acc[0] + acc[1]) + (acc[2] + acc[3]);
        }
        s += __shfl_xor(s, 16); s += __shfl_xor(s, 32);
        const float mean = s * (1.f / HD); float q = 0.f;
#pragma unroll
        for (int mt = 0; mt < 4; ++mt) { y[mt] = y[mt] - mean; q += (y[mt][0] * y[mt][0] + y[mt][1] * y[mt][1]) + (y[mt][2] * y[mt][2] + y[mt][3] * y[mt][3]); }
        q += __shfl_xor(q, 16); q += __shfl_xor(q, 32);
        const float rstd = 1.0f / sqrtf(q * (1.f / HD) + LNX_EPS);
        const float bon = BON[(tok0 + t) * NH + h];
#pragma unroll
        for (int mt = 0; mt < 4; ++mt) {
            const size_t o = (tok0 + t) * C + h * HD + 16 * mt + 4 * g;
            const v2u vv = *(const GAS v2u*)(SV + o), gg = *(const GAS v2u*)(SG + o);
            f32x4 r;
            r[0] = (y[mt][0] * rstd * lgv[mt][0] + lbv[mt][0] + bon * bflo(vv.x)) * bflo(gg.x);
            r[1] = (y[mt][1] * rstd * lgv[mt][1] + lbv[mt][1] + bon * bfhi(vv.x)) * bfhi(gg.x);
            r[2] = (y[mt][2] * rstd * lgv[mt][2] + lbv[mt][2] + bon * bflo(vv.y)) * bflo(gg.y);
            r[3] = (y[mt][3] * rstd * lgv[mt][3] + lbv[mt][3] + bon * bfhi(vv.y)) * bfhi(gg.y);
            *(GAS v2u*)(YC + (tok0 + t) * D + h * HD + 16 * mt + 4 * g) = pk4(r);
        }
    }
}

__device__ __forceinline__ int crow(int r, int hi) { return (r & 3) + 8 * (r >> 2) + 4 * hi; }
typedef short s16x4 __attribute__((ext_vector_type(4)));
__device__ __forceinline__ unsigned cvtpk(float lo, float hi) { return pk2(lo, hi); }
__device__ __forceinline__ s16x4 vtr(const LAS unsigned char* p) { return __builtin_bit_cast(s16x4, __builtin_amdgcn_ds_read_tr16_b64_v4i16((LAS s16x4*)p)); }
constexpr float ATT_THR = 6.0f;
constexpr int A_KB = 0, A_VB = 65536, A_KM = 131072;
__device__ __forceinline__ void attn2_unit(Frame& F, int b, int h, int qb, int half) {
    const bf16* AQ = (const bf16*)(F.ws + WS_AQ); const bf16* AKp = (const bf16*)(F.ws + WS_AK); const bf16* Z = (const bf16*)(F.ws + WS_Z); const float* KM = (const float*)(F.ws + WS_KM);
    bf16* YC = (bf16*)(F.ws + WS_YC);
    const int tid = F.tid, lane = F.lane, w = F.wave, qg = w & 3, kvh = w >> 2, r32 = lane & 31, hi = lane >> 5;
    LAS unsigned char* lds = F.lds;
    const size_t tb = (size_t)b * SEQ; const int q0w = qb * MB + 128 * half + 32 * qg;
    LDS_BARRIER();
    for (int i = tid; i < NBLK * AD; i += NTHR) { const float v = KM[(size_t)(b * AH + h) * NBLK * AD + i]; const unsigned hb = f2bf(v); const float rem = v - __builtin_bit_cast(float, hb << 16);
        ((LAS unsigned short*)(lds + A_KM))[i] = (unsigned short)hb; ((LAS unsigned short*)(lds + A_KM + 4096))[i] = (unsigned short)f2bf(rem); }
    bf16x8 qr[8];
    { const bf16* Qp = AQ + (tb + q0w + r32) * C + h * AD + hi * 8;
#pragma unroll
      for (int d0 = 0; d0 < 8; ++d0) qr[d0] = *(const GAS bf16x8*)(Qp + d0 * 16); }
    const int n_own = half ? 2 : 1, NS = n_own + 2 * qb;
    const bf16* Kg = AKp + tb * C + h * AD; const bf16* Vg = Z + tb * NZ + ZV + h * AD;
#define STEP_KB(si) (((si) < n_own) ? (qb * MB + 128 * (si)) : ((((si) - n_own) >> 1) * MB + 128 * (((si) - n_own) & 1)))
    const int dl_r = lane >> 4, dl_cs = lane & 15;
#define ATT_LOAD(si, bi) do { const int kb_ = STEP_KB(si); _Pragma("unroll") for (int i_ = 0; i_ < 4; ++i_) { const int pi_ = w + 8 * i_; const int row_ = 4 * pi_ + dl_r; \
        __builtin_amdgcn_global_load_lds((const GAS unsigned*)(Kg + (size_t)(kb_ + row_) * C + ((dl_cs ^ (row_ & 15)) << 3)), (LAS unsigned*)(lds + A_KB + (bi) * 32768 + pi_ * 1024), 16, 0, 0); \
        __builtin_amdgcn_global_load_lds((const GAS unsigned*)(Vg + (size_t)(kb_ + row_) * NZ + ((dl_cs ^ ((row_ & 3) << 2)) << 3)), (LAS unsigned*)(lds + A_VB + (bi) * 32768 + pi_ * 1024), 16, 0, 0); } } while (0)
    ATT_LOAD(0, 0);
    LDS_BARRIER();
    unsigned selmask;
    {
        f32x16 ga = (f32x16){0.f};
        const bool rowok = r32 < 16;
#pragma unroll
        for (int d0 = 0; d0 < 8; ++d0) {
            const LAS unsigned char* kp = lds + A_KM + (r32 & 15) * 256 + d0 * 32 + hi * 16;
            bf16x8 ah = *(const LAS bf16x8*)kp, al = *(const LAS bf16x8*)(kp + 4096);
            if (!rowok) { ah = (bf16x8){0, 0, 0, 0, 0, 0, 0, 0}; al = ah; }
            ga = __builtin_amdgcn_mfma_f32_32x32x16_bf16(ah, qr[d0], ga, 0, 0, 0);
            ga = __builtin_amdgcn_mfma_f32_32x32x16_bf16(al, qr[d0], ga, 0, 0, 0);
        }
        float gt[16];
#pragma unroll
        for (int r = 0; r < 4; ++r) { const float o0 = __shfl_xor(ga[r], 32), o1 = __shfl_xor(ga[4 + r], 32);
            gt[r] = hi ? o0 : ga[r]; gt[4 + r] = hi ? ga[r] : o0; gt[8 + r] = hi ? o1 : ga[4 + r]; gt[12 + r] = hi ? ga[4 + r] : o1; }
        float g1 = -INFINITY, g2 = -INFINITY, g3 = -INFINITY; int i1 = 0, i2 = 0, i3 = 0;
#pragma unroll
        for (int n = 0; n < 16; ++n) { if (n < qb) { const float g = gt[n];
            if (g > g1) { g3 = g2; i3 = i2; g2 = g1; i2 = i1; g1 = g; i1 = n; }
            else if (g > g2) { g3 = g2; i3 = i2; g2 = g; i2 = n; }
            else if (g > g3) { g3 = g; i3 = n; } } }
        selmask = (qb <= 3) ? ((1u << qb) - 1u) : ((1u << i1) | (1u << i2) | (1u << i3));
    }
    f32x16 O[4];
#pragma unroll
    for (int dt = 0; dt < 4; ++dt) O[dt] = (f32x16){0.f};
    float m_run = -1e30f, l_run = 0.f;
    VM_WAIT();
    LDS_BARRIER();
    const int qpos = q0w + r32;
    const int trq = (lane & 15) >> 2, trp = lane & 3, trg = (lane >> 4) & 1;
    for (int si = 0; si < NS; ++si) {
        if (si + 1 < NS) ATT_LOAD(si + 1, (si + 1) & 1);
        const bool own = si < n_own;
        const int kt = STEP_KB(si) + 64 * kvh;
        const bool skip = own && (kt > q0w + 31);
        if (!skip) {
            const LAS unsigned char* kb_ = lds + A_KB + (si & 1) * 32768 + (64 * kvh) * 256;
            const LAS unsigned char* vb_ = lds + A_VB + (si & 1) * 32768 + (64 * kvh) * 256;
            f32x16 p[2];
#pragma unroll
            for (int kb2 = 0; kb2 < 2; ++kb2) {
                f32x16 acc = (f32x16){0.f};
                const int row = 32 * kb2 + r32;
#pragma unroll
                for (int d0 = 0; d0 < 8; ++d0) {
                    const bf16x8 kf = *(const LAS bf16x8*)(kb_ + row * 256 + (((2 * d0 + hi) ^ (row & 15)) << 4));
                    acc = __builtin_amdgcn_mfma_f32_32x32x16_bf16(kf, qr[d0], acc, 0, 0, 0);
                }
                p[kb2] = acc;
            }
            if (own && (kt + 63 > q0w)) {
#pragma unroll
                for (int kb2 = 0; kb2 < 2; ++kb2)
#pragma unroll
                    for (int r = 0; r < 16; ++r) { const int kpos = kt + 32 * kb2 + crow(r, hi); p[kb2][r] = (kpos <= qpos) ? p[kb2][r] : -1e30f; }
            }
            const bool ok = own || ((selmask >> ((si - n_own) >> 1)) & 1u);
            float mx = fmaxf(p[0][0], p[1][0]);
#pragma unroll
            for (int r = 1; r < 16; ++r) mx = fmaxf(mx, fmaxf(p[0][r], p[1][r]));
            mx = fmaxf(mx, __shfl_xor(mx, 32));
            mx = ok ? mx : -1e30f;
            if (__any(mx > m_run + ATT_THR)) {
                const float m_new = fmaxf(m_run, mx); const float alpha = __builtin_amdgcn_exp2f(m_run - m_new);
                m_run = m_new; l_run *= alpha;
#pragma unroll
                for (int dt = 0; dt < 4; ++dt)
#pragma unroll
                    for (int r = 0; r < 16; ++r) O[dt][r] *= alpha;
            }
            float ls = 0.f;
#pragma unroll
            for (int kb2 = 0; kb2 < 2; ++kb2)
#pragma unroll
                for (int r = 0; r < 16; ++r) { const float e = __builtin_amdgcn_exp2f(p[kb2][r] - m_run); p[kb2][r] = e; ls += e; }
            l_run += ok ? ls : 0.f;
            const unsigned okm = ok ? 0xffffffffu : 0u;
#pragma unroll
            for (int kb2 = 0; kb2 < 2; ++kb2)
#pragma unroll
                for (int s = 0; s < 2; ++s) {
                    v4u pw; pw.x = cvtpk(p[kb2][8 * s + 0], p[kb2][8 * s + 1]) & okm; pw.y = cvtpk(p[kb2][8 * s + 2], p[kb2][8 * s + 3]) & okm;
                    pw.z = cvtpk(p[kb2][8 * s + 4], p[kb2][8 * s + 5]) & okm; pw.w = cvtpk(p[kb2][8 * s + 6], p[kb2][8 * s + 7]) & okm;
                    const bf16x8 pf = __builtin_bit_cast(bf16x8, pw);
                    const int key0 = 32 * kb2 + 16 * s + 4 * hi + trq;
#pragma unroll
                    for (int dt = 0; dt < 4; ++dt) {
                        const int dby = (32 * dt + 16 * trg + 4 * trp) * 2;
                        const s16x4 lo = vtr(vb_ + key0 * 256 + (dby ^ ((key0 & 3) << 6)));
                        const s16x4 hi4 = vtr(vb_ + (key0 + 8) * 256 + (dby ^ (((key0 + 8) & 3) << 6)));
                        const bf16x8 vf = (bf16x8){lo[0], lo[1], lo[2], lo[3], hi4[0], hi4[1], hi4[2], hi4[3]};
                        O[dt] = __builtin_amdgcn_mfma_f32_32x32x16_bf16(vf, pf, O[dt], 0, 0, 0);
                    }
                }
        }
        VM_WAIT();
        LDS_BARRIER();
    }
    LAS float* cb = (LAS float*)lds + (size_t)qg * 64 * 67;
    if (kvh == 1) {
        LAS float* cp = cb + lane * 67;
        cp[64] = m_run; cp[65] = l_run;
#pragma unroll
        for (int dt = 0; dt < 4; ++dt)
#pragma unroll
            for (int r = 0; r < 16; ++r) cp[dt * 16 + r] = O[dt][r];
    }
    LDS_BARRIER();
    if (kvh == 0) {
        const LAS float* cp = cb + lane * 67;
        const float m1 = cp[64], l1 = cp[65];
        const float m = fmaxf(m_run, m1); const float a0 = __builtin_amdgcn_exp2f(m_run - m), a1 = __builtin_amdgcn_exp2f(m1 - m);
        float l = l_run * a0 + l1 * a1; l += __shfl_xor(l, 32);
        const float inv = 1.0f / l;
#pragma unroll
        for (int dt = 0; dt < 4; ++dt)
#pragma unroll
            for (int r = 0; r < 16; ++r) O[dt][r] = (O[dt][r] * a0 + cp[dt * 16 + r] * a1) * inv;
    }
    LDS_BARRIER();
    if (kvh == 0) {
        LAS unsigned char* st = lds + 69632 + qg * (32 * 272);
#pragma unroll
        for (int dt = 0; dt < 4; ++dt)
#pragma unroll
            for (int rq = 0; rq < 4; ++rq) { v2u wv; wv.x = cvtpk(O[dt][4 * rq], O[dt][4 * rq + 1]); wv.y = cvtpk(O[dt][4 * rq + 2], O[dt][4 * rq + 3]);
                *(LAS v2u*)(st + r32 * 272 + (32 * dt + 8 * rq + 4 * hi) * 2) = wv; }
        LDS_WAIT(); asm volatile("" ::: "memory");
#pragma unroll
        for (int i = 0; i < 8; ++i) { const int row = i * 4 + (lane >> 4), ch = lane & 15;
            const v4u v = *(const LAS v4u*)(st + row * 272 + ch * 16);
            *(GAS v4u*)(YC + (tb + q0w + row) * D + C + h * AD + ch * 8) = v; }
    }
#undef STEP_KB
#undef ATT_LOAD
}
__device__ __forceinline__ void ph_wkv_r1(Frame& F, int L) { const int upc = (NUNIT + F.G - 1) / F.G; for (int k = 0; k < upc; ++k) { const int u = F.vcu * upc + k; if (u < NUNIT) wkv_r1_unit(F, L, u); } }
__device__ __forceinline__ void ph_wkv_r2(Frame& F) { for (int bh = F.vcu; bh < BATCH * NH; bh += F.G) wkv_r2_head(F, bh); }
__device__ __forceinline__ void ph_mixer(Frame& F, int L) {
    for (int u = F.vcu * NWAVES + F.wave; u < NUNIT; u += F.G * NWAVES) wkv_r3_wave(F, L, u);
    for (int it = F.vcu; it < BATCH * AH * NBLK; it += F.G) { const int bh = it >> 4, rem = it & 15, qlo = rem >> 1, hf = rem & 1;
        for (int k = 0; k < 2; ++k) attn2_unit(F, bh / AH, bh % AH, k ? qlo : NBLK - 1 - qlo, k ? hf : 1 - hf); }
}

constexpr int PH_PER_LAYER = 11, NPHASE = DEPTH * PH_PER_LAYER;
#ifndef MK_N_LAUNCHES
#define MK_N_LAUNCHES 1
#endif
struct Args { const float* in[24]; float* out; unsigned char* ws; int ph_lo, ph_hi, li, pad; };
__global__ void __launch_bounds__(NTHR, 2) mega_fwd(Args args) {
    extern __shared__ __attribute__((aligned(16))) unsigned char lds[];
    Frame F;
    F.lds = (LAS unsigned char*)lds;
    F.MISC = (volatile LAS unsigned*)(F.lds + MISC_OFF);
    F.tid = threadIdx.x; F.lane = F.tid & 63; F.wave = __builtin_amdgcn_readfirstlane(F.tid >> 6);
    F.G = gridDim.x; { const int bx = blockIdx.x; F.vcu = (F.G % 8 == 0) ? (bx % 8) * (F.G / 8) + bx / 8 : bx; }
    F.ws = args.ws; F.out = args.out; F.ctl = (gu32*)(args.ws + WS_CTL);
    for (int u = F.tid; u < (LDS_BYTES - LDSCTL_OFF) / 4; u += NTHR) ((LAS unsigned*)(F.lds + LDSCTL_OFF))[u] = 0u;
    __syncthreads();
    if (F.tid < 24) *(LAS unsigned long long*)(F.lds + PTAB_OFF + 8 * F.tid) = (unsigned long long)args.in[F.tid];
    __syncthreads();
    XcdBarrier bar; bar.bar = (unsigned*)(F.ctl + CW_BAR) + args.li * XCD_BAR_WORDS; bar.x = 0; bar.st = nullptr;
    const bool one_launch = (args.ph_hi - args.ph_lo) > 1;
    if (one_launch) bar = xcd_barrier_post((unsigned*)(F.ctl + CW_BAR) + args.li * XCD_BAR_WORDS, F.MISC + 8);
    bf16* HN = (bf16*)(F.ws + WS_HN); bf16* YC = (bf16*)(F.ws + WS_YC); bf16* Zb = (bf16*)(F.ws + WS_Z); bf16* U = (bf16*)(F.ws + WS_U);
    float* Y2 = (float*)(F.ws + WS_Y2); float* Mo = (float*)(F.ws + WS_M);
#ifdef PROBE_DUP_MASK
    bool dup_done = false;
#endif
    for (int ph = args.ph_lo; ph < args.ph_hi; ++ph) {
        const int L = ph / PH_PER_LAYER, p = ph % PH_PER_LAYER;
        { int t_ = threadIdx.x; asm volatile("" : "+v"(t_)); F.tid = t_; F.lane = t_ & 63; F.wave = __builtin_amdgcn_readfirstlane(t_ >> 6); }
        { unsigned long long w_ = (unsigned long long)args.ws, o_ = (unsigned long long)args.out; asm volatile("" : "+s"(w_), "+s"(o_)); F.ws = (unsigned char*)(GAS unsigned char*)w_; F.out = (float*)(GAS float*)o_; F.ctl = (gu32*)w_; }
        { int g_ = gridDim.x, b_ = blockIdx.x; asm volatile("" : "+s"(g_), "+s"(b_)); F.G = g_; F.bx = b_; F.vcu = (g_ % 8 == 0) ? (b_ % 8) * (g_ / 8) + b_ / 8 : b_; }
        { unsigned l_ = (unsigned)(unsigned long long)(LAS unsigned char*)lds; asm volatile("" : "+s"(l_)); F.lds = (LAS unsigned char*)(unsigned long long)l_; }
        switch (p) {
        case 0: ph_convert(F, L); break;
        case 1: { pg8::Gemm g{HN, (const bf16*)(F.ws + WS_WIN), T, (L == 0) ? NIN : NZ, D}; pg8::StaticOrder S; S.init(T, (L == 0) ? NIN : NZ, F.G, F.bx);
                  pg8::EpiBf16<0> E{Zb, NZ}; pg8::gemm_phase<pg8::EpiBf16<0>, pg8::StaticOrder, true, true>(F.lds, g, S, E, F.tid); } break;
        case 2: ph_prep(F, L); break;
        case 3: ph_wkv_r1(F, L); break;
        case 4: ph_wkv_r2(F); break;
        case 5: ph_mixer(F, L); break;
        case 6: { pg8::Gemm g{YC, (const bf16*)(F.ws + WS_WOUT), T, D, D}; pg8::StaticOrder S; S.init(T, D, F.G, F.bx);
                  pg8::EpiF32 E{Y2, D}; pg8::gemm_phase<pg8::EpiF32, pg8::StaticOrder, true, true>(F.lds, g, S, E, F.tid); } break;
        case 7: ph_resnorm(F, Y2, (L == 0) ? INP(I_X) : F.out, INP(I_NMIXPOST) + (size_t)L * D, INP(I_NMLPPRE) + (size_t)L * D, F.out, HN); break;
        case 8: { pg8::Gemm g{HN, (const bf16*)(F.ws + WS_WUP), T, FF, D}; pg8::StaticOrder S; S.init(T, FF, F.G, F.bx);
                  pg8::EpiBf16<2> E{U, FF}; pg8::gemm_phase<pg8::EpiBf16<2>, pg8::StaticOrder, true, true>(F.lds, g, S, E, F.tid); } break;
        case 9: { pg8::Gemm g{U, (const bf16*)(F.ws + WS_WDN), T, D, FF}; pg8::StaticOrder S; S.init(T, D, F.G, F.bx);
                  pg8::EpiF32 E{Mo, D}; pg8::gemm_phase<pg8::EpiF32, pg8::StaticOrder, true, true>(F.lds, g, S, E, F.tid); } break;
        case 10: ph_resnorm(F, Mo, F.out, INP(I_NMLPPOST) + (size_t)L * D, (L + 1 < DEPTH) ? INP(I_NMIXPRE) + (size_t)(L + 1) * D : nullptr, F.out, HN); break;
        }
        if (ph + 1 < args.ph_hi) xcd_barrier(bar);
#ifdef PROBE_DUP_MASK
        if (((PROBE_DUP_MASK >> p) & 1) && !dup_done) { dup_done = true; --ph; } else dup_done = false;
#endif
    }
}

extern "C" void kernel_launch(void* const* d_in, const int* in_sizes, int n_in, void* d_out, int out_size, void* d_ws, size_t ws_size, hipStream_t stream) {
    static int grid = 0;
    if (grid == 0) {
        if (n_in != 24 || in_sizes[0] != T * D || out_size != T * D || ws_size < WS_END) { fprintf(stderr, "kernel_launch: unexpected shapes (n_in %d, in0 %d, out %d, ws %zu)\n", n_in, n_in > 0 ? in_sizes[0] : -1, out_size, ws_size); grid = -1; return; }
        int dev = 0, cus = 0, per_cu = 0;
        if (hipGetDevice(&dev) != hipSuccess || hipDeviceGetAttribute(&cus, hipDeviceAttributeMultiprocessorCount, dev) != hipSuccess) { grid = -1; return; }
        if (hipFuncSetAttribute((const void*)mega_fwd, hipFuncAttributeMaxDynamicSharedMemorySize, LDS_BYTES) != hipSuccess) { fprintf(stderr, "kernel_launch: hipFuncSetAttribute failed\n"); grid = -1; return; }
        if (hipOccupancyMaxActiveBlocksPerMultiprocessor(&per_cu, (const void*)mega_fwd, NTHR, LDS_BYTES) != hipSuccess || per_cu < 1) { fprintf(stderr, "kernel_launch: occupancy query says %d\n", per_cu); per_cu = 1; }
        (void)hipGetLastError();
        grid = cus * (per_cu > 1 ? 1 : per_cu);
    }
    if (grid < 0) return;
    (void)hipMemsetAsync((char*)d_ws + WS_CTL, 0, CTL_ZERO_BYTES, stream);
    Args a{};
    for (int i = 0; i < 24; ++i) a.in[i] = (const float*)d_in[i];
    a.out = (float*)d_out; a.ws = (unsigned char*)d_ws;
    const int nl = MK_N_LAUNCHES;
    for (int li = 0; li < nl; ++li) {
        a.li = li; a.ph_lo = (int)((long)NPHASE * li / nl); a.ph_hi = (int)((long)NPHASE * (li + 1) / nl);
        if (a.ph_hi - a.ph_lo > 1) {
            void* kargs[] = {&a};
            hipError_t e = hipLaunchCooperativeKernel((const void*)mega_fwd, dim3(grid), dim3(NTHR), kargs, LDS_BYTES, stream);
            if (e != hipSuccess) fprintf(stderr, "kernel_launch: cooperative launch failed: %s (grid %d)\n", hipGetErrorString(e), grid);
        } else {
            hipLaunchKernelGGL(mega_fwd, dim3(grid), dim3(NTHR), LDS_BYTES, stream, a);
        }
    }
}
```
